# Optimizing an MI355X kernel written in HIP

```python
import jax, jax.numpy as jnp
from jax import lax
import numpy as np

D_MODEL = 2048
BATCH = 4
SEQ = 8192
DEPTH = 1

D_MIX = D_MODEL
HEAD_DIM = 64
ATTN_WIDTH = D_MIX // 2
SGU_WIDTH = D_MIX - ATTN_WIDTH
N_ATTN_HEADS = ATTN_WIDTH // HEAD_DIM
N_SGU_GROUPS = 16
SGU_GROUP_DIM = SGU_WIDTH // N_SGU_GROUPS
D_IN_PROJ = 3 * ATTN_WIDTH + 2 * SGU_WIDTH

GRID_W = 64
WIN_ROWS_MAX = 8
WIN_COLS = 16
RPB_ROWS = 2 * WIN_ROWS_MAX - 1
RPB_COLS = 2 * WIN_COLS - 1

CHUNK = 128

N_EXPERTS = 32
TOP_K = 4
D_EXPERT = D_MODEL
SWIGLU_LIMIT = 7.0
SWIGLU_ALPHA = 1.702

EPS = 1e-6

kernel_name = "hymba_natten_sgu_moe_block"


def rms_norm(x, g):
    xf = x.astype(jnp.float32)
    y = xf * lax.rsqrt(jnp.mean(xf * xf, axis=-1, keepdims=True) + EPS)
    return (y * g.astype(jnp.float32)).astype(x.dtype)


def neighbourhood_attention(q, k, v, q_norm_g, k_norm_g, rpb):
    B, S, H, dh = q.shape
    rows = S // GRID_W
    kh = min(WIN_ROWS_MAX, rows)
    n_keys = kh * WIN_COLS
    q = rms_norm(q, q_norm_g)
    k = rms_norm(k, k_norm_g)
    scale = dh ** -0.5

    cols = np.arange(GRID_W, dtype=np.int32)
    col_start = np.clip(cols - WIN_COLS // 2, 0, GRID_W - WIN_COLS).astype(np.int32)
    col_idx = (col_start[:, None] + np.arange(WIN_COLS, dtype=np.int32)[None, :]).astype(np.int32)
    col_off = (col_idx - cols[:, None] + WIN_COLS - 1).astype(np.int32)
    rpb_cols = rpb.astype(jnp.float32)[:, :, col_off]

    def one_row(r):
        row_start = jnp.clip(r - kh // 2, 0, rows - kh)
        key_rows = row_start + jnp.arange(kh, dtype=jnp.int32)
        key_pos = key_rows[None, :, None] * GRID_W + col_idx[:, None, :]
        key_pos = key_pos.reshape(-1)
        q_blk = lax.dynamic_slice_in_dim(q, r * GRID_W, GRID_W, axis=1)
        k_blk = jnp.take(k, key_pos, axis=1).reshape(B, GRID_W, n_keys, H, dh)
        v_blk = jnp.take(v, key_pos, axis=1).reshape(B, GRID_W, n_keys, H, dh)
        row_off = key_rows - r + WIN_ROWS_MAX - 1
        bias = rpb_cols[:, row_off]
        bias = bias.transpose(0, 2, 1, 3).reshape(H, GRID_W, n_keys)
        s = jnp.einsum('bqhd,bqkhd->bhqk', q_blk, k_blk,
                       preferred_element_type=jnp.float32) * scale + bias[None]
        p = jax.nn.softmax(s, axis=-1).astype(v.dtype)
        return jnp.einsum('bhqk,bqkhd->bqhd', p, v_blk)

    out = lax.map(one_row, jnp.arange(rows, dtype=jnp.int32))
    return out.transpose(1, 0, 2, 3, 4).reshape(B, S, H * dh)


def spatial_gating(u, g, sgu_norm_g, w_spatial, b_spatial):
    B, S, _ = u.shape
    n_chunks = S // CHUNK
    u = jax.nn.gelu(u, approximate=False)
    g = rms_norm(jax.nn.gelu(g, approximate=False), sgu_norm_g)
    g = g.reshape(B, n_chunks, CHUNK, N_SGU_GROUPS, SGU_GROUP_DIM)
    mixed = jnp.einsum('gpq,bcqgd->bcpgd', w_spatial, g)
    mixed = mixed + b_spatial.T[None, None, :, :, None]
    return u * mixed.reshape(B, S, SGU_WIDTH)


def moe_ffn(x, w_router, b_router, w_gate_up, b_gate_up, w_down, b_down):
    B, S, D = x.shape
    t = x.reshape(B * S, D)
    logits = jnp.einsum('td,de->te', t, w_router,
                        preferred_element_type=jnp.float32) + b_router.astype(jnp.float32)
    top_vals, top_idx = lax.top_k(logits, TOP_K)
    gates = jax.nn.softmax(top_vals, axis=-1)
    combine = jnp.sum(jax.nn.one_hot(top_idx, N_EXPERTS, dtype=jnp.float32) * gates[..., None], axis=1)
    y = jnp.zeros((B * S, D), jnp.float32)
    for e in range(N_EXPERTS):
        h = t @ w_gate_up[e] + b_gate_up[e]
        gate = jnp.minimum(h[:, :D_EXPERT], SWIGLU_LIMIT)
        lin = jnp.clip(h[:, D_EXPERT:], -SWIGLU_LIMIT, SWIGLU_LIMIT)
        act = gate * jax.nn.sigmoid(SWIGLU_ALPHA * gate) * (lin + 1)
        out = act @ w_down[e] + b_down[e]
        y = y + combine[:, e:e + 1] * out.astype(jnp.float32)
    return y.astype(x.dtype).reshape(B, S, D)


def setup_inputs(seed: int = 0) -> dict:
    key = jax.random.key(seed)
    ks = jax.random.split(key, 20)
    f32 = jnp.float32
    L = DEPTH

    def nrm(k, shape, scale):
        return jax.random.normal(k, shape, f32) * scale

    return {
        "x": jax.random.normal(ks[0], (BATCH, SEQ, D_MODEL), f32),
        "norm1_g": 1.0 + nrm(ks[1], (L, D_MODEL), 0.02),
        "w_in": nrm(ks[2], (L, D_MODEL, D_IN_PROJ), D_MODEL ** -0.5),
        "q_norm_g": 1.0 + nrm(ks[3], (L, HEAD_DIM), 0.02),
        "k_norm_g": 1.0 + nrm(ks[4], (L, HEAD_DIM), 0.02),
        "rpb": nrm(ks[5], (L, N_ATTN_HEADS, RPB_ROWS, RPB_COLS), 0.1),
        "sgu_norm_g": 1.0 + nrm(ks[6], (L, SGU_WIDTH), 0.02),
        "w_spatial": nrm(ks[7], (L, N_SGU_GROUPS, CHUNK, CHUNK), CHUNK ** -0.5),
        "b_spatial": 1.0 + nrm(ks[8], (L, N_SGU_GROUPS, CHUNK), 0.1),
        "attn_out_g": 1.0 + nrm(ks[9], (L, ATTN_WIDTH), 0.02),
        "sgu_out_g": 1.0 + nrm(ks[10], (L, SGU_WIDTH), 0.02),
        "w_out": nrm(ks[11], (L, D_MIX, D_MODEL), D_MIX ** -0.5),
        "norm2_g": 1.0 + nrm(ks[12], (L, D_MODEL), 0.02),
        "w_router": nrm(ks[13], (L, D_MODEL, N_EXPERTS), D_MODEL ** -0.5),
        "b_router": nrm(ks[14], (L, N_EXPERTS), 0.01),
        "w_gate_up": nrm(ks[15], (L, N_EXPERTS, D_MODEL, 2 * D_EXPERT), D_MODEL ** -0.5),
        "b_gate_up": nrm(ks[16], (L, N_EXPERTS, 2 * D_EXPERT), 0.02),
        "w_down": nrm(ks[17], (L, N_EXPERTS, D_EXPERT, D_MODEL), D_EXPERT ** -0.5),
        "b_down": nrm(ks[18], (L, N_EXPERTS, D_MODEL), 0.02),
    }


def reference(x, norm1_g, w_in, q_norm_g, k_norm_g, rpb, sgu_norm_g, w_spatial, b_spatial,
              attn_out_g, sgu_out_g, w_out, norm2_g, w_router, b_router,
              w_gate_up, b_gate_up, w_down, b_down):
    B, S, _ = x.shape
    for l in range(DEPTH):
        h = rms_norm(x, norm1_g[l])
        proj = h @ w_in[l]
        q, k, v, u, g = jnp.split(
            proj, [ATTN_WIDTH, 2 * ATTN_WIDTH, 3 * ATTN_WIDTH, 3 * ATTN_WIDTH + SGU_WIDTH], axis=-1)
        q = q.reshape(B, S, N_ATTN_HEADS, HEAD_DIM)
        k = k.reshape(B, S, N_ATTN_HEADS, HEAD_DIM)
        v = v.reshape(B, S, N_ATTN_HEADS, HEAD_DIM)
        a_out = neighbourhood_attention(q, k, v, q_norm_g[l], k_norm_g[l], rpb[l])
        s_out = spatial_gating(u, g, sgu_norm_g[l], w_spatial[l], b_spatial[l])
        mix = jnp.concatenate([rms_norm(a_out, attn_out_g[l]),
                               rms_norm(s_out, sgu_out_g[l])], axis=-1)
        x = x + mix @ w_out[l]
        x = x + moe_ffn(rms_norm(x, norm2_g[l]), w_router[l], b_router[l],
                        w_gate_up[l], b_gate_up[l], w_down[l], b_down[l])
    return x
```

```cpp
#include <hip/hip_runtime.h>
#include <cstdio>
#include <cstdint>

#ifndef MK_N_LAUNCHES
#define MK_N_LAUNCHES 1
#endif
constexpr int N_LAUNCHES = MK_N_LAUNCHES;
constexpr int N_PHASES = 9;

#define LAS __attribute__((address_space(3)))
#define GAS __attribute__((address_space(1)))
typedef unsigned short bf16;
typedef short bf16x8 __attribute__((ext_vector_type(8)));
typedef short s16x4 __attribute__((ext_vector_type(4)));
typedef float f32x4 __attribute__((ext_vector_type(4)));
typedef float f32x2 __attribute__((ext_vector_type(2)));
typedef unsigned u32x4 __attribute__((ext_vector_type(4)));
typedef unsigned u32x2 __attribute__((ext_vector_type(2)));
typedef GAS unsigned gu32;
typedef int v8i __attribute__((ext_vector_type(8)));
typedef int v4i __attribute__((ext_vector_type(4)));

constexpr int NTOK = 32768, DM = 2048, NPROJ = 5120, SEQ = 8192, NBATCH = 4;
constexpr int NE = 32, TOPK = 4, CAP = 32768;
constexpr int MAXROWS = NTOK * TOPK + NE * 256;
constexpr float EPS = 1e-6f;
constexpr int NWAVES = 8;

constexpr size_t MiB = 1u << 20;
constexpr size_t WS_CTL = 0, CTL_ZERO_BYTES = 1 * MiB;
constexpr size_t WS_WIN = 2 * MiB;
constexpr size_t WS_WOUT = 22 * MiB;
constexpr size_t WS_WSP = 30 * MiB;
constexpr size_t WS_WRH = 31 * MiB;
constexpr size_t WS_WRL = 31 * MiB + 128 * 1024;
constexpr size_t WS_RSTD2 = 31 * MiB + 512 * 1024;
constexpr size_t WS_SLOT = 32 * MiB;
constexpr size_t WS_GATE = 32 * MiB + 512 * 1024;
constexpr size_t WS_LIST = 33 * MiB;
constexpr size_t WS_WGU = 40 * MiB;
constexpr size_t WS_SSQA = 300 * MiB;
constexpr size_t WS_SSG = 304 * MiB;
constexpr size_t WS_RA = 308 * MiB;
constexpr size_t WS_RB = 309 * MiB;
constexpr size_t WS_SSX = 312 * MiB;
constexpr size_t WS_WDN = 552 * MiB;
constexpr size_t WS_H = 808 * MiB;
constexpr size_t WS_PROJ = 936 * MiB;
constexpr size_t WS_MIX = 1256 * MiB;
constexpr size_t WS_ACT = 1384 * MiB;
constexpr size_t WS_Y = 1928 * MiB;
constexpr size_t WS_END = 2472 * MiB;

constexpr int CW_TMO = 0, CW_CODE = 1;
constexpr int CW_BAR = 4096;
constexpr int CW_CNT = 8192;

constexpr int RING_BYTES = 131072;
constexpr int XT_OFF = RING_BYTES;
constexpr int XT_TOKL = XT_OFF;
constexpr int XT_TILEE = XT_OFF + 18432;
constexpr int XT_TSTART = XT_TILEE + 576;
constexpr int XT_CNT = XT_TSTART + 160;
constexpr int XT_BIAS = XT_OFF + 19456;
constexpr int XT_GAINS = XT_BIAS + 2048;
constexpr int XT_MISC2 = XT_GAINS + 512;
constexpr int AT_RPB = 147456;
constexpr int AT_MRG = AT_RPB + 2048;
constexpr int LDSCTL_OFF = AT_MRG + 10240;
constexpr int MISC_OFF = LDSCTL_OFF + 320;
constexpr int LDS_BYTES = LDSCTL_OFF + 1024;
static_assert(XT_CNT + 128 <= XT_BIAS && XT_MISC2 <= LDSCTL_OFF && LDS_BYTES <= 160 * 1024, "LDS map");
constexpr int N_PH = 9;

#define RLX_AGENT __ATOMIC_RELAXED, __HIP_MEMORY_SCOPE_AGENT
#define LDS_WAIT() asm volatile("s_waitcnt lgkmcnt(0)" ::: "memory")
#define VM_WAIT() asm volatile("s_waitcnt vmcnt(0)" ::: "memory")

__device__ __forceinline__ unsigned cvt_pk_bf16(float lo, float hi) { unsigned r; asm volatile("v_cvt_pk_bf16_f32 %0, %1, %2" : "=v"(r) : "v"(lo), "v"(hi)); return r; }
__device__ __forceinline__ unsigned pk4_fp8(float a, float b, float c, float d) { int w = 0; w = __builtin_amdgcn_cvt_pk_fp8_f32(a, b, w, false); w = __builtin_amdgcn_cvt_pk_fp8_f32(c, d, w, true); return (unsigned)w; }
__device__ __forceinline__ v8i cat8(bf16x8 a, bf16x8 b) { const v4i x = __builtin_bit_cast(v4i, a), y = __builtin_bit_cast(v4i, b); return __builtin_shufflevector(x, y, 0, 1, 2, 3, 4, 5, 6, 7); }
__device__ __forceinline__ bf16x8 lo8(v8i a) { return __builtin_bit_cast(bf16x8, (v4i)__builtin_shufflevector(a, a, 0, 1, 2, 3)); }
__device__ __forceinline__ bf16x8 hi8(v8i a) { return __builtin_bit_cast(bf16x8, (v4i)__builtin_shufflevector(a, a, 4, 5, 6, 7)); }
__device__ __forceinline__ void glds16(const void* gsrc, unsigned lds_dst) { unsigned keep;
    asm volatile("s_mov_b32 %0, m0\n\ts_mov_b32 m0, %2\n\ts_nop 0\n\tglobal_load_lds_dwordx4 %1, off\n\ts_mov_b32 m0, %0" : "=&s"(keep) : "v"(gsrc), "s"(lds_dst) : "memory"); }
__device__ __forceinline__ u32x4 pair16(u32x2 a, u32x2 b) { const auto s0 = __builtin_amdgcn_permlane16_swap(a.x, b.x, false, false), s1 = __builtin_amdgcn_permlane16_swap(a.y, b.y, false, false);
    u32x4 w; w.x = s0[0]; w.y = s1[0]; w.z = s0[1]; w.w = s1[1]; return w; }
__device__ __forceinline__ float bflo(unsigned u) { return __uint_as_float(u << 16); }
__device__ __forceinline__ float bfhi(unsigned u) { return __uint_as_float(u & 0xffff0000u); }
__device__ __forceinline__ float wave_sum(float v) {
#pragma unroll
    for (int o = 1; o < 64; o <<= 1) v += __shfl_xor(v, o);
    return v;
}
__device__ __forceinline__ f32x2 gelu_pk(f32x2 v) {
    const f32x2 av = __builtin_elementwise_abs(v), d = av * 0.2316418882f + 1.0f;
    f32x2 t; t.x = __builtin_amdgcn_rcpf(d.x); t.y = __builtin_amdgcn_rcpf(d.y);
    f32x2 q = t * 0.5307027145f + (-0.7265760135f); q = q * t + 0.7107068705f; q = q * t + (-0.142248368f); q = q * t + 0.127414796f; q = q * t;
    const f32x2 s = (v * v) * (-0.72134752044f);
    f32x2 e; e.x = __builtin_amdgcn_exp2f(s.x); e.y = __builtin_amdgcn_exp2f(s.y);
    const f32x2 m = v * (q * e), r = v - m;
    f32x2 o; o.x = v.x < 0.f ? m.x : r.x; o.y = v.y < 0.f ? m.y : r.y; return o;
}
__device__ __forceinline__ float gelu1(float x) { f32x2 r = gelu_pk((f32x2){x, x}); return r.x; }

#define XB_TMO      128
#define XB_XCNT(j)  (256  + 64 * (j))
#define XB_XSUB(j)  (1280 + 64 * (j))
#define XB_XGEN(j)  (2304 + 64 * (j))
#define XB_TOP      3328
#define XB_TOPGEN   3392
#define XCD_BAR_WORDS 3456
#define XB_SPIN_CAP (1u << 18)
__device__ __forceinline__ unsigned xb_ld(unsigned* p)              { return __hip_atomic_load(p, __ATOMIC_RELAXED, __HIP_MEMORY_SCOPE_AGENT); }
__device__ __forceinline__ unsigned xb_add(unsigned* p, unsigned v) { return __hip_atomic_fetch_add(p, v, __ATOMIC_RELAXED, __HIP_MEMORY_SCOPE_AGENT); }
__device__ __forceinline__ unsigned xb_xcc_id() { return (unsigned)__builtin_amdgcn_s_getreg((3 << 11) | 20) & 0xFu; }
#define XB_SPIN(cond, bar) do { unsigned _sp = 0; while (cond) { __builtin_amdgcn_s_sleep(1); \
    if ((++_sp & 255u) == 0u) { if (xb_ld(&(bar)[XB_TMO])) break; if (_sp > XB_SPIN_CAP) { atomicAdd(&(bar)[XB_TMO], 1u); break; } } } } while (0)
struct XcdBarrier { unsigned* bar; unsigned x; volatile LAS unsigned* st; };
__device__ __forceinline__ XcdBarrier xcd_barrier_post(unsigned* bar, volatile LAS unsigned* st) {
    XcdBarrier b; b.bar = bar; b.x = xb_xcc_id(); b.st = st;
    if (threadIdx.x == 0) (void)xb_add(&bar[XB_XCNT(b.x)], 1u);
    return b;
}
__device__ __forceinline__ void xcd_barrier_complete(unsigned* bar, unsigned x, unsigned& nloc, unsigned& nx) {
    const unsigned G = gridDim.x * gridDim.y * gridDim.z;
    unsigned sum, cnt, mine, sp = 0u;
    for (;;) {
        sum = 0u; cnt = 0u; mine = 0u;
#pragma unroll
        for (unsigned j = 0; j < 16; ++j) { const unsigned c = xb_ld(&bar[XB_XCNT(j)]); sum += c; cnt += (c > 0u) ? 1u : 0u; mine = (j == x) ? c : mine; }
        if (sum == G) break;
        __builtin_amdgcn_s_sleep(1);
        if ((++sp & 255u) == 0u) { if (xb_ld(&bar[XB_TMO])) break; if (sp > XB_SPIN_CAP) { atomicAdd(&bar[XB_TMO], 1u); break; } }
    }
    nloc = mine > 0u ? mine : 1u; nx = cnt > 0u ? cnt : 1u;
}
__device__ __forceinline__ void xcd_barrier(const XcdBarrier& b) {
    asm volatile("s_waitcnt vmcnt(0)" ::: "memory");
    __syncthreads();
    if (threadIdx.x == 0) {
        unsigned* bar = b.bar;
        __builtin_amdgcn_s_waitcnt(0);
        unsigned nloc = b.st[0], nx = b.st[1];
        if (nloc == 0u) { xcd_barrier_complete(bar, b.x, nloc, nx); b.st[0] = nloc; b.st[1] = nx; }
        const unsigned old = xb_add(&bar[XB_XSUB(b.x)], 1u);
        const unsigned gen = old / nloc;
        if (old + 1u == (gen + 1u) * nloc) {
            __builtin_amdgcn_fence(__ATOMIC_RELEASE, "agent");
            asm volatile("s_waitcnt vmcnt(0)" ::: "memory");
            const unsigned og = xb_add(&bar[XB_TOP], 1u);
            const unsigned tg = og / nx;
            if (og + 1u == (tg + 1u) * nx) xb_add(&bar[XB_TOPGEN], 1u);
            else XB_SPIN(xb_ld(&bar[XB_TOPGEN]) == tg, bar);
            __builtin_amdgcn_fence(__ATOMIC_ACQUIRE, "agent");
            xb_add(&bar[XB_XGEN(b.x)], 1u);
            asm volatile("s_waitcnt vmcnt(0)" ::: "memory");
        } else {
            XB_SPIN(xb_ld(&bar[XB_XGEN(b.x)]) == gen, bar);
            __builtin_amdgcn_fence(__ATOMIC_ACQUIRE, "agent");
            asm volatile("s_waitcnt vmcnt(0)" ::: "memory");
        }
    }
    __syncthreads();
}

constexpr int BM = 256, BK = 64, HALF = 128, HTB = HALF * BK * 2, NXCD = 8, WGM = 8;
__host__ __device__ __forceinline__ int lds_byte(int r, int c) { const int st = (r >> 4) * 2 + (c >> 5), rr = r & 15, cc = c & 31, ob = rr * 64 + cc * 2; return st * 1024 + (ob ^ (((ob >> 9) & 1) << 5)); }
__host__ __device__ __forceinline__ void stage_rc(int b, int& R, int& C) { const int st = b / 1024, sb = b % 1024, swz = sb ^ (((sb >> 9) & 1) << 5); R = (st >> 1) * 16 + swz / 64; C = (st & 1) * 32 + (swz % 64) / 2; }
__host__ __device__ __forceinline__ int perm32(int rho) { const int n = rho >> 4, i = rho & 15; return 8 * (i >> 2) + 4 * n + (i & 3); }

struct Unit { int pm, pn, e, ui; };
struct TileOrder {
    int nM, nN, nwg, G, c, ib, ie; const LAS unsigned char* tileE;
    __device__ __forceinline__ void init(int nM_, int nN_, int G_, int c_, const LAS unsigned char* te) { nM = nM_; nN = nN_; nwg = nM * nN; G = G_; c = c_; tileE = te; ib = 0; ie = 0x7fffffff; }
    __device__ __forceinline__ bool next(int i_, Unit& u) const {
        const int i = ib + i_; if (i >= ie) return false;
        const long L = (long)i * G + c; if (L >= nwg) return false;
        int wgid = (int)L; { const int q = nwg / NXCD, r = nwg % NXCD, xcd = wgid % NXCD, off = wgid / NXCD; wgid = (xcd < r ? xcd * (q + 1) : r * (q + 1) + (xcd - r) * q) + off; }
        const int nig = WGM * nN, gid = wgid / nig, fm = gid * WGM, gsz = (nM - fm) < WGM ? (nM - fm) : WGM;
        u.pm = fm + ((wgid % nig) % gsz); u.pn = (wgid % nig) / gsz; u.ui = i;
        u.e = tileE ? __builtin_amdgcn_readfirstlane((int)tileE[u.pm]) : 0;
        return true;
    }
};

struct EpiProjX {
    static constexpr bool MIDK = false, BIASL = false;
    static constexpr bool PERM = true;
    bf16* O; const float* gq; const float* gk; float* SSG;
    __device__ __forceinline__ void operator()(const f32x4 (&acc)[2][2][4][2], const Unit& u, int wr, int wc, int fr, int fq) const {
        const int row0 = u.pm * BM + wr * 64 + fr, col0 = u.pn * BM + wc * 64 + 8 * fq, kind = u.pn >> 2;
        if (kind <= 1) {
            const float* gp = (kind == 0 ? gq : gk) + 8 * fq; const float qs = kind == 0 ? 0.125f * 1.4426950408889634f : 1.0f;
            const f32x4 g00 = *(const f32x4*)(gp), g01 = *(const f32x4*)(gp + 4), g10 = *(const f32x4*)(gp + 32), g11 = *(const f32x4*)(gp + 36);
#pragma unroll
            for (int ai = 0; ai < 2; ++ai)
#pragma unroll
                for (int m = 0; m < 4; ++m) { const f32x4 a = acc[ai][0][m][0], b = acc[ai][0][m][1], c = acc[ai][1][m][0], d = acc[ai][1][m][1];
                    float ss = (a.x * a.x + a.y * a.y) + (a.z * a.z + a.w * a.w) + (b.x * b.x + b.y * b.y) + (b.z * b.z + b.w * b.w) + (c.x * c.x + c.y * c.y) + (c.z * c.z + c.w * c.w) + (d.x * d.x + d.y * d.y) + (d.z * d.z + d.w * d.w);
                    ss += __shfl_xor(ss, 16); ss += __shfl_xor(ss, 32);
                    const float r = qs / sqrtf(ss * (1.0f / 64.0f) + EPS);
                    const f32x4 oa = a * r * g00, ob = b * r * g01, oc = c * r * g10, od = d * r * g11;
                    bf16* rowp = O + (size_t)(row0 + ai * HALF + m * 16) * NPROJ + col0;
                    u32x4 w0, w1; w0.x = cvt_pk_bf16(oa.x, oa.y); w0.y = cvt_pk_bf16(oa.z, oa.w); w0.z = cvt_pk_bf16(ob.x, ob.y); w0.w = cvt_pk_bf16(ob.z, ob.w);
                    w1.x = cvt_pk_bf16(oc.x, oc.y); w1.y = cvt_pk_bf16(oc.z, oc.w); w1.z = cvt_pk_bf16(od.x, od.y); w1.w = cvt_pk_bf16(od.z, od.w);
                    *(u32x4*)(rowp) = w0; *(u32x4*)(rowp + 32) = w1; }
        } else if (kind == 2) {
#pragma unroll
            for (int ai = 0; ai < 2; ++ai)
#pragma unroll
                for (int m = 0; m < 4; ++m) { bf16* rowp = O + (size_t)(row0 + ai * HALF + m * 16) * NPROJ + col0;
#pragma unroll
                    for (int bj = 0; bj < 2; ++bj) { const f32x4 v0 = acc[ai][bj][m][0], v1 = acc[ai][bj][m][1];
                        u32x4 w; w.x = cvt_pk_bf16(v0[0], v0[1]); w.y = cvt_pk_bf16(v0[2], v0[3]); w.z = cvt_pk_bf16(v1[0], v1[1]); w.w = cvt_pk_bf16(v1[2], v1[3]);
                        *(u32x4*)(rowp + bj * 32) = w; } }
        } else {
#pragma unroll
            for (int ai = 0; ai < 2; ++ai)
#pragma unroll
                for (int m = 0; m < 4; ++m) { const int row = row0 + ai * HALF + m * 16; bf16* rowp = O + (size_t)row * NPROJ + col0; float ss = 0.f;
#pragma unroll
                    for (int bj = 0; bj < 2; ++bj) { const f32x4 v0 = acc[ai][bj][m][0], v1 = acc[ai][bj][m][1];
                        const f32x2 a = gelu_pk((f32x2){v0[0], v0[1]}), b = gelu_pk((f32x2){v0[2], v0[3]}), c = gelu_pk((f32x2){v1[0], v1[1]}), d = gelu_pk((f32x2){v1[2], v1[3]});
                        ss += (a.x * a.x + a.y * a.y) + (b.x * b.x + b.y * b.y) + (c.x * c.x + c.y * c.y) + (d.x * d.x + d.y * d.y);
                        u32x4 w; w.x = cvt_pk_bf16(a.x, a.y); w.y = cvt_pk_bf16(b.x, b.y); w.z = cvt_pk_bf16(c.x, c.y); w.w = cvt_pk_bf16(d.x, d.y);
                        *(u32x4*)(rowp + bj * 32) = w; }
                    if (kind == 4) { ss += __shfl_xor(ss, 16); ss += __shfl_xor(ss, 32); if (fq == 0) SSG[(size_t)row * 16 + (u.pn - 16) * 4 + wc] = ss; } }
        }
    }
};
struct EpiResid {
    static constexpr bool PERM = false, MIDK = true, BIASL = false;
    const float* base; float* out; int ldc; const float* RA; const float* RB; float* SSX;
    __device__ __forceinline__ void mid(f32x4 (&acc)[2][2][4][2], const Unit& u, int wr, int fr) const {
        const int row0 = u.pm * BM + wr * 64 + fr;
#pragma unroll
        for (int ai = 0; ai < 2; ++ai)
#pragma unroll
            for (int m = 0; m < 4; ++m) { int row = row0 + ai * HALF + m * 16; asm volatile("" : "+v"(row));
                const float f = RA[row] / RB[row];
#pragma unroll
                for (int bj = 0; bj < 2; ++bj)
#pragma unroll
                    for (int n = 0; n < 2; ++n) acc[ai][bj][m][n] = acc[ai][bj][m][n] * f; }
    }
    static __device__ __forceinline__ f32x4 ror8(f32x4 v) { f32x4 r;
#pragma unroll
        for (int i = 0; i < 4; ++i) r[i] = __int_as_float(__builtin_amdgcn_update_dpp(0, __float_as_int(v[i]), 0x128, 0xf, 0xf, false)); return r; }
    __device__ __forceinline__ void operator()(const f32x4 (&acc)[2][2][4][2], const Unit& u, int wr, int wc, int fr, int fq) const {
        const bool lo = fr < 8; const int r7 = fr & 7;
        const int rowX0 = u.pm * BM + wr * 64 + r7, col0 = u.pn * BM + wc * 32 + (fr >> 3) * 16 + 4 * fq;
#pragma unroll
        for (int ai = 0; ai < 2; ++ai) {
            f32x4 rX[4][2], rY[4][2]; float rbX[4], rbY[4];
#pragma unroll
            for (int m = 0; m < 4; ++m) { const int row = rowX0 + ai * HALF + m * 16; const size_t off = (size_t)row * ldc + col0; rbX[m] = RB[row]; rbY[m] = RB[row + 8];
#pragma unroll
                for (int bj = 0; bj < 2; ++bj) { rX[m][bj] = *(const f32x4*)(base + off + bj * HALF); rY[m][bj] = *(const f32x4*)(base + off + (size_t)8 * ldc + bj * HALF); } }
#pragma unroll
            for (int m = 0; m < 4; ++m) { const int row = rowX0 + ai * HALF + m * 16; const size_t off = (size_t)row * ldc + col0;
                float ssX = 0.f, ssY = 0.f;
#pragma unroll
                for (int bj = 0; bj < 2; ++bj) { const f32x4 v0 = acc[ai][bj][m][0], v1 = acc[ai][bj][m][1];
                    const f32x4 got = ror8(lo ? v1 : v0);
                    const f32x4 dX = lo ? v0 : got, dY = lo ? got : v1;
                    const f32x4 oX = rX[m][bj] + dX * rbX[m], oY = rY[m][bj] + dY * rbY[m];
                    *(f32x4*)(out + off + bj * HALF) = oX; *(f32x4*)(out + off + (size_t)8 * ldc + bj * HALF) = oY;
                    ssX += (oX.x * oX.x + oX.y * oX.y) + (oX.z * oX.z + oX.w * oX.w); ssY += (oY.x * oY.x + oY.y * oY.y) + (oY.z * oY.z + oY.w * oY.w); }
                ssX += __shfl_xor(ssX, 16); ssX += __shfl_xor(ssX, 32); ssX += __shfl_xor(ssX, 8);
                ssY += __shfl_xor(ssY, 16); ssY += __shfl_xor(ssY, 32); ssY += __shfl_xor(ssY, 8);
                SSX[(size_t)row * 32 + u.pn * 4 + wc] = ssX; SSX[(size_t)(row + 8) * 32 + u.pn * 4 + wc] = ssY; }
        }
    }
};
struct EpiSwiglu {
    static constexpr bool MIDK = false, BIASL = true;
    static constexpr bool PERM = true;
    unsigned char* act; const float* bgu; const LAS float* biasL; unsigned biasA;
    __device__ __forceinline__ void prefetch(const Unit& u, int wid, int lane) const {
        if (wid == 0) glds16(bgu + (size_t)u.e * 4096 + u.pn * 128 + (lane & 31) * 4 + (lane >> 5) * 2048, biasA + (unsigned)(u.ui & 1) * 1024u); }
    __device__ __forceinline__ void operator()(const f32x4 (&acc)[2][2][4][2], const Unit& u, int wr, int wc, int fr, int fq) const {
        const int jl = wc * 32 + 8 * (2 * (fq & 1) + (fq >> 1));
        const LAS float* bp = biasL + (u.ui & 1) * 256 + jl;
        const f32x4 bg0 = *(const LAS f32x4*)(bp), bg1 = *(const LAS f32x4*)(bp + 4), bl0 = *(const LAS f32x4*)(bp + 128) + 1.0f, bl1 = *(const LAS f32x4*)(bp + 132) + 1.0f;
        const float rs = 1.0f / 64.0f;
        const int hi32 = fq >> 1;
        unsigned char* obase = act + (size_t)(u.pm * BM + wr * 64 + fr) * 2048 + u.pn * 128 + wc * 32 + 16 * (fq & 1);
#pragma unroll
        for (int ai = 0; ai < 2; ++ai)
#pragma unroll
            for (int mp = 0; mp < 2; ++mp) {
                unsigned wv[2][2];
#pragma unroll
                for (int r2 = 0; r2 < 2; ++r2) { const int m = 2 * mp + r2;
#pragma unroll
                    for (int n = 0; n < 2; ++n) { const f32x4 ag = acc[ai][0][m][n], al = acc[ai][1][m][n], bg = n ? bg1 : bg0, bl = n ? bl1 : bl0; f32x2 o2[2];
#pragma unroll
                        for (int hq = 0; hq < 2; ++hq) {
                            f32x2 g = (f32x2){ag[2 * hq], ag[2 * hq + 1]} * rs + (f32x2){bg[2 * hq], bg[2 * hq + 1]};
                            f32x2 l = (f32x2){al[2 * hq], al[2 * hq + 1]} * rs + (f32x2){bl[2 * hq], bl[2 * hq + 1]};
                            g.x = fminf(g.x, 7.0f); g.y = fminf(g.y, 7.0f);
                            l.x = __builtin_amdgcn_fmed3f(l.x, -6.0f, 8.0f); l.y = __builtin_amdgcn_fmed3f(l.y, -6.0f, 8.0f);
                            const f32x2 z = g * (-1.702f * 1.4426950408889634f);
                            f32x2 e; e.x = __builtin_amdgcn_exp2f(z.x); e.y = __builtin_amdgcn_exp2f(z.y);
                            const f32x2 d = e + 1.0f; f32x2 r; r.x = __builtin_amdgcn_rcpf(d.x); r.y = __builtin_amdgcn_rcpf(d.y);
                            o2[hq] = (g * r) * l; }
                        wv[r2][n] = pk4_fp8(o2[0].x, o2[0].y, o2[1].x, o2[1].y); } }
                const auto s0 = __builtin_amdgcn_permlane32_swap(wv[0][0], wv[1][0], false, false), s1 = __builtin_amdgcn_permlane32_swap(wv[0][1], wv[1][1], false, false);
                u32x4 w; w.x = s0[0]; w.y = s1[0]; w.z = s0[1]; w.w = s1[1];
                *(u32x4*)(obase + (size_t)(ai * HALF + (2 * mp + hi32) * 16) * 2048) = w; }
    }
};
struct EpiDown {
    static constexpr bool MIDK = false, BIASL = true;
    static constexpr bool PERM = true;
    unsigned char* Y; const float* bdn; const LAS unsigned* dstL; const LAS float* biasL; unsigned biasA;
    __device__ __forceinline__ void prefetch(const Unit& u, int wid, int lane) const {
        if (wid == 0) glds16(bdn + (size_t)u.e * 2048 + u.pn * 256 + lane * 4, biasA + (unsigned)(u.ui & 1) * 1024u); }
    __device__ __forceinline__ void operator()(const f32x4 (&acc)[2][2][4][2], const Unit& u, int wr, int wc, int fr, int fq) const {
        const int col0 = u.pn * BM + wc * 64 + 16 * fq;
        const LAS float* bp = biasL + (u.ui & 1) * 256 + wc * 64 + 16 * fq;
        f32x4 bv[2][2];
#pragma unroll
        for (int bj = 0; bj < 2; ++bj)
#pragma unroll
            for (int n = 0; n < 2; ++n) bv[bj][n] = *(const LAS f32x4*)(bp + 8 * bj + 4 * n);
#pragma unroll
        for (int ai = 0; ai < 2; ++ai)
#pragma unroll
            for (int m = 0; m < 4; ++m) { const unsigned dst = dstL[u.ui * 256 + ai * HALF + wr * 64 + m * 16 + fr];
                const f32x4 v00 = acc[ai][0][m][0] * (1.0f / 64.0f) + bv[0][0], v01 = acc[ai][0][m][1] * (1.0f / 64.0f) + bv[0][1], v10 = acc[ai][1][m][0] * (1.0f / 64.0f) + bv[1][0], v11 = acc[ai][1][m][1] * (1.0f / 64.0f) + bv[1][1];
                u32x4 w; w.x = pk4_fp8(v00[0], v00[1], v00[2], v00[3]); w.y = pk4_fp8(v01[0], v01[1], v01[2], v01[3]); w.z = pk4_fp8(v10[0], v10[1], v10[2], v10[3]); w.w = pk4_fp8(v11[0], v11[1], v11[2], v11[3]);
                *(u32x4*)(Y + (size_t)dst * 2048 + col0) = w; }
    }
};

template <class Epi, bool GATHER, bool ALIGN_EPI, bool FP8>
__device__ __forceinline__ void gemm_phase(LAS unsigned char* lds, const char* Abase, const char* Bbase, size_t estrideB, int KB, const TileOrder& S, const Epi& E, const LAS unsigned short* tokL) {
    const int tid = threadIdx.x, wid = __builtin_amdgcn_readfirstlane(tid >> 6), lane = tid & 63, wr = wid >> 2, wc = wid & 3, fr = lane & 15, fq = lane >> 4;
    const int nt = KB / 128;
    int Rr[2], Cc[2]; unsigned voffB[2], vA[2][2];
#pragma unroll
    for (int i = 0; i < 2; ++i) { int R, C; stage_rc(tid * 16 + i * 8192, R, C); const int Rb = Epi::PERM ? ((R & ~31) + perm32(R & 31)) : R;
        Rr[i] = R; Cc[i] = C; voffB[i] = (unsigned)(Rb * KB + C * 2); }
    const size_t kstep = (size_t)128;
    const size_t hstep = (size_t)HALF * KB;
    const size_t tstep = 2 * hstep;
    const unsigned ldsw = (unsigned)wid * 1024u;
    const int aoff = lds_byte(wr * 64 + fr, fq * 8), boff = lds_byte(wc * 32 + fr, fq * 8);
#define PG8_SA(b, h) (((b) * 2 + (h)) * HTB)
#define PG8_SB(b, h) ((4 + (b) * 2 + (h)) * HTB)
#define PG8_STAGE(bufoff, gbase, voff) do { _Pragma("unroll") for (int _i = 0; _i < 2; ++_i) \
        __builtin_amdgcn_global_load_lds((const GAS unsigned*)((const char*)(gbase) + (voff)[_i]), (LAS unsigned*)(lds + (bufoff) + ldsw + _i * 8192), 16, 0, 0); } while (0)
#define PG8_LDA(dst, b, h) do { _Pragma("unroll") for (int m = 0; m < 4; ++m) dst[m] = __builtin_shufflevector(*(const LAS v4i*)(lds + PG8_SA(b, h) + aoff + m * 2048), *(const LAS v4i*)(lds + PG8_SA(b, h) + aoff + m * 2048 + 1024), 0, 1, 2, 3, 4, 5, 6, 7); } while (0)
#define PG8_LDB(dst, b, h) do { _Pragma("unroll") for (int n = 0; n < 2; ++n) dst[n] = __builtin_shufflevector(*(const LAS v4i*)(lds + PG8_SB(b, h) + boff + n * 2048), *(const LAS v4i*)(lds + PG8_SB(b, h) + boff + n * 2048 + 1024), 0, 1, 2, 3, 4, 5, 6, 7); } while (0)
#define PG8_MMA(ai, bj, At, Bt) do { __builtin_amdgcn_s_setprio(1); _Pragma("unroll") for (int m = 0; m < 4; ++m) _Pragma("unroll") for (int n = 0; n < 2; ++n) { \
        if constexpr (FP8) acc[ai][bj][m][n] = __builtin_amdgcn_mfma_scale_f32_16x16x128_f8f6f4(Bt[n], At[m], acc[ai][bj][m][n], 0, 0, 0, 0x7f7f7f7f, 0, 0x7f7f7f7f); \
        else { acc[ai][bj][m][n] = __builtin_amdgcn_mfma_f32_16x16x32_bf16(lo8(Bt[n]), lo8(At[m]), acc[ai][bj][m][n], 0, 0, 0); acc[ai][bj][m][n] = __builtin_amdgcn_mfma_f32_16x16x32_bf16(hi8(Bt[n]), hi8(At[m]), acc[ai][bj][m][n], 0, 0, 0); } } __builtin_amdgcn_s_setprio(0); } while (0)
#define PG8_WAIT_V(n) asm volatile("s_waitcnt vmcnt(" #n ")" ::: "memory")
#define PG8_WAIT_L(n) asm volatile("s_waitcnt lgkmcnt(" #n ")" ::: "memory")
#define PG8_BAR __builtin_amdgcn_s_barrier()
#define PG8_SCHED __builtin_amdgcn_sched_barrier(0)
#define PG8_SETVA(u) do { _Pragma("unroll") for (int _h = 0; _h < 2; ++_h) _Pragma("unroll") for (int _i = 0; _i < 2; ++_i) { \
        const int _row = GATHER ? (int)tokL[(u).ui * 256 + _h * HALF + Rr[_i]] : (_h * HALF + Rr[_i]); vA[_h][_i] = (unsigned)(_row * KB + Cc[_i] * 2); asm volatile("" : "+v"(vA[_h][_i])); } } while (0)
    Unit cur, nxt; int ui = 0;
    if (!S.next(0, cur)) return;
    f32x4 acc[2][2][4][2];
#pragma unroll
    for (int a = 0; a < 2; ++a)
#pragma unroll
        for (int b = 0; b < 2; ++b)
#pragma unroll
            for (int m = 0; m < 4; ++m)
#pragma unroll
                for (int n = 0; n < 2; ++n) acc[a][b][m][n] = (f32x4){0.f, 0.f, 0.f, 0.f};
    v8i At[4], B0[2], B1[2];
    const char* cA = GATHER ? Abase : Abase + (size_t)cur.pm * tstep;
    const char* cB = Bbase + (size_t)cur.e * estrideB + (size_t)cur.pn * tstep;
    PG8_SETVA(cur);
    if constexpr (Epi::BIASL) E.prefetch(cur, wid, lane);
    PG8_STAGE(PG8_SB(0, 0), cB, voffB); PG8_STAGE(PG8_SB(0, 1), cB + hstep, voffB); PG8_STAGE(PG8_SA(0, 0), cA, vA[0]); PG8_STAGE(PG8_SA(0, 1), cA, vA[1]);
    if (wr == 1) PG8_BAR;
    PG8_WAIT_V(2); PG8_BAR;
    PG8_STAGE(PG8_SB(1, 0), cB + kstep, voffB); PG8_STAGE(PG8_SA(1, 0), cA + kstep, vA[0]); PG8_STAGE(PG8_SB(1, 1), cB + hstep + kstep, voffB);
    PG8_WAIT_V(6); PG8_BAR;
    for (;;) {
        const bool has_next = S.next(ui + 1, nxt);
        const char* nA = has_next ? (GATHER ? Abase : Abase + (size_t)nxt.pm * tstep) : cA;
        const char* nB = has_next ? Bbase + (size_t)nxt.e * estrideB + (size_t)nxt.pn * tstep : cB;
        for (int t = 0; t < nt; t += 2) {
            if constexpr (Epi::MIDK) { if (t == nt / 2) E.mid(acc, cur, wr, fr); }
            const bool last = (t == nt - 2);
            const char* a1 = cA + (size_t)(t + 1) * kstep;
            const char* a2 = last ? nA : cA + (size_t)(t + 2) * kstep; const char* b2 = last ? nB : cB + (size_t)(t + 2) * kstep;
            const char* a3 = a2 + kstep; const char* b3 = b2 + kstep;
            PG8_LDB(B0, 0, 0); PG8_LDB(B1, 0, 1); PG8_SCHED; PG8_LDA(At, 0, 0); PG8_STAGE(PG8_SA(1, 1), a1, vA[1]);
            if (last && has_next) PG8_SETVA(nxt);
            PG8_WAIT_V(8); PG8_WAIT_L(0); PG8_BAR; PG8_MMA(0, 0, At, B0); PG8_MMA(0, 1, At, B1); PG8_BAR; PG8_SCHED;
            PG8_LDA(At, 0, 1); PG8_STAGE(PG8_SB(0, 0), b2, voffB); PG8_STAGE(PG8_SB(0, 1), b2 + hstep, voffB); PG8_STAGE(PG8_SA(0, 0), a2, vA[0]);
            PG8_WAIT_V(8); PG8_WAIT_L(0); PG8_BAR; PG8_MMA(1, 0, At, B0); PG8_MMA(1, 1, At, B1); PG8_BAR; PG8_SCHED;
            PG8_LDB(B0, 1, 0); PG8_LDB(B1, 1, 1); PG8_SCHED; PG8_LDA(At, 1, 0); PG8_STAGE(PG8_SA(0, 1), a2, vA[1]);
            PG8_WAIT_V(8); PG8_WAIT_L(0); PG8_BAR; PG8_MMA(0, 0, At, B0); PG8_MMA(0, 1, At, B1); PG8_BAR; PG8_SCHED;
            PG8_LDA(At, 1, 1); PG8_STAGE(PG8_SB(1, 0), b3, voffB); PG8_STAGE(PG8_SB(1, 1), b3 + hstep, voffB); PG8_STAGE(PG8_SA(1, 0), a3, vA[0]);
            PG8_WAIT_V(8); PG8_WAIT_L(0); PG8_BAR; PG8_MMA(1, 0, At, B0); PG8_MMA(1, 1, At, B1); PG8_BAR; PG8_SCHED;
        }
        if constexpr (ALIGN_EPI) { if (wr == 0) PG8_BAR; }
        E(acc, cur, wr, wc, fr, fq);
        if (!has_next) break;
#pragma unroll
        for (int a = 0; a < 2; ++a)
#pragma unroll
            for (int b = 0; b < 2; ++b)
#pragma unroll
                for (int m = 0; m < 4; ++m)
#pragma unroll
                    for (int n = 0; n < 2; ++n) acc[a][b][m][n] = (f32x4){0.f, 0.f, 0.f, 0.f};
        cur = nxt; cA = nA; cB = nB; ++ui;
        if constexpr (Epi::BIASL) E.prefetch(cur, wid, lane);
        if constexpr (ALIGN_EPI) { if (wr == 1) PG8_BAR; }
    }
    PG8_WAIT_V(0);
    if constexpr (!ALIGN_EPI) { if (wr == 0) PG8_BAR; }
    PG8_BAR;
#undef PG8_SA
#undef PG8_SB
#undef PG8_STAGE
#undef PG8_LDA
#undef PG8_LDB
#undef PG8_MMA
#undef PG8_WAIT_V
#undef PG8_WAIT_L
#undef PG8_BAR
#undef PG8_SCHED
#undef PG8_SETVA
}

struct Frame {
    LAS unsigned char* lds;
    volatile LAS unsigned* MISC;
    gu32* ctl;
    int tid, lane, wave, vcu, G;
    const float *x, *g1, *w_in, *gq, *gk, *rpb, *gsg, *w_sp, *b_sp, *ga, *gs, *w_out, *g2, *w_r, *b_r, *w_gu, *b_gu, *w_dn, *b_dn;
    float* out;
    bf16 *WIN, *WOUT, *WSP, *WRH, *WRL, *H, *PROJ, *MIX; unsigned char *WGU, *WDN, *ACT, *H8, *Y;
    float *RSTD2, *GATE, *SSQA, *SSG, *RA, *RB, *SSX; unsigned* SLOT; int* LIST;
};

__device__ __forceinline__ void p0_transpose_item(const float* W, int N, int K, bf16* WT, int k0, int n0, int out_row0, int hi_off, const float* kgain, LAS float* scr, int lane) {
    const int l16 = lane & 15, lq = lane >> 4;
#pragma unroll 4
    for (int i = 0; i < 16; ++i) { const int kk = 4 * i + lq; f32x4 v = *(const f32x4*)(W + (size_t)(k0 + kk) * N + n0 + 4 * l16); if (kgain) v = v * kgain[k0 + kk];
        LAS float* d = scr + kk * 65 + 4 * l16; d[0] = v.x; d[1] = v.y; d[2] = v.z; d[3] = v.w; }
    LDS_WAIT(); asm volatile("" ::: "memory");
    const int c = lane >> 3, nn = lane & 7;
#pragma unroll
    for (int j = 0; j < 8; ++j) { const int n = nn + 8 * j; const LAS float* s = scr + (8 * c) * 65 + n;
        u32x4 o; o.x = cvt_pk_bf16(s[0], s[65]); o.y = cvt_pk_bf16(s[2 * 65], s[3 * 65]); o.z = cvt_pk_bf16(s[4 * 65], s[5 * 65]); o.w = cvt_pk_bf16(s[6 * 65], s[7 * 65]);
        *(u32x4*)(WT + (size_t)(out_row0 + n + (n >= 32 ? hi_off : 0)) * K + k0 + 8 * c) = o; }
    LDS_WAIT(); asm volatile("" ::: "memory");
}
__device__ __forceinline__ void p0_transpose_item_fp8(const float* W, int N, int K, unsigned char* WT, int k0, int n0, int out_row0, LAS float* scr, int lane) {
    const int l8 = lane & 7, lr = lane >> 3;
#pragma unroll 4
    for (int i = 0; i < 16; ++i) { const int kk = 8 * i + lr; const f32x4 v = *(const f32x4*)(W + (size_t)(k0 + kk) * N + n0 + 4 * l8);
        LAS float* d = scr + kk * 33 + 4 * l8; d[0] = v.x; d[1] = v.y; d[2] = v.z; d[3] = v.w; }
    LDS_WAIT(); asm volatile("" ::: "memory");
    const int n = lane & 31, kh = lane >> 5; const LAS float* s = scr + (64 * kh) * 33 + n;
#pragma unroll
    for (int c4 = 0; c4 < 4; ++c4) { u32x4 o;
        o.x = pk4_fp8(s[(16 * c4 + 0) * 33] * 64.f, s[(16 * c4 + 1) * 33] * 64.f, s[(16 * c4 + 2) * 33] * 64.f, s[(16 * c4 + 3) * 33] * 64.f);
        o.y = pk4_fp8(s[(16 * c4 + 4) * 33] * 64.f, s[(16 * c4 + 5) * 33] * 64.f, s[(16 * c4 + 6) * 33] * 64.f, s[(16 * c4 + 7) * 33] * 64.f);
        o.z = pk4_fp8(s[(16 * c4 + 8) * 33] * 64.f, s[(16 * c4 + 9) * 33] * 64.f, s[(16 * c4 + 10) * 33] * 64.f, s[(16 * c4 + 11) * 33] * 64.f);
        o.w = pk4_fp8(s[(16 * c4 + 12) * 33] * 64.f, s[(16 * c4 + 13) * 33] * 64.f, s[(16 * c4 + 14) * 33] * 64.f, s[(16 * c4 + 15) * 33] * 64.f);
        *(u32x4*)(WT + (size_t)(out_row0 + n) * K + k0 + 64 * kh + 16 * c4) = o; }
    LDS_WAIT(); asm volatile("" ::: "memory");
}
__device__ __forceinline__ void moe_convert(Frame& F, int j0, int j1) {
    LAS float* img = (LAS float*)F.lds;
    constexpr int T_GU = 16 * 16, T_DN = 16 * 8, NT = NE * (T_GU + T_DN);
    const int w = F.wave, lane = F.lane;
    f32x4 v[16];
#define P0_DECODE(t, W_, N_, WT_, k0_, n0_, isgu_) do { int r_ = (t); if (r_ < NE * T_GU) { const int e_ = r_ / T_GU, q_ = r_ % T_GU; W_ = F.w_gu + (size_t)e_ * DM * 4096; N_ = 4096; WT_ = F.WGU + (size_t)e_ * 4096 * DM; k0_ = 128 * (q_ / 16); n0_ = 256 * (q_ % 16); isgu_ = 1; } \
        else { r_ -= NE * T_GU; const int e_ = r_ / T_DN, q_ = r_ % T_DN; W_ = F.w_dn + (size_t)e_ * DM * DM; N_ = DM; WT_ = F.WDN + (size_t)e_ * DM * DM; k0_ = 128 * (q_ / 8); n0_ = 256 * (q_ % 8); isgu_ = 0; } } while (0)
#define P0_LOAD(W_, N_, k0_, n0_) do { _Pragma("unroll") for (int i = 0; i < 16; ++i) v[i] = __builtin_nontemporal_load((const f32x4*)(W_ + (size_t)(k0_ + 16 * w + i) * N_ + n0_ + 4 * lane)); } while (0)
    int j = j0, t = F.vcu + j0 * F.G;
    const float* W = nullptr; unsigned char* WT = nullptr; int N = 0, k0 = 0, n0 = 0, isgu = 0;
    if (j < j1 && t < NT) { P0_DECODE(t, W, N, WT, k0, n0, isgu); P0_LOAD(W, N, k0, n0); }
    while (j < j1 && t < NT) {
#pragma unroll
        for (int i = 0; i < 16; ++i) *(LAS f32x4*)(img + (16 * w + i) * 260 + 4 * lane) = v[i];
        __syncthreads();
        const int tn = t + F.G; const float* Wn = nullptr; unsigned char* WTn = nullptr; int Nn = 0, k0n = 0, n0n = 0, isgun = 0;
        if (j + 1 < j1 && tn < NT) { P0_DECODE(tn, Wn, Nn, WTn, k0n, n0n, isgun); P0_LOAD(Wn, Nn, k0n, n0n); }
        { const int n = 32 * w + (lane & 31), kh = lane >> 5; const LAS float* sp = img + (64 * kh) * 260 + n;
          const int nn = n0 + n; const int ll = nn & 255;
          const int jl = nn & 127, g8 = (jl >> 3) & 3;
          const int orow = isgu ? (((nn & 2047) >> 7) * 256 + (nn >> 11) * 128 + (jl & ~31) + 8 * (2 * (g8 & 1) + (g8 >> 1)) + (jl & 7)) : ((nn & ~255) + 128 * ((ll >> 3) & 1) + 32 * (ll >> 6) + 8 * ((ll >> 4) & 3) + (ll & 7));
          unsigned char* dst = WT + (size_t)orow * DM + k0 + 64 * kh;
#pragma unroll
          for (int c4 = 0; c4 < 4; ++c4) { u32x4 o;
              o.x = pk4_fp8(sp[(16 * c4 + 0) * 260] * 64.f, sp[(16 * c4 + 1) * 260] * 64.f, sp[(16 * c4 + 2) * 260] * 64.f, sp[(16 * c4 + 3) * 260] * 64.f);
              o.y = pk4_fp8(sp[(16 * c4 + 4) * 260] * 64.f, sp[(16 * c4 + 5) * 260] * 64.f, sp[(16 * c4 + 6) * 260] * 64.f, sp[(16 * c4 + 7) * 260] * 64.f);
              o.z = pk4_fp8(sp[(16 * c4 + 8) * 260] * 64.f, sp[(16 * c4 + 9) * 260] * 64.f, sp[(16 * c4 + 10) * 260] * 64.f, sp[(16 * c4 + 11) * 260] * 64.f);
              o.w = pk4_fp8(sp[(16 * c4 + 12) * 260] * 64.f, sp[(16 * c4 + 13) * 260] * 64.f, sp[(16 * c4 + 14) * 260] * 64.f, sp[(16 * c4 + 15) * 260] * 64.f);
              __builtin_nontemporal_store(o, (u32x4*)(dst + 16 * c4)); } }
        __syncthreads();
        ++j; t = tn; W = Wn; WT = WTn; N = Nn; k0 = k0n; n0 = n0n; isgu = isgun;
    }
#undef P0_DECODE
#undef P0_LOAD
}
__device__ __forceinline__ void p0_prologue(Frame& F) {
    LAS float* scr = (LAS float*)(F.lds + F.wave * 16896);
    const int gw = F.vcu * NWAVES + F.wave, NGW = F.G * NWAVES, lane = F.lane;
    constexpr int I_IN = 32 * 80, I_OUT = 32 * 32;
    constexpr int NITEMS = I_IN + I_OUT;
    for (int it = gw; it < NITEMS; it += NGW) {
        int r = it;
        if (r < I_IN) { const int kb = r / 80, nb = r % 80; p0_transpose_item(F.w_in, NPROJ, DM, F.WIN, 64 * kb, 64 * nb, (nb >> 2) * 256 + (nb & 3) * 32, 96, nullptr, scr, lane); continue; } r -= I_IN;
        { const int kb = r / 32, nb = r % 32; p0_transpose_item(F.w_out, DM, DM, F.WOUT, 64 * kb, 64 * nb, 64 * nb, 0, kb < 16 ? F.ga : F.gs - 1024, scr, lane); }
    }
    {
        f32x4 g1v[8];
#pragma unroll
        for (int j = 0; j < 4; ++j) { g1v[2 * j] = *(const f32x4*)(F.g1 + 8 * lane + 512 * j); g1v[2 * j + 1] = *(const f32x4*)(F.g1 + 8 * lane + 512 * j + 4); }
        for (int m = gw; m < NTOK; m += 2 * NGW) {
            const int m2 = m + NGW; const bool has2 = m2 < NTOK;
            const float* xr = F.x + (size_t)m * DM + 8 * lane; const float* xr2 = F.x + (size_t)(has2 ? m2 : m) * DM + 8 * lane;
            f32x4 v[8], u[8]; float s = 0.f, s2 = 0.f;
#pragma unroll
            for (int j = 0; j < 4; ++j) { v[2 * j] = __builtin_nontemporal_load((const f32x4*)(xr + 512 * j)); v[2 * j + 1] = __builtin_nontemporal_load((const f32x4*)(xr + 512 * j + 4)); u[2 * j] = __builtin_nontemporal_load((const f32x4*)(xr2 + 512 * j)); u[2 * j + 1] = __builtin_nontemporal_load((const f32x4*)(xr2 + 512 * j + 4)); }
#pragma unroll
            for (int j = 0; j < 8; ++j) { s += (v[j].x * v[j].x + v[j].y * v[j].y) + (v[j].z * v[j].z + v[j].w * v[j].w); s2 += (u[j].x * u[j].x + u[j].y * u[j].y) + (u[j].z * u[j].z + u[j].w * u[j].w); }
            const float rs = 1.0f / sqrtf(wave_sum(s) * (1.0f / DM) + EPS), rs2 = 1.0f / sqrtf(wave_sum(s2) * (1.0f / DM) + EPS);
#pragma unroll
            for (int j = 0; j < 4; ++j) { const f32x4 a = v[2 * j] * rs * g1v[2 * j], b = v[2 * j + 1] * rs * g1v[2 * j + 1]; u32x4 o; o.x = cvt_pk_bf16(a.x, a.y); o.y = cvt_pk_bf16(a.z, a.w); o.z = cvt_pk_bf16(b.x, b.y); o.w = cvt_pk_bf16(b.z, b.w);
                *(u32x4*)(F.H + (size_t)m * DM + 8 * lane + 512 * j) = o; }
            if (has2) {
#pragma unroll
                for (int j = 0; j < 4; ++j) { const f32x4 a = u[2 * j] * rs2 * g1v[2 * j], b = u[2 * j + 1] * rs2 * g1v[2 * j + 1]; u32x4 o; o.x = cvt_pk_bf16(a.x, a.y); o.y = cvt_pk_bf16(a.z, a.w); o.z = cvt_pk_bf16(b.x, b.y); o.w = cvt_pk_bf16(b.z, b.w);
                    *(u32x4*)(F.H + (size_t)m2 * DM + 8 * lane + 512 * j) = o; } }
        }
    }
    const int gt = F.vcu * 512 + F.tid, NGT = F.G * 512;
    for (int i = gt; i < 16 * 128 * 128; i += NGT) { const float v = F.w_sp[i]; F.WSP[i] = (bf16)(cvt_pk_bf16(v, 0.f) & 0xffffu); }
    for (int i = gt; i < NE * DM; i += NGT) { const int e = i / DM, d = i % DM; const float v = F.w_r[(size_t)d * NE + e]; const unsigned hi = cvt_pk_bf16(v, 0.f) & 0xffffu; const float lo = v - __uint_as_float(hi << 16);
        F.WRH[i] = (bf16)hi; F.WRL[i] = (bf16)(cvt_pk_bf16(lo, 0.f) & 0xffffu); }
}

typedef short v4i16_t __attribute__((ext_vector_type(4)));
__device__ __forceinline__ s16x4 tr_read(const LAS unsigned char* p) { return __builtin_bit_cast(s16x4, __builtin_amdgcn_ds_read_tr16_b64_v4i16((LAS v4i16_t*)p)); }
__device__ __forceinline__ void attn_unit(Frame& F, int b, int h, int band) {
    constexpr int SLOT = 16384;
    LAS unsigned char* ring = F.lds;
    LAS float* rpbL = (LAS float*)(F.lds + AT_RPB);
    LAS unsigned* mrg = (LAS unsigned*)(F.lds + AT_MRG);
    const int tid = F.tid, lane = F.lane, w = F.wave, fr = lane & 15, quad = lane >> 4;
    const int cg = w & 3, hf8 = w >> 2;
    const int c0 = 16 * cg, w0 = (cg == 0) ? 0 : (cg == 1) ? 8 : (cg == 2) ? 24 : 32;
    const int qc = c0 + fr; const int cs = min(max(qc - 8, 0), 48);
    const int R0 = band * 16;
    __syncthreads();
    for (int i = tid; i < 480; i += 512) { const int ro = i >> 5, co = i & 31; rpbL[i] = co < 31 ? F.rpb[h * 465 + ro * 31 + co] * 1.4426950408889634f : -INFINITY; }
    int cooff[2][4];
#pragma unroll
    for (int hf = 0; hf < 2; ++hf)
#pragma unroll
        for (int i = 0; i < 4; ++i) { const int kc = w0 + 16 * hf + 4 * quad + i; const bool valid = (kc >= cs) && (kc < cs + 16); cooff[hf][i] = 4 * (valid ? kc - qc + 15 : 31); }
    const char* projb = (const char*)F.PROJ + (size_t)b * SEQ * NPROJ * 2; const unsigned ringb = (unsigned)(size_t)ring;
    const unsigned lane_src = (unsigned)((8 * w + (lane >> 3)) * NPROJ + 1024 + h * 64) * 2u + (unsigned)(((lane & 7) ^ (lane >> 3)) * 16);
#define ROW_DMA(rowabs) do { const char* src_ = projb + (size_t)(rowabs) * 64 * NPROJ * 2 + lane_src; const unsigned sb_ = ringb + (unsigned)(((rowabs) % 9) * SLOT + w * 1024); \
        glds16(src_, sb_); glds16(src_ + 2048, sb_ + 8192u); } while (0)
    const int rs0 = min(max(R0 - 4, 0), 120);
    for (int j = 0; j < 8; ++j) ROW_DMA(rs0 + j);
    int loaded_hi = rs0 + 7;
    const bf16* qbase = F.PROJ + ((size_t)b * SEQ + qc) * NPROJ + h * 64 + 8 * quad;
    bf16x8 qa = *(const bf16x8*)(qbase + (size_t)R0 * 64 * NPROJ), qb = *(const bf16x8*)(qbase + (size_t)R0 * 64 * NPROJ + 32);
    VM_WAIT(); __syncthreads();
    for (int step = 0; step < 16; ++step) {
        const int r = R0 + step, rs = min(max(r - 4, 0), 120);
        bf16x8 qf0 = qa, qf1 = qb;
        if (step < 15) { const int nh = min(max(r - 3, 0), 120) + 7; if (nh > loaded_hi) { ROW_DMA(nh); loaded_hi = nh; }
            qa = *(const bf16x8*)(qbase + (size_t)(r + 1) * 64 * NPROJ); qb = *(const bf16x8*)(qbase + (size_t)(r + 1) * 64 * NPROJ + 32); }
        f32x4 s[4][2];
#pragma unroll
        for (int kr = 0; kr < 4; ++kr) { const int sb = ((rs + 4 * hf8 + kr) % 9) * SLOT;
#pragma unroll
            for (int hf = 0; hf < 2; ++hf) { const int key = w0 + 16 * hf + fr;
                const bf16x8 a0 = *(const LAS bf16x8*)(ring + sb + key * 128 + ((quad ^ (key & 7)) << 4));
                const bf16x8 a1 = *(const LAS bf16x8*)(ring + sb + key * 128 + (((quad + 4) ^ (key & 7)) << 4));
                f32x4 z = {0.f, 0.f, 0.f, 0.f};
                z = __builtin_amdgcn_mfma_f32_16x16x32_bf16(a0, qf0, z, 0, 0, 0);
                z = __builtin_amdgcn_mfma_f32_16x16x32_bf16(a1, qf1, z, 0, 0, 0);
                s[kr][hf] = z; } }
        float mx = -INFINITY;
        { const LAS unsigned char* bb = (const LAS unsigned char*)rpbL + (rs + 4 * hf8 - r + 7) * 128;
#pragma unroll
            for (int kr = 0; kr < 4; ++kr)
#pragma unroll
                for (int hf = 0; hf < 2; ++hf)
#pragma unroll
                    for (int i = 0; i < 4; ++i) { const float v = s[kr][hf][i] + *(const LAS float*)(bb + kr * 128 + cooff[hf][i]); s[kr][hf][i] = v; mx = fmaxf(mx, v); } }
        mx = fmaxf(mx, __shfl_xor(mx, 16)); mx = fmaxf(mx, __shfl_xor(mx, 32));
        float lsum = 0.f; bf16x8 pf[4];
#pragma unroll
        for (int kr = 0; kr < 4; ++kr) { float p[8];
#pragma unroll
            for (int i = 0; i < 8; ++i) { p[i] = __builtin_amdgcn_exp2f(s[kr][i >> 2][i & 3] - mx); lsum += p[i]; }
            u32x4 pk; pk.x = cvt_pk_bf16(p[0], p[1]); pk.y = cvt_pk_bf16(p[2], p[3]); pk.z = cvt_pk_bf16(p[4], p[5]); pk.w = cvt_pk_bf16(p[6], p[7]); pf[kr] = __builtin_bit_cast(bf16x8, pk); }
        lsum += __shfl_xor(lsum, 16); lsum += __shfl_xor(lsum, 32);
        f32x4 o[4];
#pragma unroll
        for (int dt = 0; dt < 4; ++dt) o[dt] = (f32x4){0.f, 0.f, 0.f, 0.f};
#pragma unroll
        for (int kr = 0; kr < 4; ++kr) { const int sb = ((rs + 4 * hf8 + kr) % 9) * SLOT + 8192; const int key = w0 + 4 * quad + (fr >> 2), pp = fr & 3;
#pragma unroll
            for (int dt = 0; dt < 4; ++dt) { const int c = 2 * dt + (pp >> 1); const int ad = sb + key * 128 + ((c ^ (key & 7)) << 4) + 8 * (pp & 1);
                const s16x4 lo = tr_read(ring + ad), hi = tr_read(ring + ad + 16 * 128);
                const bf16x8 vf = __builtin_shufflevector(lo, hi, 0, 1, 2, 3, 4, 5, 6, 7);
                o[dt] = __builtin_amdgcn_mfma_f32_16x16x32_bf16(vf, pf[kr], o[dt], 0, 0, 0); } }
        if (w >= 4) { LAS unsigned* m = mrg + (w - 4) * 640 + lane; m[0] = __float_as_uint(mx); m[64] = __float_as_uint(lsum);
#pragma unroll
            for (int dt = 0; dt < 4; ++dt) { m[(2 + 2 * dt) * 64] = cvt_pk_bf16(o[dt][0], o[dt][1]); m[(3 + 2 * dt) * 64] = cvt_pk_bf16(o[dt][2], o[dt][3]); } }
        __syncthreads();
        if (w < 4) { const LAS unsigned* m = mrg + w * 640 + lane; const float mx2 = __uint_as_float(m[0]), l2 = __uint_as_float(m[64]);
            const float mm = fmaxf(mx, mx2), a1 = __builtin_amdgcn_exp2f(mx - mm), a2 = __builtin_amdgcn_exp2f(mx2 - mm); const float inv = 1.0f / (lsum * a1 + l2 * a2);
            const float f1 = a1 * inv, f2 = a2 * inv; float ssq = 0.f;
            bf16* op = F.MIX + ((size_t)b * SEQ + (size_t)r * 64 + qc) * DM + h * 64 + 4 * quad;
            u32x2 pk[4];
#pragma unroll
            for (int dt = 0; dt < 4; ++dt) { const unsigned u0 = m[(2 + 2 * dt) * 64], u1 = m[(3 + 2 * dt) * 64];
                const float v0 = o[dt][0] * f1 + bflo(u0) * f2, v1 = o[dt][1] * f1 + bfhi(u0) * f2, v2 = o[dt][2] * f1 + bflo(u1) * f2, v3 = o[dt][3] * f1 + bfhi(u1) * f2;
                ssq += (v0 * v0 + v1 * v1) + (v2 * v2 + v3 * v3);
                pk[dt].x = cvt_pk_bf16(v0, v1); pk[dt].y = cvt_pk_bf16(v2, v3); }
            ssq += __shfl_xor(ssq, 16); ssq += __shfl_xor(ssq, 32);
            VM_WAIT();
#pragma unroll
            for (int dp = 0; dp < 2; ++dp) *(u32x4*)(op + 32 * dp + ((quad & 1) ? 12 : 0)) = pair16(pk[2 * dp], pk[2 * dp + 1]);
            if (quad == 0) F.SSQA[((size_t)b * SEQ + (size_t)r * 64 + qc) * 16 + h] = ssq; }
        else VM_WAIT();
        __syncthreads();
    }
#undef ROW_DMA
}

__device__ __forceinline__ void sgu_unit(Frame& F, int unit) {
    LAS unsigned char* Gn = F.lds;
    LAS float* rsG = (LAS float*)(F.lds + 16384);
    const int tid = F.tid, lane = F.lane, w = F.wave, fr = lane & 15, quad = lane >> 4;
    const size_t tk0 = (size_t)unit * 128;
    __syncthreads();
    if (tid < 128) { const f32x4* sp = (const f32x4*)(F.SSG + (tk0 + tid) * 16); const f32x4 a = sp[0], b2 = sp[1], c = sp[2], d = sp[3];
        const float ss = ((a.x + a.y) + (a.z + a.w)) + ((b2.x + b2.y) + (b2.z + b2.w)) + ((c.x + c.y) + (c.z + c.w)) + ((d.x + d.y) + (d.z + d.w)); rsG[tid] = 1.0f / sqrtf(ss * (1.0f / 1024.0f) + EPS); }
    else if (tid < 256) { const int q = tid - 128; const f32x4* sp = (const f32x4*)(F.SSQA + (tk0 + q) * 16); const f32x4 a = sp[0], b2 = sp[1], c = sp[2], d = sp[3];
        const float ss = ((a.x + a.y) + (a.z + a.w)) + ((b2.x + b2.y) + (b2.z + b2.w)) + ((c.x + c.y) + (c.z + c.w)) + ((d.x + d.y) + (d.z + d.w)); F.RA[tk0 + q] = 1.0f / sqrtf(ss * (1.0f / 1024.0f) + EPS); }
    float ssq = 0.f; const int p = 16 * w + fr;
    const bf16* gsrc0 = F.PROJ + (tk0 + (tid >> 3)) * NPROJ + 4096 + (tid & 7) * 8;
    const bf16* usrc = F.PROJ + (tk0 + p) * NPROJ + 3072 + 4 * quad;
    const bf16* wsrc = F.WSP + (size_t)p * 128 + 8 * quad;
    u32x4 gv0 = *(const u32x4*)(gsrc0), gv1 = *(const u32x4*)(gsrc0 + (size_t)64 * NPROJ);
    u32x2 uv[4]; bf16x8 wv[4];
#pragma unroll
    for (int dt = 0; dt < 4; ++dt) { uv[dt] = *(const u32x2*)(usrc + 16 * dt); wv[dt] = *(const bf16x8*)(wsrc + 32 * dt); }
#define SGU_STAGE(gi_, buf_) do { _Pragma("unroll") for (int j = 0; j < 2; ++j) { const int q = (tid >> 3) + 64 * j, c = tid & 7; const u32x4 v = j ? gv1 : gv0; const float rr = rsG[q]; \
            const f32x4 ga = *(const f32x4*)(F.gsg + (gi_) * 64 + c * 8), gb = *(const f32x4*)(F.gsg + (gi_) * 64 + c * 8 + 4); \
            u32x4 o; o.x = cvt_pk_bf16(bflo(v.x) * rr * ga.x, bfhi(v.x) * rr * ga.y); o.y = cvt_pk_bf16(bflo(v.y) * rr * ga.z, bfhi(v.y) * rr * ga.w); \
            o.z = cvt_pk_bf16(bflo(v.z) * rr * gb.x, bfhi(v.z) * rr * gb.y); o.w = cvt_pk_bf16(bflo(v.w) * rr * gb.z, bfhi(v.w) * rr * gb.w); \
            *(LAS u32x4*)(Gn + (buf_) * 20480 + q * 128 + ((c ^ (q & 7)) << 4)) = o; } } while (0)
#define SGU_LOAD(gi_) do { gv0 = *(const u32x4*)(gsrc0 + (gi_) * 64); gv1 = *(const u32x4*)(gsrc0 + (size_t)64 * NPROJ + (gi_) * 64); \
            _Pragma("unroll") for (int dt = 0; dt < 4; ++dt) { uv[dt] = *(const u32x2*)(usrc + (gi_) * 64 + 16 * dt); wv[dt] = *(const bf16x8*)(wsrc + (size_t)(gi_) * 16384 + 32 * dt); } } while (0)
    u32x2 uc[4]; bf16x8 wf[4];
    __syncthreads();
    SGU_STAGE(0, 0);
#pragma unroll
    for (int dt = 0; dt < 4; ++dt) { uc[dt] = uv[dt]; wf[dt] = wv[dt]; }
    SGU_LOAD(1);
    __syncthreads();
    for (int gi = 0; gi < 16; ++gi) {
        const LAS unsigned char* G = Gn + (gi & 1) * 20480;
        f32x4 acc[4];
#pragma unroll
        for (int dt = 0; dt < 4; ++dt) acc[dt] = (f32x4){0.f, 0.f, 0.f, 0.f};
#pragma unroll
        for (int ks = 0; ks < 4; ++ks) { const int rowA = 32 * ks + 8 * quad + (fr >> 2), rowB = rowA + 4; const int pp = fr & 3;
#pragma unroll
            for (int dt = 0; dt < 4; ++dt) { const int c = 2 * dt + (pp >> 1);
                const s16x4 lo = tr_read(G + rowA * 128 + ((c ^ (rowA & 7)) << 4) + 8 * (pp & 1)), hi = tr_read(G + rowB * 128 + ((c ^ (rowB & 7)) << 4) + 8 * (pp & 1));
                const bf16x8 af = __builtin_shufflevector(lo, hi, 0, 1, 2, 3, 4, 5, 6, 7);
                acc[dt] = __builtin_amdgcn_mfma_f32_16x16x32_bf16(af, wf[ks], acc[dt], 0, 0, 0); } }
        const float bs = F.b_sp[gi * 128 + p];
        u32x2 pk[4];
#pragma unroll
        for (int dt = 0; dt < 4; ++dt) { const u32x2 uu = uc[dt];
            const float s0 = bflo(uu.x) * (acc[dt][0] + bs), s1 = bfhi(uu.x) * (acc[dt][1] + bs), s2 = bflo(uu.y) * (acc[dt][2] + bs), s3 = bfhi(uu.y) * (acc[dt][3] + bs);
            ssq += (s0 * s0 + s1 * s1) + (s2 * s2 + s3 * s3);
            pk[dt].x = cvt_pk_bf16(s0, s1); pk[dt].y = cvt_pk_bf16(s2, s3); }
        if (gi < 15) { SGU_STAGE(gi + 1, (gi + 1) & 1);
#pragma unroll
            for (int dt = 0; dt < 4; ++dt) { uc[dt] = uv[dt]; wf[dt] = wv[dt]; }
            if (gi < 14) SGU_LOAD(gi + 2); }
#pragma unroll
        for (int dp = 0; dp < 2; ++dp) *(u32x4*)(F.MIX + (tk0 + p) * DM + 1024 + gi * 64 + 32 * dp + 4 * quad + ((quad & 1) ? 12 : 0)) = pair16(pk[2 * dp], pk[2 * dp + 1]);
        __syncthreads();
    }
#undef SGU_STAGE
#undef SGU_LOAD
    ssq += __shfl_xor(ssq, 16); ssq += __shfl_xor(ssq, 32);
    if (quad == 0) F.RB[tk0 + p] = 1.0f / sqrtf(ssq * (1.0f / 1024.0f) + EPS);
}

__device__ __forceinline__ void router_unit(Frame& F, int unit) {
    constexpr int WROW = 544, WBUF = 64 * WROW;
    LAS unsigned char* wimg = F.lds;
    LAS float* lgL = (LAS float*)(F.lds + 2 * WBUF);
    LAS unsigned* histL = (LAS unsigned*)(F.lds + 2 * WBUF + 16896); LAS unsigned* baseL = histL + 32;
    const int tid = F.tid, lane = F.lane, w = F.wave, fr = lane & 15, quad = lane >> 4;
    const int token = unit * 128 + 16 * w + fr;
    __syncthreads();
    if (tid < 32) histL[tid] = 0u;
    const float* xrow = F.out + (size_t)token * DM + 8 * quad;
    unsigned char* trow = F.H8 + (size_t)token * DM + 8 * quad;
    f32x4 acc[2]; acc[0] = (f32x4){0.f, 0.f, 0.f, 0.f}; acc[1] = acc[0];
    float rstd;
    { const f32x4 p0 = *(const f32x4*)(F.SSX + (size_t)token * 32 + 8 * quad), p1 = *(const f32x4*)(F.SSX + (size_t)token * 32 + 8 * quad + 4);
      float ss = ((p0.x + p0.y) + (p0.z + p0.w)) + ((p1.x + p1.y) + (p1.z + p1.w)); ss += __shfl_xor(ss, 16); ss += __shfl_xor(ss, 32); rstd = 1.0f / sqrtf(ss * (1.0f / DM) + EPS); }
    u32x4 wst[4];
#define RT_WLOAD(c) do { _Pragma("unroll") for (int j = 0; j < 4; ++j) { const int id = j * 512 + tid, row = id >> 5, cc = id & 31; \
        wst[j] = *(const u32x4*)((row < 32 ? F.WRH + (size_t)row * DM : F.WRL + (size_t)(row - 32) * DM) + 256 * (c) + 8 * cc); } } while (0)
#define RT_WSTORE(b) do { _Pragma("unroll") for (int j = 0; j < 4; ++j) { const int id = j * 512 + tid, row = id >> 5, cc = id & 31; *(LAS u32x4*)(wimg + (b) * WBUF + row * WROW + cc * 16) = wst[j]; } } while (0)
    RT_WLOAD(0); RT_WSTORE(0);
    __syncthreads();
    for (int c = 0; c < 8; ++c) {
        if (c < 7) RT_WLOAD(c + 1);
        const LAS unsigned char* wb = wimg + (c & 1) * WBUF + fr * WROW + quad * 16;
#pragma unroll 2
        for (int kp = 0; kp < 4; ++kp) {
            u32x2 t8[2];
#pragma unroll
            for (int h2 = 0; h2 < 2; ++h2) { const int kl = 2 * kp + h2, ks = 8 * c + kl;
                const f32x4 xa = *(const f32x4*)(xrow + 32 * ks), xb = *(const f32x4*)(xrow + 32 * ks + 4);
                const f32x4 ga = *(const f32x4*)(F.g2 + 32 * ks + 8 * quad), gb = *(const f32x4*)(F.g2 + 32 * ks + 8 * quad + 4);
                const f32x4 ya = xa * ga * rstd, yb = xb * gb * rstd;
                u32x4 h; h.x = cvt_pk_bf16(ya.x, ya.y); h.y = cvt_pk_bf16(ya.z, ya.w); h.z = cvt_pk_bf16(yb.x, yb.y); h.w = cvt_pk_bf16(yb.z, yb.w);
                u32x4 l; l.x = cvt_pk_bf16(ya.x - bflo(h.x), ya.y - bfhi(h.x)); l.y = cvt_pk_bf16(ya.z - bflo(h.y), ya.w - bfhi(h.y)); l.z = cvt_pk_bf16(yb.x - bflo(h.z), yb.y - bfhi(h.z)); l.w = cvt_pk_bf16(yb.z - bflo(h.w), yb.w - bfhi(h.w));
                t8[h2].x = pk4_fp8(ya.x, ya.y, ya.z, ya.w); t8[h2].y = pk4_fp8(yb.x, yb.y, yb.z, yb.w);
                const bf16x8 yh = __builtin_bit_cast(bf16x8, h), yl = __builtin_bit_cast(bf16x8, l);
#pragma unroll
                for (int et = 0; et < 2; ++et) {
                    const bf16x8 wh = *(const LAS bf16x8*)(wb + (16 * et) * WROW + kl * 64), wl = *(const LAS bf16x8*)(wb + (32 + 16 * et) * WROW + kl * 64);
                    acc[et] = __builtin_amdgcn_mfma_f32_16x16x32_bf16(wh, yh, acc[et], 0, 0, 0);
                    acc[et] = __builtin_amdgcn_mfma_f32_16x16x32_bf16(wh, yl, acc[et], 0, 0, 0);
                    acc[et] = __builtin_amdgcn_mfma_f32_16x16x32_bf16(wl, yh, acc[et], 0, 0, 0); } }
            *(u32x4*)(trow + 64 * (4 * c + kp) + ((quad & 1) ? 24 : 0)) = pair16(t8[0], t8[1]);
        }
        if (c < 7) RT_WSTORE((c + 1) & 1);
        __syncthreads();
    }
#undef RT_WLOAD
#undef RT_WSTORE
#pragma unroll
    for (int et = 0; et < 2; ++et)
#pragma unroll
        for (int i = 0; i < 4; ++i) { const int e = 16 * et + 4 * quad + i; lgL[(w * 16 + fr) * 33 + e] = acc[et][i] + F.b_r[e]; }
    __syncthreads();
    int ev[4]; float gv[4]; unsigned lp[4];
    const int mytok = unit * 128 + 16 * w + lane;
    if (lane < 16) {
        const LAS float* lg = lgL + (w * 16 + lane) * 33; unsigned mask = 0u; float vv[4];
#pragma unroll
        for (int k = 0; k < 4; ++k) { float best = -INFINITY; int bi = 0;
            for (int e = 0; e < 32; ++e) { const float v = lg[e]; if (!((mask >> e) & 1u) && v > best) { best = v; bi = e; } }
            mask |= 1u << bi; ev[k] = bi; vv[k] = best; }
        const float e1 = __expf(vv[1] - vv[0]), e2 = __expf(vv[2] - vv[0]), e3 = __expf(vv[3] - vv[0]); const float inv = 1.0f / (1.0f + e1 + e2 + e3);
        gv[0] = inv; gv[1] = e1 * inv; gv[2] = e2 * inv; gv[3] = e3 * inv;
#pragma unroll
        for (int k = 0; k < 4; ++k) lp[k] = __hip_atomic_fetch_add(histL + ev[k], 1u, __ATOMIC_RELAXED, __HIP_MEMORY_SCOPE_WORKGROUP);
    }
    __syncthreads();
    if (tid < 32) baseL[tid] = __hip_atomic_fetch_add((unsigned*)(F.ctl + CW_CNT + 64 * tid), histL[tid], RLX_AGENT);
    __syncthreads();
    if (lane < 16) {
#pragma unroll
        for (int k = 0; k < 4; ++k) { const unsigned pos = baseL[ev[k]] + lp[k];
            F.LIST[(size_t)ev[k] * CAP + pos] = mytok * 4 + k; F.GATE[(size_t)mytok * 4 + k] = gv[k]; }
    }
}

__device__ __forceinline__ int moe_tables(Frame& F) {
    LAS int* cntL = (LAS int*)(F.lds + XT_CNT); LAS int* tstartL = (LAS int*)(F.lds + XT_TSTART); LAS unsigned char* tileE = F.lds + XT_TILEE;
    __syncthreads();
    if (F.tid < 32) cntL[F.tid] = (int)__hip_atomic_load((unsigned*)(F.ctl + CW_CNT + 64 * F.tid), RLX_AGENT);
    __syncthreads();
    if (F.tid == 0) { int s = 0; for (int e = 0; e < 32; ++e) { tstartL[e] = s; s += (cntL[e] + 255) >> 8; } tstartL[32] = s; }
    __syncthreads();
    const int total = tstartL[32];
    for (int mt = F.tid; mt < total; mt += 512) { int e = 0; for (int k = 1; k < 32; ++k) e += (tstartL[k] <= mt) ? 1 : 0; tileE[mt] = (unsigned char)e; }
    __syncthreads();
    return __builtin_amdgcn_readfirstlane(total);
}

struct Args { const float* in[19]; float* out; unsigned char* ws; int ph_lo, ph_hi; };
__global__ void __launch_bounds__(NWAVES * 64, 2) mk_fwd(Args args) {
    extern __shared__ __attribute__((aligned(16))) unsigned char lds[];
    Frame F;
    F.lds = (LAS unsigned char*)lds;
    F.MISC = (volatile LAS unsigned*)(F.lds + MISC_OFF);
    F.tid = threadIdx.x; F.lane = F.tid & 63; F.wave = __builtin_amdgcn_readfirstlane(F.tid >> 6);
    F.G = gridDim.x; { const int bx = blockIdx.x; F.vcu = (F.G % 8 == 0) ? (bx % 8) * (F.G / 8) + bx / 8 : bx; }
    unsigned char* ws = args.ws;
    F.ctl = (gu32*)(ws + WS_CTL);
    F.x = args.in[0]; F.g1 = args.in[1]; F.w_in = args.in[2]; F.gq = args.in[3]; F.gk = args.in[4]; F.rpb = args.in[5]; F.gsg = args.in[6]; F.w_sp = args.in[7]; F.b_sp = args.in[8];
    F.ga = args.in[9]; F.gs = args.in[10]; F.w_out = args.in[11]; F.g2 = args.in[12]; F.w_r = args.in[13]; F.b_r = args.in[14]; F.w_gu = args.in[15]; F.b_gu = args.in[16]; F.w_dn = args.in[17]; F.b_dn = args.in[18];
    F.out = args.out;
    F.WIN = (bf16*)(ws + WS_WIN); F.WOUT = (bf16*)(ws + WS_WOUT); F.WSP = (bf16*)(ws + WS_WSP); F.WRH = (bf16*)(ws + WS_WRH); F.WRL = (bf16*)(ws + WS_WRL);
    F.WGU = ws + WS_WGU; F.WDN = ws + WS_WDN; F.H = (bf16*)(ws + WS_H); F.H8 = ws + WS_H; F.PROJ = (bf16*)(ws + WS_PROJ); F.MIX = (bf16*)(ws + WS_MIX);
    F.ACT = ws + WS_ACT; F.Y = ws + WS_Y; F.SSX = (float*)(ws + WS_SSX); F.RA = (float*)(ws + WS_RA); F.RB = (float*)(ws + WS_RB); F.SSQA = (float*)(ws + WS_SSQA); F.SSG = (float*)(ws + WS_SSG); F.RSTD2 = (float*)(ws + WS_RSTD2); F.GATE = (float*)(ws + WS_GATE); F.SLOT = (unsigned*)(ws + WS_SLOT); F.LIST = (int*)(ws + WS_LIST);
    for (int u = F.tid; u < (LDS_BYTES - LDSCTL_OFF) / 4; u += NWAVES * 64) ((LAS unsigned*)(F.lds + LDSCTL_OFF))[u] = 0u;
    __syncthreads();
    XcdBarrier bar; bar.bar = (unsigned*)(F.ctl + CW_BAR); bar.x = 0; bar.st = nullptr;
    if (N_LAUNCHES == 1) bar = xcd_barrier_post((unsigned*)(F.ctl + CW_BAR), F.MISC + 8);
#define GRID_BAR() do { if (N_LAUNCHES == 1) xcd_barrier(bar); } while (0)
    const int lo = args.ph_lo, hi = args.ph_hi;
#define IN(k) (lo <= (k) && (k) < hi)
#define BOTH(k) (IN(k) && IN((k) + 1))

    if (IN(0)) { p0_prologue(F); if (BOTH(0)) GRID_BAR(); }

    if (IN(1)) {
        TileOrder S; S.init(NTOK / BM, NPROJ / BM, F.G, (int)blockIdx.x, nullptr);
        EpiProjX E{F.PROJ, F.gq, F.gk, F.SSG};
        const int grp = F.vcu & 1, nconv = (NE * (16 * 16 + 16 * 8) - F.vcu + F.G - 1) / F.G, hconv = nconv / 2;
        moe_convert(F, 0, grp == 0 ? hconv : 0);
        S.ib = 0; S.ie = 5;
        gemm_phase<EpiProjX, false, true, false>(F.lds, (const char*)F.H, (const char*)F.WIN, 0, DM * 2, S, E, nullptr);
        moe_convert(F, grp == 0 ? hconv : 0, grp == 0 ? nconv : hconv);
        S.ib = 5; S.ie = 0x7fffffff;
        gemm_phase<EpiProjX, false, true, false>(F.lds, (const char*)F.H, (const char*)F.WIN, 0, DM * 2, S, E, nullptr);
        moe_convert(F, grp == 0 ? nconv : hconv, nconv);
        if (BOTH(1)) GRID_BAR();
    }

    if (IN(2)) {
        for (int u = F.vcu; u < NBATCH * 16 * 8; u += F.G) attn_unit(F, u >> 7, (u >> 3) & 15, u & 7);
        if (BOTH(2)) GRID_BAR();
    }

    if (IN(3)) {
        for (int u = F.vcu; u < NTOK / 128; u += F.G) sgu_unit(F, u);
        if (BOTH(3)) GRID_BAR();
    }

    if (IN(4)) {
        TileOrder S; S.init(NTOK / BM, DM / BM, F.G, (int)blockIdx.x, nullptr);
        EpiResid E{F.x, F.out, DM, F.RA, F.RB, F.SSX};
        gemm_phase<EpiResid, false, true, false>(F.lds, (const char*)F.MIX, (const char*)F.WOUT, 0, DM * 2, S, E, nullptr);
        if (BOTH(4)) GRID_BAR();
    }

    if (IN(5)) {
        for (int u = F.vcu; u < NTOK / 128; u += F.G) router_unit(F, u);
        if (BOTH(5)) GRID_BAR();
    }

    if (IN(6)) {
        const int total = moe_tables(F);
        LAS unsigned short* tokL = (LAS unsigned short*)(F.lds + XT_TOKL); const LAS int* cntL = (const LAS int*)(F.lds + XT_CNT); const LAS int* tstartL = (const LAS int*)(F.lds + XT_TSTART);
        TileOrder S; S.init(total, 16, F.G, (int)blockIdx.x, F.lds + XT_TILEE);
        { Unit u; for (int i = 0; i < 36 && S.next(i, u); ++i) { if (F.tid < 256) { const int lp = (u.pm - tstartL[u.e]) * 256 + F.tid; tokL[i * 256 + F.tid] = (unsigned short)(lp < cntL[u.e] ? (F.LIST[(size_t)u.e * CAP + lp] >> 2) : 0); } } }
        __syncthreads();
        EpiSwiglu E{F.ACT, F.b_gu, (const LAS float*)(F.lds + XT_BIAS), (unsigned)(size_t)(F.lds + XT_BIAS)};
        gemm_phase<EpiSwiglu, true, true, true>(F.lds, (const char*)F.H8, (const char*)F.WGU, (size_t)4096 * DM, DM, S, E, tokL);
        if (BOTH(6)) GRID_BAR();
    }

    if (IN(7)) {
        const int total = moe_tables(F);
        LAS unsigned* dstL = (LAS unsigned*)(F.lds + XT_TOKL); const LAS int* cntL = (const LAS int*)(F.lds + XT_CNT); const LAS int* tstartL = (const LAS int*)(F.lds + XT_TSTART);
        TileOrder S; S.init(total, 8, F.G, (int)blockIdx.x, F.lds + XT_TILEE);
        { Unit u; for (int i = 0; i < 18 && S.next(i, u); ++i) { if (F.tid < 256) { const int lp = (u.pm - tstartL[u.e]) * 256 + F.tid; dstL[i * 256 + F.tid] = lp < cntL[u.e] ? (unsigned)F.LIST[(size_t)u.e * CAP + lp] : (unsigned)(NTOK * TOPK); } } }
        __syncthreads();
        EpiDown E{F.Y, F.b_dn, dstL, (const LAS float*)(F.lds + XT_BIAS), (unsigned)(size_t)(F.lds + XT_BIAS)};
        gemm_phase<EpiDown, false, true, true>(F.lds, (const char*)F.ACT, (const char*)F.WDN, (size_t)DM * DM, DM, S, E, nullptr);
        if (BOTH(7)) GRID_BAR();
    }

    if (IN(8)) {
        const int gw = F.vcu * NWAVES + F.wave, NGW = F.G * NWAVES, lane = F.lane;
        for (int t = gw; t < NTOK; t += NGW) {
            const f32x4 gt = *(const f32x4*)(F.GATE + (size_t)t * 4);
            float* orow = F.out + (size_t)t * DM + 16 * lane; const unsigned char* yrow = F.Y + (size_t)t * 4 * DM + 16 * lane;
#pragma unroll
            for (int j = 0; j < 2; ++j) { f32x4 o[4];
#pragma unroll
                for (int q = 0; q < 4; ++q) o[q] = *(const f32x4*)(orow + 1024 * j + 4 * q);
#pragma unroll
                for (int k = 0; k < 4; ++k) { const u32x4 y = *(const u32x4*)(yrow + (size_t)k * DM + 1024 * j); const float g = gt[k];
#pragma unroll
                    for (int q = 0; q < 4; ++q) { const f32x2 lo = __builtin_amdgcn_cvt_pk_f32_fp8((int)y[q], false), hi = __builtin_amdgcn_cvt_pk_f32_fp8((int)y[q], true);
                        o[q].x += g * lo.x; o[q].y += g * lo.y; o[q].z += g * hi.x; o[q].w += g * hi.y; } }
#pragma unroll
                for (int q = 0; q < 4; ++q) *(f32x4*)(orow + 1024 * j + 4 * q) = o[q]; }
        }
    }
#undef IN
#undef BOTH
}

extern "C" void kernel_launch(void* const* d_in, const int* in_sizes, int n_in, void* d_out, int out_size, void* d_ws, size_t ws_size, hipStream_t stream) {
    static int grid = 0;
    if (grid == 0) {
        if (n_in != 19 || out_size != NTOK * DM || ws_size < WS_END) { fprintf(stderr, "kernel_launch: unexpected problem (n_in %d, out %d, ws %zu)\n", n_in, out_size, ws_size); grid = -1; return; }
        int dev = 0, cus = 0, per_cu = 0;
        if (hipGetDevice(&dev) != hipSuccess || hipDeviceGetAttribute(&cus, hipDeviceAttributeMultiprocessorCount, dev) != hipSuccess) { grid = -1; return; }
        if (hipFuncSetAttribute((const void*)mk_fwd, hipFuncAttributeMaxDynamicSharedMemorySize, LDS_BYTES) != hipSuccess) { fprintf(stderr, "kernel_launch: hipFuncSetAttribute failed\n"); grid = -1; return; }
        if (hipOccupancyMaxActiveBlocksPerMultiprocessor(&per_cu, (const void*)mk_fwd, NWAVES * 64, LDS_BYTES) != hipSuccess || per_cu < 1) { fprintf(stderr, "kernel_launch: occupancy query says %d\n", per_cu); }
        (void)hipGetLastError();
        grid = cus;
    }
    if (grid < 0) return;
    if (hipMemsetAsync((char*)d_ws + WS_CTL, 0, CTL_ZERO_BYTES, stream) != hipSuccess) return;
    Args a{};
    for (int i = 0; i < 19; ++i) a.in[i] = (const float*)d_in[i];
    a.out = (float*)d_out; a.ws = (unsigned char*)d_ws;
    for (int li = 0; li < N_LAUNCHES; ++li) {
        a.ph_lo = (N_LAUNCHES == 1) ? 0 : li; a.ph_hi = (N_LAUNCHES == 1) ? N_PHASES : li + 1;
        hipLaunchKernelGGL(mk_fwd, dim3(grid), dim3(NWAVES * 64), LDS_BYTES, stream, a);
    }
}
```

```cpp
#include <hip/hip_runtime.h>
#include <cstdio>
#include <cstdint>

#ifndef MK_N_LAUNCHES
#define MK_N_LAUNCHES 1
#endif
constexpr int N_LAUNCHES = MK_N_LAUNCHES;
constexpr int N_PHASES = 9;

#define LAS __attribute__((address_space(3)))
#define GAS __attribute__((address_space(1)))
typedef unsigned short bf16;
typedef short bf16x8 __attribute__((ext_vector_type(8)));
typedef short s16x4 __attribute__((ext_vector_type(4)));
typedef float f32x4 __attribute__((ext_vector_type(4)));
typedef float f32x2 __attribute__((ext_vector_type(2)));
typedef unsigned u32x4 __attribute__((ext_vector_type(4)));
typedef unsigned u32x2 __attribute__((ext_vector_type(2)));
typedef GAS unsigned gu32;
typedef int v8i __attribute__((ext_vector_type(8)));
typedef int v4i __attribute__((ext_vector_type(4)));

constexpr int NTOK = 32768, DM = 2048, NPROJ = 5120, SEQ = 8192, NBATCH = 4;
constexpr int NE = 32, TOPK = 4, CAP = 32768;
constexpr int MAXROWS = NTOK * TOPK + NE * 256;
constexpr float EPS = 1e-6f;
constexpr int NWAVES = 8;

constexpr size_t MiB = 1u << 20;
constexpr size_t WS_CTL = 0, CTL_ZERO_BYTES = 1 * MiB;
constexpr size_t WS_WIN = 2 * MiB;
constexpr size_t WS_WOUT = 22 * MiB;
constexpr size_t WS_WSP = 30 * MiB;
constexpr size_t WS_WRH = 31 * MiB;
constexpr size_t WS_WRL = 31 * MiB + 128 * 1024;
constexpr size_t WS_RSTD2 = 31 * MiB + 512 * 1024;
constexpr size_t WS_SLOT = 32 * MiB;
constexpr size_t WS_GATE = 32 * MiB + 512 * 1024;
constexpr size_t WS_LIST = 33 * MiB;
constexpr size_t WS_WGU = 40 * MiB;
constexpr size_t WS_SSQA = 300 * MiB;
constexpr size_t WS_SSG = 304 * MiB;
constexpr size_t WS_RA = 308 * MiB;
constexpr size_t WS_RB = 309 * MiB;
constexpr size_t WS_SSX = 312 * MiB;
constexpr size_t WS_WDN = 552 * MiB;
constexpr size_t WS_H = 808 * MiB;
constexpr size_t WS_PROJ = 936 * MiB;
constexpr size_t WS_MIX = 1256 * MiB;
constexpr size_t WS_ACT = 1384 * MiB;
constexpr size_t WS_Y = 1928 * MiB;
constexpr size_t WS_END = 2472 * MiB;

constexpr int CW_TMO = 0, CW_CODE = 1;
constexpr int CW_BAR = 4096;
constexpr int CW_CNT = 8192;

constexpr int RING_BYTES = 131072;
constexpr int XT_OFF = RING_BYTES;
constexpr int XT_TOKL = XT_OFF;
constexpr int XT_TILEE = XT_OFF + 18432;
constexpr int XT_TSTART = XT_TILEE + 576;
constexpr int XT_CNT = XT_TSTART + 160;
constexpr int XT_BIAS = XT_OFF + 19456;
constexpr int XT_GAINS = XT_BIAS + 2048;
constexpr int XT_MISC2 = XT_GAINS + 512;
constexpr int AT_RPB = 147456;
constexpr int AT_MRG = AT_RPB + 2048;
constexpr int LDSCTL_OFF = AT_MRG + 10240;
constexpr int MISC_OFF = LDSCTL_OFF + 320;
constexpr int LDS_BYTES = LDSCTL_OFF + 1024;
static_assert(XT_CNT + 128 <= XT_BIAS && XT_MISC2 <= LDSCTL_OFF && LDS_BYTES <= 160 * 1024, "LDS map");
constexpr int N_PH = 9;

#define RLX_AGENT __ATOMIC_RELAXED, __HIP_MEMORY_SCOPE_AGENT
#define LDS_WAIT() asm volatile("s_waitcnt lgkmcnt(0)" ::: "memory")
#define VM_WAIT() asm volatile("s_waitcnt vmcnt(0)" ::: "memory")

__device__ __forceinline__ unsigned cvt_pk_bf16(float lo, float hi) { unsigned r; asm volatile("v_cvt_pk_bf16_f32 %0, %1, %2" : "=v"(r) : "v"(lo), "v"(hi)); return r; }
__device__ __forceinline__ unsigned pk4_fp8(float a, float b, float c, float d) { int w = 0; w = __builtin_amdgcn_cvt_pk_fp8_f32(a, b, w, false); w = __builtin_amdgcn_cvt_pk_fp8_f32(c, d, w, true); return (unsigned)w; }
__device__ __forceinline__ v8i cat8(bf16x8 a, bf16x8 b) { const v4i x = __builtin_bit_cast(v4i, a), y = __builtin_bit_cast(v4i, b); return __builtin_shufflevector(x, y, 0, 1, 2, 3, 4, 5, 6, 7); }
__device__ __forceinline__ bf16x8 lo8(v8i a) { return __builtin_bit_cast(bf16x8, (v4i)__builtin_shufflevector(a, a, 0, 1, 2, 3)); }
__device__ __forceinline__ bf16x8 hi8(v8i a) { return __builtin_bit_cast(bf16x8, (v4i)__builtin_shufflevector(a, a, 4, 5, 6, 7)); }
__device__ __forceinline__ void glds16(const void* gsrc, unsigned lds_dst) { unsigned keep;
    asm volatile("s_mov_b32 %0, m0\n\ts_mov_b32 m0, %2\n\ts_nop 0\n\tglobal_load_lds_dwordx4 %1, off\n\ts_mov_b32 m0, %0" : "=&s"(keep) : "v"(gsrc), "s"(lds_dst) : "memory"); }
__device__ __forceinline__ u32x4 pair16(u32x2 a, u32x2 b) { const auto s0 = __builtin_amdgcn_permlane16_swap(a.x, b.x, false, false), s1 = __builtin_amdgcn_permlane16_swap(a.y, b.y, false, false);
    u32x4 w; w.x = s0[0]; w.y = s1[0]; w.z = s0[1]; w.w = s1[1]; return w; }
__device__ __forceinline__ float bflo(unsigned u) { return __uint_as_float(u << 16); }
__device__ __forceinline__ float bfhi(unsigned u) { return __uint_as_float(u & 0xffff0000u); }
__device__ __forceinline__ float wave_sum(float v) {
#pragma unroll
    for (int o = 1; o < 64; o <<= 1) v += __shfl_xor(v, o);
    return v;
}
__device__ __forceinline__ f32x2 gelu_pk(f32x2 v) {
    const f32x2 av = __builtin_elementwise_abs(v), d = av * 0.2316418882f + 1.0f;
    f32x2 t; t.x = __builtin_amdgcn_rcpf(d.x); t.y = __builtin_amdgcn_rcpf(d.y);
    f32x2 q = t * 0.5307027145f + (-0.7265760135f); q = q * t + 0.7107068705f; q = q * t + (-0.142248368f); q = q * t + 0.127414796f; q = q * t;
    const f32x2 s = (v * v) * (-0.72134752044f);
    f32x2 e; e.x = __builtin_amdgcn_exp2f(s.x); e.y = __builtin_amdgcn_exp2f(s.y);
    const f32x2 m = v * (q * e), r = v - m;
    f32x2 o; o.x = v.x < 0.f ? m.x : r.x; o.y = v.y < 0.f ? m.y : r.y; return o;
}
__device__ __forceinline__ float gelu1(float x) { f32x2 r = gelu_pk((f32x2){x, x}); return r.x; }

#define XB_TMO      128
#define XB_XCNT(j)  (256  + 64 * (j))
#define XB_XSUB(j)  (1280 + 64 * (j))
#define XB_XGEN(j)  (2304 + 64 * (j))
#define XB_TOP      3328
#define XB_TOPGEN   3392
#define XCD_BAR_WORDS 3456
#define XB_SPIN_CAP (1u << 18)
__device__ __forceinline__ unsigned xb_ld(unsigned* p)              { return __hip_atomic_load(p, __ATOMIC_RELAXED, __HIP_MEMORY_SCOPE_AGENT); }
__device__ __forceinline__ unsigned xb_add(unsigned* p, unsigned v) { return __hip_atomic_fetch_add(p, v, __ATOMIC_RELAXED, __HIP_MEMORY_SCOPE_AGENT); }
__device__ __forceinline__ unsigned xb_xcc_id() { return (unsigned)__builtin_amdgcn_s_getreg((3 << 11) | 20) & 0xFu; }
#define XB_SPIN(cond, bar) do { unsigned _sp = 0; while (cond) { __builtin_amdgcn_s_sleep(1); \
    if ((++_sp & 255u) == 0u) { if (xb_ld(&(bar)[XB_TMO])) break; if (_sp > XB_SPIN_CAP) { atomicAdd(&(bar)[XB_TMO], 1u); break; } } } } while (0)
struct XcdBarrier { unsigned* bar; unsigned x; volatile LAS unsigned* st; };
__device__ __forceinline__ XcdBarrier xcd_barrier_post(unsigned* bar, volatile LAS unsigned* st) {
    XcdBarrier b; b.bar = bar; b.x = xb_xcc_id(); b.st = st;
    if (threadIdx.x == 0) (void)xb_add(&bar[XB_XCNT(b.x)], 1u);
    return b;
}
__device__ __forceinline__ void xcd_barrier_complete(unsigned* bar, unsigned x, unsigned& nloc, unsigned& nx) {
    const unsigned G = gridDim.x * gridDim.y * gridDim.z;
    unsigned sum, cnt, mine, sp = 0u;
    for (;;) {
        sum = 0u; cnt = 0u; mine = 0u;
#pragma unroll
        for (unsigned j = 0; j < 16; ++j) { const unsigned c = xb_ld(&bar[XB_XCNT(j)]); sum += c; cnt += (c > 0u) ? 1u : 0u; mine = (j == x) ? c : mine; }
        if (sum == G) break;
        __builtin_amdgcn_s_sleep(1);
        if ((++sp & 255u) == 0u) { if (xb_ld(&bar[XB_TMO])) break; if (sp > XB_SPIN_CAP) { atomicAdd(&bar[XB_TMO], 1u); break; } }
    }
    nloc = mine > 0u ? mine : 1u; nx = cnt > 0u ? cnt : 1u;
}
__device__ __forceinline__ void xcd_barrier(const XcdBarrier& b) {
    asm volatile("s_waitcnt vmcnt(0)" ::: "memory");
    __syncthreads();
    if (threadIdx.x == 0) {
        unsigned* bar = b.bar;
        __builtin_amdgcn_s_waitcnt(0);
        unsigned nloc = b.st[0], nx = b.st[1];
        if (nloc == 0u) { xcd_barrier_complete(bar, b.x, nloc, nx); b.st[0] = nloc; b.st[1] = nx; }
        const unsigned old = xb_add(&bar[XB_XSUB(b.x)], 1u);
        const unsigned gen = old / nloc;
        if (old + 1u == (gen + 1u) * nloc) {
            __builtin_amdgcn_fence(__ATOMIC_RELEASE, "agent");
            asm volatile("s_waitcnt vmcnt(0)" ::: "memory");
            const unsigned og = xb_add(&bar[XB_TOP], 1u);
            const unsigned tg = og / nx;
            if (og + 1u == (tg + 1u) * nx) xb_add(&bar[XB_TOPGEN], 1u);
            else XB_SPIN(xb_ld(&bar[XB_TOPGEN]) == tg, bar);
            __builtin_amdgcn_fence(__ATOMIC_ACQUIRE, "agent");
            xb_add(&bar[XB_XGEN(b.x)], 1u);
            asm volatile("s_waitcnt vmcnt(0)" ::: "memory");
        } else {
            XB_SPIN(xb_ld(&bar[XB_XGEN(b.x)]) == gen, bar);
            __builtin_amdgcn_fence(__ATOMIC_ACQUIRE, "agent");
            asm volatile("s_waitcnt vmcnt(0)" ::: "memory");
        }
    }
    __syncthreads();
}

constexpr int BM = 256, BK = 64, HALF = 128, HTB = HALF * BK * 2, NXCD = 8, WGM = 8;
__host__ __device__ __forceinline__ int lds_byte(int r, int c) { const int st = (r >> 4) * 2 + (c >> 5), rr = r & 15, cc = c & 31, ob = rr * 64 + cc * 2; return st * 1024 + (ob ^ (((ob >> 9) & 1) << 5)); }
__host__ __device__ __forceinline__ void stage_rc(int b, int& R, int& C) { const int st = b / 1024, sb = b % 1024, swz = sb ^ (((sb >> 9) & 1) << 5); R = (st >> 1) * 16 + swz / 64; C = (st & 1) * 32 + (swz % 64) / 2; }
__host__ __device__ __forceinline__ int perm32(int rho) { const int n = rho >> 4, i = rho & 15; return 8 * (i >> 2) + 4 * n + (i & 3); }

struct Unit { int pm, pn, e, ui; };
struct TileOrder {
    int nM, nN, nwg, G, c, ib, ie; const LAS unsigned char* tileE;
    __device__ __forceinline__ void init(int nM_, int nN_, int G_, int c_, const LAS unsigned char* te) { nM = nM_; nN = nN_; nwg = nM * nN; G = G_; c = c_; tileE = te; ib = 0; ie = 0x7fffffff; }
    __device__ __forceinline__ bool next(int i_, Unit& u) const {
        const int i = ib + i_; if (i >= ie) return false;
        const long L = (long)i * G + c; if (L >= nwg) return false;
        int wgid = (int)L; { const int q = nwg / NXCD, r = nwg % NXCD, xcd = wgid % NXCD, off = wgid / NXCD; wgid = (xcd < r ? xcd * (q + 1) : r * (q + 1) + (xcd - r) * q) + off; }
        const int nig = WGM * nN, gid = wgid / nig, fm = gid * WGM, gsz = (nM - fm) < WGM ? (nM - fm) : WGM;
        u.pm = fm + ((wgid % nig) % gsz); u.pn = (wgid % nig) / gsz; u.ui = i;
        u.e = tileE ? __builtin_amdgcn_readfirstlane((int)tileE[u.pm]) : 0;
        return true;
    }
};

struct EpiProjX {
    static constexpr bool MIDK = false, BIASL = false;
    static constexpr bool PERM = true;
    bf16* O; const float* gq; const float* gk; float* SSG;
    __device__ __forceinline__ void operator()(const f32x4 (&acc)[2][2][4][2], const Unit& u, int wr, int wc, int fr, int fq) const {
        const int row0 = u.pm * BM + wr * 64 + fr, col0 = u.pn * BM + wc * 64 + 8 * fq, kind = u.pn >> 2;
        if (kind <= 1) {
            const float* gp = (kind == 0 ? gq : gk) + 8 * fq; const float qs = kind == 0 ? 0.125f * 1.4426950408889634f : 1.0f;
            const f32x4 g00 = *(const f32x4*)(gp), g01 = *(const f32x4*)(gp + 4), g10 = *(const f32x4*)(gp + 32), g11 = *(const f32x4*)(gp + 36);
#pragma unroll
            for (int ai = 0; ai < 2; ++ai)
#pragma unroll
                for (int m = 0; m < 4; ++m) { const f32x4 a = acc[ai][0][m][0], b = acc[ai][0][m][1], c = acc[ai][1][m][0], d = acc[ai][1][m][1];
                    float ss = (a.x * a.x + a.y * a.y) + (a.z * a.z + a.w * a.w) + (b.x * b.x + b.y * b.y) + (b.z * b.z + b.w * b.w) + (c.x * c.x + c.y * c.y) + (c.z * c.z + c.w * c.w) + (d.x * d.x + d.y * d.y) + (d.z * d.z + d.w * d.w);
                    ss += __shfl_xor(ss, 16); ss += __shfl_xor(ss, 32);
                    const float r = qs / sqrtf(ss * (1.0f / 64.0f) + EPS);
                    const f32x4 oa = a * r * g00, ob = b * r * g01, oc = c * r * g10, od = d * r * g11;
                    bf16* rowp = O + (size_t)(row0 + ai * HALF + m * 16) * NPROJ + col0;
                    u32x4 w0, w1; w0.x = cvt_pk_bf16(oa.x, oa.y); w0.y = cvt_pk_bf16(oa.z, oa.w); w0.z = cvt_pk_bf16(ob.x, ob.y); w0.w = cvt_pk_bf16(ob.z, ob.w);
                    w1.x = cvt_pk_bf16(oc.x, oc.y); w1.y = cvt_pk_bf16(oc.z, oc.w); w1.z = cvt_pk_bf16(od.x, od.y); w1.w = cvt_pk_bf16(od.z, od.w);
                    *(u32x4*)(rowp) = w0; *(u32x4*)(rowp + 32) = w1; }
        } else if (kind == 2) {
#pragma unroll
            for (int ai = 0; ai < 2; ++ai)
#pragma unroll
                for (int m = 0; m < 4; ++m) { bf16* rowp = O + (size_t)(row0 + ai * HALF + m * 16) * NPROJ + col0;
#pragma unroll
                    for (int bj = 0; bj < 2; ++bj) { const f32x4 v0 = acc[ai][bj][m][0], v1 = acc[ai][bj][m][1];
                        u32x4 w; w.x = cvt_pk_bf16(v0[0], v0[1]); w.y = cvt_pk_bf16(v0[2], v0[3]); w.z = cvt_pk_bf16(v1[0], v1[1]); w.w = cvt_pk_bf16(v1[2], v1[3]);
                        *(u32x4*)(rowp + bj * 32) = w; } }
        } else {
#pragma unroll
            for (int ai = 0; ai < 2; ++ai)
#pragma unroll
                for (int m = 0; m < 4; ++m) { const int row = row0 + ai * HALF + m * 16; bf16* rowp = O + (size_t)row * NPROJ + col0; float ss = 0.f;
#pragma unroll
                    for (int bj = 0; bj < 2; ++bj) { const f32x4 v0 = acc[ai][bj][m][0], v1 = acc[ai][bj][m][1];
                        const f32x2 a = gelu_pk((f32x2){v0[0], v0[1]}), b = gelu_pk((f32x2){v0[2], v0[3]}), c = gelu_pk((f32x2){v1[0], v1[1]}), d = gelu_pk((f32x2){v1[2], v1[3]});
                        ss += (a.x * a.x + a.y * a.y) + (b.x * b.x + b.y * b.y) + (c.x * c.x + c.y * c.y) + (d.x * d.x + d.y * d.y);
                        u32x4 w; w.x = cvt_pk_bf16(a.x, a.y); w.y = cvt_pk_bf16(b.x, b.y); w.z = cvt_pk_bf16(c.x, c.y); w.w = cvt_pk_bf16(d.x, d.y);
                        *(u32x4*)(rowp + bj * 32) = w; }
                    if (kind == 4) { ss += __shfl_xor(ss, 16); ss += __shfl_xor(ss, 32); if (fq == 0) SSG[(size_t)row * 16 + (u.pn - 16) * 4 + wc] = ss; } }
        }
    }
};
struct EpiResid {
    static constexpr bool PERM = false, MIDK = true, BIASL = false;
    const float* base; float* out; int ldc; const float* RA; const float* RB; float* SSX;
    __device__ __forceinline__ void mid(f32x4 (&acc)[2][2][4][2], const Unit& u, int wr, int fr) const {
        const int row0 = u.pm * BM + wr * 64 + fr;
#pragma unroll
        for (int ai = 0; ai < 2; ++ai)
#pragma unroll
            for (int m = 0; m < 4; ++m) { int row = row0 + ai * HALF + m * 16; asm volatile("" : "+v"(row));
                const float f = RA[row] / RB[row];
#pragma unroll
                for (int bj = 0; bj < 2; ++bj)
#pragma unroll
                    for (int n = 0; n < 2; ++n) acc[ai][bj][m][n] = acc[ai][bj][m][n] * f; }
    }
    static __device__ __forceinline__ f32x4 ror8(f32x4 v) { f32x4 r;
#pragma unroll
        for (int i = 0; i < 4; ++i) r[i] = __int_as_float(__builtin_amdgcn_update_dpp(0, __float_as_int(v[i]), 0x128, 0xf, 0xf, false)); return r; }
    __device__ __forceinline__ void operator()(const f32x4 (&acc)[2][2][4][2], const Unit& u, int wr, int wc, int fr, int fq) const {
        const bool lo = fr < 8; const int r7 = fr & 7;
        const int rowX0 = u.pm * BM + wr * 64 + r7, col0 = u.pn * BM + wc * 32 + (fr >> 3) * 16 + 4 * fq;
#pragma unroll
        for (int ai = 0; ai < 2; ++ai) {
            f32x4 rX[4][2], rY[4][2]; float rbX[4], rbY[4];
#pragma unroll
            for (int m = 0; m < 4; ++m) { const int row = rowX0 + ai * HALF + m * 16; const size_t off = (size_t)row * ldc + col0; rbX[m] = RB[row]; rbY[m] = RB[row + 8];
#pragma unroll
                for (int bj = 0; bj < 2; ++bj) { rX[m][bj] = *(const f32x4*)(base + off + bj * HALF); rY[m][bj] = *(const f32x4*)(base + off + (size_t)8 * ldc + bj * HALF); } }
#pragma unroll
            for (int m = 0; m < 4; ++m) { const int row = rowX0 + ai * HALF + m * 16; const size_t off = (size_t)row * ldc + col0;
                float ssX = 0.f, ssY = 0.f;
#pragma unroll
                for (int bj = 0; bj < 2; ++bj) { const f32x4 v0 = acc[ai][bj][m][0], v1 = acc[ai][bj][m][1];
                    const f32x4 got = ror8(lo ? v1 : v0);
                    const f32x4 dX = lo ? v0 : got, dY = lo ? got : v1;
                    const f32x4 oX = rX[m][bj] + dX * rbX[m], oY = rY[m][bj] + dY * rbY[m];
                    *(f32x4*)(out + off + bj * HALF) = oX; *(f32x4*)(out + off + (size_t)8 * ldc + bj * HALF) = oY;
                    ssX += (oX.x * oX.x + oX.y * oX.y) + (oX.z * oX.z + oX.w * oX.w); ssY += (oY.x * oY.x + oY.y * oY.y) + (oY.z * oY.z + oY.w * oY.w); }
                ssX += __shfl_xor(ssX, 16); ssX += __shfl_xor(ssX, 32); ssX += __shfl_xor(ssX, 8);
                ssY += __shfl_xor(ssY, 16); ssY += __shfl_xor(ssY, 32); ssY += __shfl_xor(ssY, 8);
                SSX[(size_t)row * 32 + u.pn * 4 + wc] = ssX; SSX[(size_t)(row + 8) * 32 + u.pn * 4 + wc] = ssY; }
        }
    }
};
struct EpiSwiglu {
    static constexpr bool MIDK = false, BIASL = true;
    static constexpr bool PERM = true;
    unsigned char* act; const float* bgu; const LAS float* biasL; unsigned biasA;
    __device__ __forceinline__ void prefetch(const Unit& u, int wid, int lane) const {
        if (wid == 0) glds16(bgu + (size_t)u.e * 4096 + u.pn * 128 + (lane & 31) * 4 + (lane >> 5) * 2048, biasA + (unsigned)(u.ui & 1) * 1024u); }
    __device__ __forceinline__ void operator()(const f32x4 (&acc)[2][2][4][2], const Unit& u, int wr, int wc, int fr, int fq) const {
        const int jl = wc * 32 + 8 * (2 * (fq & 1) + (fq >> 1));
        const LAS float* bp = biasL + (u.ui & 1) * 256 + jl;
        const f32x4 bg0 = *(const LAS f32x4*)(bp), bg1 = *(const LAS f32x4*)(bp + 4), bl0 = *(const LAS f32x4*)(bp + 128) + 1.0f, bl1 = *(const LAS f32x4*)(bp + 132) + 1.0f;
        const float rs = 1.0f / 64.0f;
        const int hi32 = fq >> 1;
        unsigned char* obase = act + (size_t)(u.pm * BM + wr * 64 + fr) * 2048 + u.pn * 128 + wc * 32 + 16 * (fq & 1);
#pragma unroll
        for (int ai = 0; ai < 2; ++ai)
#pragma unroll
            for (int mp = 0; mp < 2; ++mp) {
                unsigned wv[2][2];
#pragma unroll
                for (int r2 = 0; r2 < 2; ++r2) { const int m = 2 * mp + r2;
#pragma unroll
                    for (int n = 0; n < 2; ++n) { const f32x4 ag = acc[ai][0][m][n], al = acc[ai][1][m][n], bg = n ? bg1 : bg0, bl = n ? bl1 : bl0; f32x2 o2[2];
#pragma unroll
                        for (int hq = 0; hq < 2; ++hq) {
                            f32x2 g = (f32x2){ag[2 * hq], ag[2 * hq + 1]} * rs + (f32x2){bg[2 * hq], bg[2 * hq + 1]};
                            f32x2 l = (f32x2){al[2 * hq], al[2 * hq + 1]} * rs + (f32x2){bl[2 * hq], bl[2 * hq + 1]};
                            g.x = fminf(g.x, 7.0f); g.y = fminf(g.y, 7.0f);
                            l.x = __builtin_amdgcn_fmed3f(l.x, -6.0f, 8.0f); l.y = __builtin_amdgcn_fmed3f(l.y, -6.0f, 8.0f);
                            const f32x2 z = g * (-1.702f * 1.4426950408889634f);
                            f32x2 e; e.x = __builtin_amdgcn_exp2f(z.x); e.y = __builtin_amdgcn_exp2f(z.y);
                            const f32x2 d = e + 1.0f; f32x2 r; r.x = __builtin_amdgcn_rcpf(d.x); r.y = __builtin_amdgcn_rcpf(d.y);
                            o2[hq] = (g * r) * l; }
                        wv[r2][n] = pk4_fp8(o2[0].x, o2[0].y, o2[1].x, o2[1].y); } }
                const auto s0 = __builtin_amdgcn_permlane32_swap(wv[0][0], wv[1][0], false, false), s1 = __builtin_amdgcn_permlane32_swap(wv[0][1], wv[1][1], false, false);
                u32x4 w; w.x = s0[0]; w.y = s1[0]; w.z = s0[1]; w.w = s1[1];
                *(u32x4*)(obase + (size_t)(ai * HALF + (2 * mp + hi32) * 16) * 2048) = w; }
    }
};
struct EpiDown {
    static constexpr bool MIDK = false, BIASL = true;
    static constexpr bool PERM = true;
    unsigned char* Y; const float* bdn; const LAS unsigned* dstL; const LAS float* biasL; unsigned biasA;
    __device__ __forceinline__ void prefetch(const Unit& u, int wid, int lane) const {
        if (wid == 0) glds16(bdn + (size_t)u.e * 2048 + u.pn * 256 + lane * 4, biasA + (unsigned)(u.ui & 1) * 1024u); }
    __device__ __forceinline__ void operator()(const f32x4 (&acc)[2][2][4][2], const Unit& u, int wr, int wc, int fr, int fq) const {
        const int col0 = u.pn * BM + wc * 64 + 16 * fq;
        const LAS float* bp = biasL + (u.ui & 1) * 256 + wc * 64 + 16 * fq;
        f32x4 bv[2][2];
#pragma unroll
        for (int bj = 0; bj < 2; ++bj)
#pragma unroll
            for (int n = 0; n < 2; ++n) bv[bj][n] = *(const LAS f32x4*)(bp + 8 * bj + 4 * n);
#pragma unroll
        for (int ai = 0; ai < 2; ++ai)
#pragma unroll
            for (int m = 0; m < 4; ++m) { const unsigned dst = dstL[u.ui * 256 + ai * HALF + wr * 64 + m * 16 + fr];
                const f32x4 v00 = acc[ai][0][m][0] * (1.0f / 64.0f) + bv[0][0], v01 = acc[ai][0][m][1] * (1.0f / 64.0f) + bv[0][1], v10 = acc[ai][1][m][0] * (1.0f / 64.0f) + bv[1][0], v11 = acc[ai][1][m][1] * (1.0f / 64.0f) + bv[1][1];
                u32x4 w; w.x = pk4_fp8(v00[0], v00[1], v00[2], v00[3]); w.y = pk4_fp8(v01[0], v01[1], v01[2], v01[3]); w.z = pk4_fp8(v10[0], v10[1], v10[2], v10[3]); w.w = pk4_fp8(v11[0], v11[1], v11[2], v11[3]);
                *(u32x4*)(Y + (size_t)dst * 2048 + col0) = w; }
    }
};

template <class Epi, bool GATHER, bool ALIGN_EPI, bool FP8>
__device__ __forceinline__ void gemm_phase(LAS unsigned char* lds, const char* Abase, const char* Bbase, size_t estrideB, int KB, const TileOrder& S, const Epi& E, const LAS unsigned short* tokL) {
    const int tid = threadIdx.x, wid = __builtin_amdgcn_readfirstlane(tid >> 6), lane = tid & 63, wr = wid >> 2, wc = wid & 3, fr = lane & 15, fq = lane >> 4;
    const int nt = KB / 128;
    int Rr[2], Cc[2]; unsigned voffB[2], vA[2][2];
#pragma unroll
    for (int i = 0; i < 2; ++i) { int R, C; stage_rc(tid * 16 + i * 8192, R, C); const int Rb = Epi::PERM ? ((R & ~31) + perm32(R & 31)) : R;
        Rr[i] = R; Cc[i] = C; voffB[i] = (unsigned)(Rb * KB + C * 2); }
    const size_t kstep = (size_t)128;
    const size_t hstep = (size_t)HALF * KB;
    const size_t tstep = 2 * hstep;
    const unsigned ldsw = (unsigned)wid * 1024u;
    const int aoff = lds_byte(wr * 64 + fr, fq * 8), boff = lds_byte(wc * 32 + fr, fq * 8);
#define PG8_SA(b, h) (((b) * 2 + (h)) * HTB)
#define PG8_SB(b, h) ((4 + (b) * 2 + (h)) * HTB)
#define PG8_STAGE(bufoff, gbase, voff) do { _Pragma("unroll") for (int _i = 0; _i < 2; ++_i) \
        __builtin_amdgcn_global_load_lds((const GAS unsigned*)((const char*)(gbase) + (voff)[_i]), (LAS unsigned*)(lds + (bufoff) + ldsw + _i * 8192), 16, 0, 0); } while (0)
#define PG8_LDA(dst, b, h) do { _Pragma("unroll") for (int m = 0; m < 4; ++m) dst[m] = __builtin_shufflevector(*(const LAS v4i*)(lds + PG8_SA(b, h) + aoff + m * 2048), *(const LAS v4i*)(lds + PG8_SA(b, h) + aoff + m * 2048 + 1024), 0, 1, 2, 3, 4, 5, 6, 7); } while (0)
#define PG8_LDB(dst, b, h) do { _Pragma("unroll") for (int n = 0; n < 2; ++n) dst[n] = __builtin_shufflevector(*(const LAS v4i*)(lds + PG8_SB(b, h) + boff + n * 2048), *(const LAS v4i*)(lds + PG8_SB(b, h) + boff + n * 2048 + 1024), 0, 1, 2, 3, 4, 5, 6, 7); } while (0)
#define PG8_MMA(ai, bj, At, Bt) do { __builtin_amdgcn_s_setprio(1); _Pragma("unroll") for (int m = 0; m < 4; ++m) _Pragma("unroll") for (int n = 0; n < 2; ++n) { \
        if constexpr (FP8) acc[ai][bj][m][n] = __builtin_amdgcn_mfma_scale_f32_16x16x128_f8f6f4(Bt[n], At[m], acc[ai][bj][m][n], 0, 0, 0, 0, 0, 0)    ; \
        else { acc[ai][bj][m][n] = __builtin_amdgcn_mfma_f32_16x16x32_bf16(lo8(Bt[n]), lo8(At[m]), acc[ai][bj][m][n], 0, 0, 0); acc[ai][bj][m][n] = __builtin_amdgcn_mfma_f32_16x16x32_bf16(hi8(Bt[n]), hi8(At[m]), acc[ai][bj][m][n], 0, 0, 0); } } __builtin_amdgcn_s_setprio(0); } while (0)
#define PG8_WAIT_V(n) asm volatile("s_waitcnt vmcnt(" #n ")" ::: "memory")
#define PG8_WAIT_L(n) asm volatile("s_waitcnt lgkmcnt(" #n ")" ::: "memory")
#define PG8_BAR __builtin_amdgcn_s_barrier()
#define PG8_SCHED __builtin_amdgcn_sched_barrier(0)
#define PG8_SETVA(u) do { _Pragma("unroll") for (int _h = 0; _h < 2; ++_h) _Pragma("unroll") for (int _i = 0; _i < 2; ++_i) { \
        const int _row = GATHER ? (int)tokL[(u).ui * 256 + _h * HALF + Rr[_i]] : (_h * HALF + Rr[_i]); vA[_h][_i] = (unsigned)(_row * KB + Cc[_i] * 2); asm volatile("" : "+v"(vA[_h][_i])); } } while (0)
    Unit cur, nxt; int ui = 0;
    if (!S.next(0, cur)) return;
    f32x4 acc[2][2][4][2];
#pragma unroll
    for (int a = 0; a < 2; ++a)
#pragma unroll
        for (int b = 0; b < 2; ++b)
#pragma unroll
            for (int m = 0; m < 4; ++m)
#pragma unroll
                for (int n = 0; n < 2; ++n) acc[a][b][m][n] = (f32x4){0.f, 0.f, 0.f, 0.f};
    v8i At[4], B0[2], B1[2];
    const char* cA = GATHER ? Abase : Abase + (size_t)cur.pm * tstep;
    const char* cB = Bbase + (size_t)cur.e * estrideB + (size_t)cur.pn * tstep;
    PG8_SETVA(cur);
    if constexpr (Epi::BIASL) E.prefetch(cur, wid, lane);
    PG8_STAGE(PG8_SB(0, 0), cB, voffB); PG8_STAGE(PG8_SB(0, 1), cB + hstep, voffB); PG8_STAGE(PG8_SA(0, 0), cA, vA[0]); PG8_STAGE(PG8_SA(0, 1), cA, vA[1]);
    if (wr == 1) PG8_BAR;
    PG8_WAIT_V(2); PG8_BAR;
    PG8_STAGE(PG8_SB(1, 0), cB + kstep, voffB); PG8_STAGE(PG8_SA(1, 0), cA + kstep, vA[0]); PG8_STAGE(PG8_SB(1, 1), cB + hstep + kstep, voffB);
    PG8_WAIT_V(6); PG8_BAR;
    for (;;) {
        const bool has_next = S.next(ui + 1, nxt);
        const char* nA = has_next ? (GATHER ? Abase : Abase + (size_t)nxt.pm * tstep) : cA;
        const char* nB = has_next ? Bbase + (size_t)nxt.e * estrideB + (size_t)nxt.pn * tstep : cB;
        for (int t = 0; t < nt; t += 2) {
            if constexpr (Epi::MIDK) { if (t == nt / 2) E.mid(acc, cur, wr, fr); }
            const bool last = (t == nt - 2);
            const char* a1 = cA + (size_t)(t + 1) * kstep;
            const char* a2 = last ? nA : cA + (size_t)(t + 2) * kstep; const char* b2 = last ? nB : cB + (size_t)(t + 2) * kstep;
            const char* a3 = a2 + kstep; const char* b3 = b2 + kstep;
            PG8_LDB(B0, 0, 0); PG8_LDB(B1, 0, 1); PG8_SCHED; PG8_LDA(At, 0, 0); PG8_STAGE(PG8_SA(1, 1), a1, vA[1]);
            if (last && has_next) PG8_SETVA(nxt);
            PG8_WAIT_V(8); PG8_WAIT_L(0); PG8_BAR; PG8_MMA(0, 0, At, B0); PG8_MMA(0, 1, At, B1); PG8_BAR; PG8_SCHED;
            PG8_LDA(At, 0, 1); PG8_STAGE(PG8_SB(0, 0), b2, voffB); PG8_STAGE(PG8_SB(0, 1), b2 + hstep, voffB); PG8_STAGE(PG8_SA(0, 0), a2, vA[0]);
            PG8_WAIT_V(8); PG8_WAIT_L(0); PG8_BAR; PG8_MMA(1, 0, At, B0); PG8_MMA(1, 1, At, B1); PG8_BAR; PG8_SCHED;
            PG8_LDB(B0, 1, 0); PG8_LDB(B1, 1, 1); PG8_SCHED; PG8_LDA(At, 1, 0); PG8_STAGE(PG8_SA(0, 1), a2, vA[1]);
            PG8_WAIT_V(8); PG8_WAIT_L(0); PG8_BAR; PG8_MMA(0, 0, At, B0); PG8_MMA(0, 1, At, B1); PG8_BAR; PG8_SCHED;
            PG8_LDA(At, 1, 1); PG8_STAGE(PG8_SB(1, 0), b3, voffB); PG8_STAGE(PG8_SB(1, 1), b3 + hstep, voffB); PG8_STAGE(PG8_SA(1, 0), a3, vA[0]);
            PG8_WAIT_V(8); PG8_WAIT_L(0); PG8_BAR; PG8_MMA(1, 0, At, B0); PG8_MMA(1, 1, At, B1); PG8_BAR; PG8_SCHED;
        }
        if constexpr (ALIGN_EPI) { if (wr == 0) PG8_BAR; }
        E(acc, cur, wr, wc, fr, fq);
        if (!has_next) break;
#pragma unroll
        for (int a = 0; a < 2; ++a)
#pragma unroll
            for (int b = 0; b < 2; ++b)
#pragma unroll
                for (int m = 0; m < 4; ++m)
#pragma unroll
                    for (int n = 0; n < 2; ++n) acc[a][b][m][n] = (f32x4){0.f, 0.f, 0.f, 0.f};
        cur = nxt; cA = nA; cB = nB; ++ui;
        if constexpr (Epi::BIASL) E.prefetch(cur, wid, lane);
        if constexpr (ALIGN_EPI) { if (wr == 1) PG8_BAR; }
    }
    PG8_WAIT_V(0);
    if constexpr (!ALIGN_EPI) { if (wr == 0) PG8_BAR; }
    PG8_BAR;
#undef PG8_SA
#undef PG8_SB
#undef PG8_STAGE
#undef PG8_LDA
#undef PG8_LDB
#undef PG8_MMA
#undef PG8_WAIT_V
#undef PG8_WAIT_L
#undef PG8_BAR
#undef PG8_SCHED
#undef PG8_SETVA
}

struct Frame {
    LAS unsigned char* lds;
    volatile LAS unsigned* MISC;
    gu32* ctl;
    int tid, lane, wave, vcu, G;
    const float *x, *g1, *w_in, *gq, *gk, *rpb, *gsg, *w_sp, *b_sp, *ga, *gs, *w_out, *g2, *w_r, *b_r, *w_gu, *b_gu, *w_dn, *b_dn;
    float* out;
    bf16 *WIN, *WOUT, *WSP, *WRH, *WRL, *H, *PROJ, *MIX; unsigned char *WGU, *WDN, *ACT, *H8, *Y;
    float *RSTD2, *GATE, *SSQA, *SSG, *RA, *RB, *SSX; unsigned* SLOT; int* LIST;
};

__device__ __forceinline__ void p0_transpose_item(const float* W, int N, int K, bf16* WT, int k0, int n0, int out_row0, int hi_off, const float* kgain, LAS float* scr, int lane) {
    const int l16 = lane & 15, lq = lane >> 4;
#pragma unroll 4
    for (int i = 0; i < 16; ++i) { const int kk = 4 * i + lq; f32x4 v = *(const f32x4*)(W + (size_t)(k0 + kk) * N + n0 + 4 * l16); if (kgain) v = v * kgain[k0 + kk];
        LAS float* d = scr + kk * 65 + 4 * l16; d[0] = v.x; d[1] = v.y; d[2] = v.z; d[3] = v.w; }
    LDS_WAIT(); asm volatile("" ::: "memory");
    const int c = lane >> 3, nn = lane & 7;
#pragma unroll
    for (int j = 0; j < 8; ++j) { const int n = nn + 8 * j; const LAS float* s = scr + (8 * c) * 65 + n;
        u32x4 o; o.x = cvt_pk_bf16(s[0], s[65]); o.y = cvt_pk_bf16(s[2 * 65], s[3 * 65]); o.z = cvt_pk_bf16(s[4 * 65], s[5 * 65]); o.w = cvt_pk_bf16(s[6 * 65], s[7 * 65]);
        *(u32x4*)(WT + (size_t)(out_row0 + n + (n >= 32 ? hi_off : 0)) * K + k0 + 8 * c) = o; }
    LDS_WAIT(); asm volatile("" ::: "memory");
}
__device__ __forceinline__ void p0_transpose_item_fp8(const float* W, int N, int K, unsigned char* WT, int k0, int n0, int out_row0, LAS float* scr, int lane) {
    const int l8 = lane & 7, lr = lane >> 3;
#pragma unroll 4
    for (int i = 0; i < 16; ++i) { const int kk = 8 * i + lr; const f32x4 v = *(const f32x4*)(W + (size_t)(k0 + kk) * N + n0 + 4 * l8);
        LAS float* d = scr + kk * 33 + 4 * l8; d[0] = v.x; d[1] = v.y; d[2] = v.z; d[3] = v.w; }
    LDS_WAIT(); asm volatile("" ::: "memory");
    const int n = lane & 31, kh = lane >> 5; const LAS float* s = scr + (64 * kh) * 33 + n;
#pragma unroll
    for (int c4 = 0; c4 < 4; ++c4) { u32x4 o;
        o.x = pk4_fp8(s[(16 * c4 + 0) * 33] * 64.f, s[(16 * c4 + 1) * 33] * 64.f, s[(16 * c4 + 2) * 33] * 64.f, s[(16 * c4 + 3) * 33] * 64.f);
        o.y = pk4_fp8(s[(16 * c4 + 4) * 33] * 64.f, s[(16 * c4 + 5) * 33] * 64.f, s[(16 * c4 + 6) * 33] * 64.f, s[(16 * c4 + 7) * 33] * 64.f);
        o.z = pk4_fp8(s[(16 * c4 + 8) * 33] * 64.f, s[(16 * c4 + 9) * 33] * 64.f, s[(16 * c4 + 10) * 33] * 64.f, s[(16 * c4 + 11) * 33] * 64.f);
        o.w = pk4_fp8(s[(16 * c4 + 12) * 33] * 64.f, s[(16 * c4 + 13) * 33] * 64.f, s[(16 * c4 + 14) * 33] * 64.f, s[(16 * c4 + 15) * 33] * 64.f);
        *(u32x4*)(WT + (size_t)(out_row0 + n) * K + k0 + 64 * kh + 16 * c4) = o; }
    LDS_WAIT(); asm volatile("" ::: "memory");
}
__device__ __forceinline__ void moe_convert(Frame& F, int j0, int j1) {
    LAS float* img = (LAS float*)F.lds;
    constexpr int T_GU = 16 * 16, T_DN = 16 * 8, NT = NE * (T_GU + T_DN);
    const int w = F.wave, lane = F.lane;
    f32x4 v[16];
#define P0_DECODE(t, W_, N_, WT_, k0_, n0_, isgu_) do { int r_ = (t); if (r_ < NE * T_GU) { const int e_ = r_ / T_GU, q_ = r_ % T_GU; W_ = F.w_gu + (size_t)e_ * DM * 4096; N_ = 4096; WT_ = F.WGU + (size_t)e_ * 4096 * DM; k0_ = 128 * (q_ / 16); n0_ = 256 * (q_ % 16); isgu_ = 1; } \
        else { r_ -= NE * T_GU; const int e_ = r_ / T_DN, q_ = r_ % T_DN; W_ = F.w_dn + (size_t)e_ * DM * DM; N_ = DM; WT_ = F.WDN + (size_t)e_ * DM * DM; k0_ = 128 * (q_ / 8); n0_ = 256 * (q_ % 8); isgu_ = 0; } } while (0)
#define P0_LOAD(W_, N_, k0_, n0_) do { _Pragma("unroll") for (int i = 0; i < 16; ++i) v[i] = __builtin_nontemporal_load((const f32x4*)(W_ + (size_t)(k0_ + 16 * w + i) * N_ + n0_ + 4 * lane)); } while (0)
    int j = j0, t = F.vcu + j0 * F.G;
    const float* W = nullptr; unsigned char* WT = nullptr; int N = 0, k0 = 0, n0 = 0, isgu = 0;
    if (j < j1 && t < NT) { P0_DECODE(t, W, N, WT, k0, n0, isgu); P0_LOAD(W, N, k0, n0); }
    while (j < j1 && t < NT) {
#pragma unroll
        for (int i = 0; i < 16; ++i) *(LAS f32x4*)(img + (16 * w + i) * 260 + 4 * lane) = v[i];
        __syncthreads();
        const int tn = t + F.G; const float* Wn = nullptr; unsigned char* WTn = nullptr; int Nn = 0, k0n = 0, n0n = 0, isgun = 0;
        if (j + 1 < j1 && tn < NT) { P0_DECODE(tn, Wn, Nn, WTn, k0n, n0n, isgun); P0_LOAD(Wn, Nn, k0n, n0n); }
        { const int n = 32 * w + (lane & 31), kh = lane >> 5; const LAS float* sp = img + (64 * kh) * 260 + n;
          const int nn = n0 + n; const int ll = nn & 255;
          const int jl = nn & 127, g8 = (jl >> 3) & 3;
          const int orow = isgu ? (((nn & 2047) >> 7) * 256 + (nn >> 11) * 128 + (jl & ~31) + 8 * (2 * (g8 & 1) + (g8 >> 1)) + (jl & 7)) : ((nn & ~255) + 128 * ((ll >> 3) & 1) + 32 * (ll >> 6) + 8 * ((ll >> 4) & 3) + (ll & 7));
          unsigned char* dst = WT + (size_t)orow * DM + k0 + 64 * kh;
#pragma unroll
          for (int c4 = 0; c4 < 4; ++c4) { u32x4 o;
              o.x = pk4_fp8(sp[(16 * c4 + 0) * 260] * 64.f, sp[(16 * c4 + 1) * 260] * 64.f, sp[(16 * c4 + 2) * 260] * 64.f, sp[(16 * c4 + 3) * 260] * 64.f);
              o.y = pk4_fp8(sp[(16 * c4 + 4) * 260] * 64.f, sp[(16 * c4 + 5) * 260] * 64.f, sp[(16 * c4 + 6) * 260] * 64.f, sp[(16 * c4 + 7) * 260] * 64.f);
              o.z = pk4_fp8(sp[(16 * c4 + 8) * 260] * 64.f, sp[(16 * c4 + 9) * 260] * 64.f, sp[(16 * c4 + 10) * 260] * 64.f, sp[(16 * c4 + 11) * 260] * 64.f);
              o.w = pk4_fp8(sp[(16 * c4 + 12) * 260] * 64.f, sp[(16 * c4 + 13) * 260] * 64.f, sp[(16 * c4 + 14) * 260] * 64.f, sp[(16 * c4 + 15) * 260] * 64.f);
              __builtin_nontemporal_store(o, (u32x4*)(dst + 16 * c4)); } }
        __syncthreads();
        ++j; t = tn; W = Wn; WT = WTn; N = Nn; k0 = k0n; n0 = n0n; isgu = isgun;
    }
#undef P0_DECODE
#undef P0_LOAD
}
__device__ __forceinline__ void p0_prologue(Frame& F) {
    LAS float* scr = (LAS float*)(F.lds + F.wave * 16896);
    const int gw = F.vcu * NWAVES + F.wave, NGW = F.G * NWAVES, lane = F.lane;
    constexpr int I_IN = 32 * 80, I_OUT = 32 * 32;
    constexpr int NITEMS = I_IN + I_OUT;
    for (int it = gw; it < NITEMS; it += NGW) {
        int r = it;
        if (r < I_IN) { const int kb = r / 80, nb = r % 80; p0_transpose_item(F.w_in, NPROJ, DM, F.WIN, 64 * kb, 64 * nb, (nb >> 2) * 256 + (nb & 3) * 32, 96, nullptr, scr, lane); continue; } r -= I_IN;
        { const int kb = r / 32, nb = r % 32; p0_transpose_item(F.w_out, DM, DM, F.WOUT, 64 * kb, 64 * nb, 64 * nb, 0, kb < 16 ? F.ga : F.gs - 1024, scr, lane); }
    }
    {
        f32x4 g1v[8];
#pragma unroll
        for (int j = 0; j < 4; ++j) { g1v[2 * j] = *(const f32x4*)(F.g1 + 8 * lane + 512 * j); g1v[2 * j + 1] = *(const f32x4*)(F.g1 + 8 * lane + 512 * j + 4); }
        for (int m = gw; m < NTOK; m += 2 * NGW) {
            const int m2 = m + NGW; const bool has2 = m2 < NTOK;
            const float* xr = F.x + (size_t)m * DM + 8 * lane; const float* xr2 = F.x + (size_t)(has2 ? m2 : m) * DM + 8 * lane;
            f32x4 v[8], u[8]; float s = 0.f, s2 = 0.f;
#pragma unroll
            for (int j = 0; j < 4; ++j) { v[2 * j] = __builtin_nontemporal_load((const f32x4*)(xr + 512 * j)); v[2 * j + 1] = __builtin_nontemporal_load((const f32x4*)(xr + 512 * j + 4)); u[2 * j] = __builtin_nontemporal_load((const f32x4*)(xr2 + 512 * j)); u[2 * j + 1] = __builtin_nontemporal_load((const f32x4*)(xr2 + 512 * j + 4)); }
#pragma unroll
            for (int j = 0; j < 8; ++j) { s += (v[j].x * v[j].x + v[j].y * v[j].y) + (v[j].z * v[j].z + v[j].w * v[j].w); s2 += (u[j].x * u[j].x + u[j].y * u[j].y) + (u[j].z * u[j].z + u[j].w * u[j].w); }
            const float rs = 1.0f / sqrtf(wave_sum(s) * (1.0f / DM) + EPS), rs2 = 1.0f / sqrtf(wave_sum(s2) * (1.0f / DM) + EPS);
#pragma unroll
            for (int j = 0; j < 4; ++j) { const f32x4 a = v[2 * j] * rs * g1v[2 * j], b = v[2 * j + 1] * rs * g1v[2 * j + 1]; u32x4 o; o.x = cvt_pk_bf16(a.x, a.y); o.y = cvt_pk_bf16(a.z, a.w); o.z = cvt_pk_bf16(b.x, b.y); o.w = cvt_pk_bf16(b.z, b.w);
                *(u32x4*)(F.H + (size_t)m * DM + 8 * lane + 512 * j) = o; }
            if (has2) {
#pragma unroll
                for (int j = 0; j < 4; ++j) { const f32x4 a = u[2 * j] * rs2 * g1v[2 * j], b = u[2 * j + 1] * rs2 * g1v[2 * j + 1]; u32x4 o; o.x = cvt_pk_bf16(a.x, a.y); o.y = cvt_pk_bf16(a.z, a.w); o.z = cvt_pk_bf16(b.x, b.y); o.w = cvt_pk_bf16(b.z, b.w);
                    *(u32x4*)(F.H + (size_t)m2 * DM + 8 * lane + 512 * j) = o; } }
        }
    }
    const int gt = F.vcu * 512 + F.tid, NGT = F.G * 512;
    for (int i = gt; i < 16 * 128 * 128; i += NGT) { const float v = F.w_sp[i]; F.WSP[i] = (bf16)(cvt_pk_bf16(v, 0.f) & 0xffffu); }
    for (int i = gt; i < NE * DM; i += NGT) { const int e = i / DM, d = i % DM; const float v = F.w_r[(size_t)d * NE + e]; const unsigned hi = cvt_pk_bf16(v, 0.f) & 0xffffu; const float lo = v - __uint_as_float(hi << 16);
        F.WRH[i] = (bf16)hi; F.WRL[i] = (bf16)(cvt_pk_bf16(lo, 0.f) & 0xffffu); }
}

typedef short v4i16_t __attribute__((ext_vector_type(4)));
__device__ __forceinline__ s16x4 tr_read(const LAS unsigned char* p) { return __builtin_bit_cast(s16x4, __builtin_amdgcn_ds_read_tr16_b64_v4i16((LAS v4i16_t*)p)); }
__device__ __forceinline__ void attn_unit(Frame& F, int b, int h, int band) {
    constexpr int SLOT = 16384;
    LAS unsigned char* ring = F.lds;
    LAS float* rpbL = (LAS float*)(F.lds + AT_RPB);
    LAS unsigned* mrg = (LAS unsigned*)(F.lds + AT_MRG);
    const int tid = F.tid, lane = F.lane, w = F.wave, fr = lane & 15, quad = lane >> 4;
    const int cg = w & 3, hf8 = w >> 2;
    const int c0 = 16 * cg, w0 = (cg == 0) ? 0 : (cg == 1) ? 8 : (cg == 2) ? 24 : 32;
    const int qc = c0 + fr; const int cs = min(max(qc - 8, 0), 48);
    const int R0 = band * 16;
    __syncthreads();
    for (int i = tid; i < 480; i += 512) { const int ro = i >> 5, co = i & 31; rpbL[i] = co < 31 ? F.rpb[h * 465 + ro * 31 + co] * 1.4426950408889634f : -INFINITY; }
    int cooff[2][4];
#pragma unroll
    for (int hf = 0; hf < 2; ++hf)
#pragma unroll
        for (int i = 0; i < 4; ++i) { const int kc = w0 + 16 * hf + 4 * quad + i; const bool valid = (kc >= cs) && (kc < cs + 16); cooff[hf][i] = 4 * (valid ? kc - qc + 15 : 31); }
    const char* projb = (const char*)F.PROJ + (size_t)b * SEQ * NPROJ * 2; const unsigned ringb = (unsigned)(size_t)ring;
    const unsigned lane_src = (unsigned)((8 * w + (lane >> 3)) * NPROJ + 1024 + h * 64) * 2u + (unsigned)(((lane & 7) ^ (lane >> 3)) * 16);
#define ROW_DMA(rowabs) do { const char* src_ = projb + (size_t)(rowabs) * 64 * NPROJ * 2 + lane_src; const unsigned sb_ = ringb + (unsigned)(((rowabs) % 9) * SLOT + w * 1024); \
        glds16(src_, sb_); glds16(src_ + 2048, sb_ + 8192u); } while (0)
    const int rs0 = min(max(R0 - 4, 0), 120);
    for (int j = 0; j < 8; ++j) ROW_DMA(rs0 + j);
    int loaded_hi = rs0 + 7;
    const bf16* qbase = F.PROJ + ((size_t)b * SEQ + qc) * NPROJ + h * 64 + 8 * quad;
    bf16x8 qa = *(const bf16x8*)(qbase + (size_t)R0 * 64 * NPROJ), qb = *(const bf16x8*)(qbase + (size_t)R0 * 64 * NPROJ + 32);
    VM_WAIT(); __syncthreads();
    for (int step = 0; step < 16; ++step) {
        const int r = R0 + step, rs = min(max(r - 4, 0), 120);
        bf16x8 qf0 = qa, qf1 = qb;
        if (step < 15) { const int nh = min(max(r - 3, 0), 120) + 7; if (nh > loaded_hi) { ROW_DMA(nh); loaded_hi = nh; }
            qa = *(const bf16x8*)(qbase + (size_t)(r + 1) * 64 * NPROJ); qb = *(const bf16x8*)(qbase + (size_t)(r + 1) * 64 * NPROJ + 32); }
        f32x4 s[4][2];
#pragma unroll
        for (int kr = 0; kr < 4; ++kr) { const int sb = ((rs + 4 * hf8 + kr) % 9) * SLOT;
#pragma unroll
            for (int hf = 0; hf < 2; ++hf) { const int key = w0 + 16 * hf + fr;
                const bf16x8 a0 = *(const LAS bf16x8*)(ring + sb + key * 128 + ((quad ^ (key & 7)) << 4));
                const bf16x8 a1 = *(const LAS bf16x8*)(ring + sb + key * 128 + (((quad + 4) ^ (key & 7)) << 4));
                f32x4 z = {0.f, 0.f, 0.f, 0.f};
                z = __builtin_amdgcn_mfma_f32_16x16x32_bf16(a0, qf0, z, 0, 0, 0);
                z = __builtin_amdgcn_mfma_f32_16x16x32_bf16(a1, qf1, z, 0, 0, 0);
                s[kr][hf] = z; } }
        float mx = -INFINITY;
        { const LAS unsigned char* bb = (const LAS unsigned char*)rpbL + (rs + 4 * hf8 - r + 7) * 128;
#pragma unroll
            for (int kr = 0; kr < 4; ++kr)
#pragma unroll
                for (int hf = 0; hf < 2; ++hf)
#pragma unroll
                    for (int i = 0; i < 4; ++i) { const float v = s[kr][hf][i] + *(const LAS float*)(bb + kr * 128 + cooff[hf][i]); s[kr][hf][i] = v; mx = fmaxf(mx, v); } }
        mx = fmaxf(mx, __shfl_xor(mx, 16)); mx = fmaxf(mx, __shfl_xor(mx, 32));
        float lsum = 0.f; bf16x8 pf[4];
#pragma unroll
        for (int kr = 0; kr < 4; ++kr) { float p[8];
#pragma unroll
            for (int i = 0; i < 8; ++i) { p[i] = __builtin_amdgcn_exp2f(s[kr][i >> 2][i & 3] - mx); lsum += p[i]; }
            u32x4 pk; pk.x = cvt_pk_bf16(p[0], p[1]); pk.y = cvt_pk_bf16(p[2], p[3]); pk.z = cvt_pk_bf16(p[4], p[5]); pk.w = cvt_pk_bf16(p[6], p[7]); pf[kr] = __builtin_bit_cast(bf16x8, pk); }
        lsum += __shfl_xor(lsum, 16); lsum += __shfl_xor(lsum, 32);
        f32x4 o[4];
#pragma unroll
        for (int dt = 0; dt < 4; ++dt) o[dt] = (f32x4){0.f, 0.f, 0.f, 0.f};
#pragma unroll
        for (int kr = 0; kr < 4; ++kr) { const int sb = ((rs + 4 * hf8 + kr) % 9) * SLOT + 8192; const int key = w0 + 4 * quad + (fr >> 2), pp = fr & 3;
#pragma unroll
            for (int dt = 0; dt < 4; ++dt) { const int c = 2 * dt + (pp >> 1); const int ad = sb + key * 128 + ((c ^ (key & 7)) << 4) + 8 * (pp & 1);
                const s16x4 lo = tr_read(ring + ad), hi = tr_read(ring + ad + 16 * 128);
                const bf16x8 vf = __builtin_shufflevector(lo, hi, 0, 1, 2, 3, 4, 5, 6, 7);
                o[dt] = __builtin_amdgcn_mfma_f32_16x16x32_bf16(vf, pf[kr], o[dt], 0, 0, 0); } }
        if (w >= 4) { LAS unsigned* m = mrg + (w - 4) * 640 + lane; m[0] = __float_as_uint(mx); m[64] = __float_as_uint(lsum);
#pragma unroll
            for (int dt = 0; dt < 4; ++dt) { m[(2 + 2 * dt) * 64] = cvt_pk_bf16(o[dt][0], o[dt][1]); m[(3 + 2 * dt) * 64] = cvt_pk_bf16(o[dt][2], o[dt][3]); } }
        __syncthreads();
        if (w < 4) { const LAS unsigned* m = mrg + w * 640 + lane; const float mx2 = __uint_as_float(m[0]), l2 = __uint_as_float(m[64]);
            const float mm = fmaxf(mx, mx2), a1 = __builtin_amdgcn_exp2f(mx - mm), a2 = __builtin_amdgcn_exp2f(mx2 - mm); const float inv = 1.0f / (lsum * a1 + l2 * a2);
            const float f1 = a1 * inv, f2 = a2 * inv; float ssq = 0.f;
            bf16* op = F.MIX + ((size_t)b * SEQ + (size_t)r * 64 + qc) * DM + h * 64 + 4 * quad;
            u32x2 pk[4];
#pragma unroll
            for (int dt = 0; dt < 4; ++dt) { const unsigned u0 = m[(2 + 2 * dt) * 64], u1 = m[(3 + 2 * dt) * 64];
                const float v0 = o[dt][0] * f1 + bflo(u0) * f2, v1 = o[dt][1] * f1 + bfhi(u0) * f2, v2 = o[dt][2] * f1 + bflo(u1) * f2, v3 = o[dt][3] * f1 + bfhi(u1) * f2;
                ssq += (v0 * v0 + v1 * v1) + (v2 * v2 + v3 * v3);
                pk[dt].x = cvt_pk_bf16(v0, v1); pk[dt].y = cvt_pk_bf16(v2, v3); }
            ssq += __shfl_xor(ssq, 16); ssq += __shfl_xor(ssq, 32);
            VM_WAIT();
#pragma unroll
            for (int dp = 0; dp < 2; ++dp) *(u32x4*)(op + 32 * dp + ((quad & 1) ? 12 : 0)) = pair16(pk[2 * dp], pk[2 * dp + 1]);
            if (quad == 0) F.SSQA[((size_t)b * SEQ + (size_t)r * 64 + qc) * 16 + h] = ssq; }
        else VM_WAIT();
        __syncthreads();
    }
#undef ROW_DMA
}

__device__ __forceinline__ void sgu_unit(Frame& F, int unit) {
    LAS unsigned char* Gn = F.lds;
    LAS float* rsG = (LAS float*)(F.lds + 16384);
    const int tid = F.tid, lane = F.lane, w = F.wave, fr = lane & 15, quad = lane >> 4;
    const size_t tk0 = (size_t)unit * 128;
    __syncthreads();
    if (tid < 128) { const f32x4* sp = (const f32x4*)(F.SSG + (tk0 + tid) * 16); const f32x4 a = sp[0], b2 = sp[1], c = sp[2], d = sp[3];
        const float ss = ((a.x + a.y) + (a.z + a.w)) + ((b2.x + b2.y) + (b2.z + b2.w)) + ((c.x + c.y) + (c.z + c.w)) + ((d.x + d.y) + (d.z + d.w)); rsG[tid] = 1.0f / sqrtf(ss * (1.0f / 1024.0f) + EPS); }
    else if (tid < 256) { const int q = tid - 128; const f32x4* sp = (const f32x4*)(F.SSQA + (tk0 + q) * 16); const f32x4 a = sp[0], b2 = sp[1], c = sp[2], d = sp[3];
        const float ss = ((a.x + a.y) + (a.z + a.w)) + ((b2.x + b2.y) + (b2.z + b2.w)) + ((c.x + c.y) + (c.z + c.w)) + ((d.x + d.y) + (d.z + d.w)); F.RA[tk0 + q] = 1.0f / sqrtf(ss * (1.0f / 1024.0f) + EPS); }
    float ssq = 0.f; const int p = 16 * w + fr;
    const bf16* gsrc0 = F.PROJ + (tk0 + (tid >> 3)) * NPROJ + 4096 + (tid & 7) * 8;
    const bf16* usrc = F.PROJ + (tk0 + p) * NPROJ + 3072 + 4 * quad;
    const bf16* wsrc = F.WSP + (size_t)p * 128 + 8 * quad;
    u32x4 gv0 = *(const u32x4*)(gsrc0), gv1 = *(const u32x4*)(gsrc0 + (size_t)64 * NPROJ);
    u32x2 uv[4]; bf16x8 wv[4];
#pragma unroll
    for (int dt = 0; dt < 4; ++dt) { uv[dt] = *(const u32x2*)(usrc + 16 * dt); wv[dt] = *(const bf16x8*)(wsrc + 32 * dt); }
    for (int gi = 0; gi < 16; ++gi) {
        __syncthreads();
#pragma unroll
        for (int j = 0; j < 2; ++j) { const int q = (tid >> 3) + 64 * j, c = tid & 7; const u32x4 v = j ? gv1 : gv0; const float rr = rsG[q];
            const f32x4 ga = *(const f32x4*)(F.gsg + gi * 64 + c * 8), gb = *(const f32x4*)(F.gsg + gi * 64 + c * 8 + 4);
            u32x4 o; o.x = cvt_pk_bf16(bflo(v.x) * rr * ga.x, bfhi(v.x) * rr * ga.y); o.y = cvt_pk_bf16(bflo(v.y) * rr * ga.z, bfhi(v.y) * rr * ga.w);
            o.z = cvt_pk_bf16(bflo(v.z) * rr * gb.x, bfhi(v.z) * rr * gb.y); o.w = cvt_pk_bf16(bflo(v.w) * rr * gb.z, bfhi(v.w) * rr * gb.w);
            *(LAS u32x4*)(Gn + q * 128 + ((c ^ (q & 7)) << 4)) = o; }
        u32x2 uc[4]; bf16x8 wf[4];
#pragma unroll
        for (int dt = 0; dt < 4; ++dt) { uc[dt] = uv[dt]; wf[dt] = wv[dt]; }
        if (gi < 15) { gv0 = *(const u32x4*)(gsrc0 + (gi + 1) * 64); gv1 = *(const u32x4*)(gsrc0 + (size_t)64 * NPROJ + (gi + 1) * 64);
#pragma unroll
            for (int dt = 0; dt < 4; ++dt) { uv[dt] = *(const u32x2*)(usrc + (gi + 1) * 64 + 16 * dt); wv[dt] = *(const bf16x8*)(wsrc + (size_t)(gi + 1) * 16384 + 32 * dt); } }
        __syncthreads();
        f32x4 acc[4];
#pragma unroll
        for (int dt = 0; dt < 4; ++dt) acc[dt] = (f32x4){0.f, 0.f, 0.f, 0.f};
#pragma unroll
        for (int ks = 0; ks < 4; ++ks) { const int rowA = 32 * ks + 8 * quad + (fr >> 2), rowB = rowA + 4; const int pp = fr & 3;
#pragma unroll
            for (int dt = 0; dt < 4; ++dt) { const int c = 2 * dt + (pp >> 1);
                const s16x4 lo = tr_read(Gn + rowA * 128 + ((c ^ (rowA & 7)) << 4) + 8 * (pp & 1)), hi = tr_read(Gn + rowB * 128 + ((c ^ (rowB & 7)) << 4) + 8 * (pp & 1));
                const bf16x8 af = __builtin_shufflevector(lo, hi, 0, 1, 2, 3, 4, 5, 6, 7);
                acc[dt] = __builtin_amdgcn_mfma_f32_16x16x32_bf16(af, wf[ks], acc[dt], 0, 0, 0); } }
        const float bs = F.b_sp[gi * 128 + p];
        u32x2 pk[4];
#pragma unroll
        for (int dt = 0; dt < 4; ++dt) { const u32x2 uu = uc[dt];
            const float s0 = bflo(uu.x) * (acc[dt][0] + bs), s1 = bfhi(uu.x) * (acc[dt][1] + bs), s2 = bflo(uu.y) * (acc[dt][2] + bs), s3 = bfhi(uu.y) * (acc[dt][3] + bs);
            ssq += (s0 * s0 + s1 * s1) + (s2 * s2 + s3 * s3);
            pk[dt].x = cvt_pk_bf16(s0, s1); pk[dt].y = cvt_pk_bf16(s2, s3); }
#pragma unroll
        for (int dp = 0; dp < 2; ++dp) *(u32x4*)(F.MIX + (tk0 + p) * DM + 1024 + gi * 64 + 32 * dp + 4 * quad + ((quad & 1) ? 12 : 0)) = pair16(pk[2 * dp], pk[2 * dp + 1]);
    }
    ssq += __shfl_xor(ssq, 16); ssq += __shfl_xor(ssq, 32);
    if (quad == 0) F.RB[tk0 + p] = 1.0f / sqrtf(ssq * (1.0f / 1024.0f) + EPS);
}

__device__ __forceinline__ void router_unit(Frame& F, int unit) {
    constexpr int WROW = 544, WBUF = 64 * WROW;
    LAS unsigned char* wimg = F.lds;
    LAS float* lgL = (LAS float*)(F.lds + 2 * WBUF);
    LAS unsigned* histL = (LAS unsigned*)(F.lds + 2 * WBUF + 16896); LAS unsigned* baseL = histL + 32;
    const int tid = F.tid, lane = F.lane, w = F.wave, fr = lane & 15, quad = lane >> 4;
    const int token = unit * 128 + 16 * w + fr;
    __syncthreads();
    if (tid < 32) histL[tid] = 0u;
    const float* xrow = F.out + (size_t)token * DM + 8 * quad;
    unsigned char* trow = F.H8 + (size_t)token * DM + 8 * quad;
    f32x4 acc[2]; acc[0] = (f32x4){0.f, 0.f, 0.f, 0.f}; acc[1] = acc[0];
    float rstd;
    { const f32x4 p0 = *(const f32x4*)(F.SSX + (size_t)token * 32 + 8 * quad), p1 = *(const f32x4*)(F.SSX + (size_t)token * 32 + 8 * quad + 4);
      float ss = ((p0.x + p0.y) + (p0.z + p0.w)) + ((p1.x + p1.y) + (p1.z + p1.w)); ss += __shfl_xor(ss, 16); ss += __shfl_xor(ss, 32); rstd = 1.0f / sqrtf(ss * (1.0f / DM) + EPS); }
    u32x4 wst[4];
#define RT_WLOAD(c) do { _Pragma("unroll") for (int j = 0; j < 4; ++j) { const int id = j * 512 + tid, row = id >> 5, cc = id & 31; \
        wst[j] = *(const u32x4*)((row < 32 ? F.WRH + (size_t)row * DM : F.WRL + (size_t)(row - 32) * DM) + 256 * (c) + 8 * cc); } } while (0)
#define RT_WSTORE(b) do { _Pragma("unroll") for (int j = 0; j < 4; ++j) { const int id = j * 512 + tid, row = id >> 5, cc = id & 31; *(LAS u32x4*)(wimg + (b) * WBUF + row * WROW + cc * 16) = wst[j]; } } while (0)
    RT_WLOAD(0); RT_WSTORE(0);
    __syncthreads();
    for (int c = 0; c < 8; ++c) {
        if (c < 7) RT_WLOAD(c + 1);
        const LAS unsigned char* wb = wimg + (c & 1) * WBUF + fr * WROW + quad * 16;
#pragma unroll 2
        for (int kp = 0; kp < 4; ++kp) {
            u32x2 t8[2];
#pragma unroll
            for (int h2 = 0; h2 < 2; ++h2) { const int kl = 2 * kp + h2, ks = 8 * c + kl;
                const f32x4 xa = *(const f32x4*)(xrow + 32 * ks), xb = *(const f32x4*)(xrow + 32 * ks + 4);
                const f32x4 ga = *(const f32x4*)(F.g2 + 32 * ks + 8 * quad), gb = *(const f32x4*)(F.g2 + 32 * ks + 8 * quad + 4);
                const f32x4 ya = xa * ga * rstd, yb = xb * gb * rstd;
                u32x4 h; h.x = cvt_pk_bf16(ya.x, ya.y); h.y = cvt_pk_bf16(ya.z, ya.w); h.z = cvt_pk_bf16(yb.x, yb.y); h.w = cvt_pk_bf16(yb.z, yb.w);
                u32x4 l; l.x = cvt_pk_bf16(ya.x - bflo(h.x), ya.y - bfhi(h.x)); l.y = cvt_pk_bf16(ya.z - bflo(h.y), ya.w - bfhi(h.y)); l.z = cvt_pk_bf16(yb.x - bflo(h.z), yb.y - bfhi(h.z)); l.w = cvt_pk_bf16(yb.z - bflo(h.w), yb.w - bfhi(h.w));
                t8[h2].x = pk4_fp8(ya.x, ya.y, ya.z, ya.w); t8[h2].y = pk4_fp8(yb.x, yb.y, yb.z, yb.w);
                const bf16x8 yh = __builtin_bit_cast(bf16x8, h), yl = __builtin_bit_cast(bf16x8, l);
#pragma unroll
                for (int et = 0; et < 2; ++et) {
                    const bf16x8 wh = *(const LAS bf16x8*)(wb + (16 * et) * WROW + kl * 64), wl = *(const LAS bf16x8*)(wb + (32 + 16 * et) * WROW + kl * 64);
                    acc[et] = __builtin_amdgcn_mfma_f32_16x16x32_bf16(wh, yh, acc[et], 0, 0, 0);
                    acc[et] = __builtin_amdgcn_mfma_f32_16x16x32_bf16(wh, yl, acc[et], 0, 0, 0);
                    acc[et] = __builtin_amdgcn_mfma_f32_16x16x32_bf16(wl, yh, acc[et], 0, 0, 0); } }
            *(u32x4*)(trow + 64 * (4 * c + kp) + ((quad & 1) ? 24 : 0)) = pair16(t8[0], t8[1]);
        }
        if (c < 7) RT_WSTORE((c + 1) & 1);
        __syncthreads();
    }
#undef RT_WLOAD
#undef RT_WSTORE
#pragma unroll
    for (int et = 0; et < 2; ++et)
#pragma unroll
        for (int i = 0; i < 4; ++i) { const int e = 16 * et + 4 * quad + i; lgL[(w * 16 + fr) * 33 + e] = acc[et][i] + F.b_r[e]; }
    __syncthreads();
    int ev[4]; float gv[4]; unsigned lp[4];
    const int mytok = unit * 128 + 16 * w + lane;
    if (lane < 16) {
        const LAS float* lg = lgL + (w * 16 + lane) * 33; unsigned mask = 0u; float vv[4];
#pragma unroll
        for (int k = 0; k < 4; ++k) { float best = -INFINITY; int bi = 0;
            for (int e = 0; e < 32; ++e) { const float v = lg[e]; if (!((mask >> e) & 1u) && v > best) { best = v; bi = e; } }
            mask |= 1u << bi; ev[k] = bi; vv[k] = best; }
        const float e1 = __expf(vv[1] - vv[0]), e2 = __expf(vv[2] - vv[0]), e3 = __expf(vv[3] - vv[0]); const float inv = 1.0f / (1.0f + e1 + e2 + e3);
        gv[0] = inv; gv[1] = e1 * inv; gv[2] = e2 * inv; gv[3] = e3 * inv;
#pragma unroll
        for (int k = 0; k < 4; ++k) lp[k] = __hip_atomic_fetch_add(histL + ev[k], 1u, __ATOMIC_RELAXED, __HIP_MEMORY_SCOPE_WORKGROUP);
    }
    __syncthreads();
    if (tid < 32) baseL[tid] = __hip_atomic_fetch_add((unsigned*)(F.ctl + CW_CNT + 64 * tid), histL[tid], RLX_AGENT);
    __syncthreads();
    if (lane < 16) {
#pragma unroll
        for (int k = 0; k < 4; ++k) { const unsigned pos = baseL[ev[k]] + lp[k];
            F.LIST[(size_t)ev[k] * CAP + pos] = mytok * 4 + k; F.GATE[(size_t)mytok * 4 + k] = gv[k]; }
    }
}

__device__ __forceinline__ int moe_tables(Frame& F) {
    LAS int* cntL = (LAS int*)(F.lds + XT_CNT); LAS int* tstartL = (LAS int*)(F.lds + XT_TSTART); LAS unsigned char* tileE = F.lds + XT_TILEE;
    __syncthreads();
    if (F.tid < 32) cntL[F.tid] = (int)__hip_atomic_load((unsigned*)(F.ctl + CW_CNT + 64 * F.tid), RLX_AGENT);
    __syncthreads();
    if (F.tid == 0) { int s = 0; for (int e = 0; e < 32; ++e) { tstartL[e] = s; s += (cntL[e] + 255) >> 8; } tstartL[32] = s; }
    __syncthreads();
    const int total = tstartL[32];
    for (int mt = F.tid; mt < total; mt += 512) { int e = 0; for (int k = 1; k < 32; ++k) e += (tstartL[k] <= mt) ? 1 : 0; tileE[mt] = (unsigned char)e; }
    __syncthreads();
    return __builtin_amdgcn_readfirstlane(total);
}

struct Args { const float* in[19]; float* out; unsigned char* ws; int ph_lo, ph_hi; };
__global__ void __launch_bounds__(NWAVES * 64, 2) mk_fwd(Args args) {
    extern __shared__ __attribute__((aligned(16))) unsigned char lds[];
    Frame F;
    F.lds = (LAS unsigned char*)lds;
    F.MISC = (volatile LAS unsigned*)(F.lds + MISC_OFF);
    F.tid = threadIdx.x; F.lane = F.tid & 63; F.wave = __builtin_amdgcn_readfirstlane(F.tid >> 6);
    F.G = gridDim.x; { const int bx = blockIdx.x; F.vcu = (F.G % 8 == 0) ? (bx % 8) * (F.G / 8) + bx / 8 : bx; }
    unsigned char* ws = args.ws;
    F.ctl = (gu32*)(ws + WS_CTL);
    F.x = args.in[0]; F.g1 = args.in[1]; F.w_in = args.in[2]; F.gq = args.in[3]; F.gk = args.in[4]; F.rpb = args.in[5]; F.gsg = args.in[6]; F.w_sp = args.in[7]; F.b_sp = args.in[8];
    F.ga = args.in[9]; F.gs = args.in[10]; F.w_out = args.in[11]; F.g2 = args.in[12]; F.w_r = args.in[13]; F.b_r = args.in[14]; F.w_gu = args.in[15]; F.b_gu = args.in[16]; F.w_dn = args.in[17]; F.b_dn = args.in[18];
    F.out = args.out;
    F.WIN = (bf16*)(ws + WS_WIN); F.WOUT = (bf16*)(ws + WS_WOUT); F.WSP = (bf16*)(ws + WS_WSP); F.WRH = (bf16*)(ws + WS_WRH); F.WRL = (bf16*)(ws + WS_WRL);
    F.WGU = ws + WS_WGU; F.WDN = ws + WS_WDN; F.H = (bf16*)(ws + WS_H); F.H8 = ws + WS_H; F.PROJ = (bf16*)(ws + WS_PROJ); F.MIX = (bf16*)(ws + WS_MIX);
    F.ACT = ws + WS_ACT; F.Y = ws + WS_Y; F.SSX = (float*)(ws + WS_SSX); F.RA = (float*)(ws + WS_RA); F.RB = (float*)(ws + WS_RB); F.SSQA = (float*)(ws + WS_SSQA); F.SSG = (float*)(ws + WS_SSG); F.RSTD2 = (float*)(ws + WS_RSTD2); F.GATE = (float*)(ws + WS_GATE); F.SLOT = (unsigned*)(ws + WS_SLOT); F.LIST = (int*)(ws + WS_LIST);
    for (int u = F.tid; u < (LDS_BYTES - LDSCTL_OFF) / 4; u += NWAVES * 64) ((LAS unsigned*)(F.lds + LDSCTL_OFF))[u] = 0u;
    __syncthreads();
    XcdBarrier bar; bar.bar = (unsigned*)(F.ctl + CW_BAR); bar.x = 0; bar.st = nullptr;
    if (N_LAUNCHES == 1) bar = xcd_barrier_post((unsigned*)(F.ctl + CW_BAR), F.MISC + 8);
#define GRID_BAR() do { if (N_LAUNCHES == 1) xcd_barrier(bar); } while (0)
    const int lo = args.ph_lo, hi = args.ph_hi;
#define IN(k) (lo <= (k) && (k) < hi)
#define BOTH(k) (IN(k) && IN((k) + 1))

    if (IN(0)) { p0_prologue(F); if (BOTH(0)) GRID_BAR(); }

    if (IN(1)) {
        TileOrder S; S.init(NTOK / BM, NPROJ / BM, F.G, (int)blockIdx.x, nullptr);
        EpiProjX E{F.PROJ, F.gq, F.gk, F.SSG};
        const int grp = F.vcu & 1, nconv = (NE * (16 * 16 + 16 * 8) - F.vcu + F.G - 1) / F.G, hconv = nconv / 2;
        moe_convert(F, 0, grp == 0 ? hconv : 0);
        S.ib = 0; S.ie = 5;
        gemm_phase<EpiProjX, false, true, false>(F.lds, (const char*)F.H, (const char*)F.WIN, 0, DM * 2, S, E, nullptr);
        moe_convert(F, grp == 0 ? hconv : 0, grp == 0 ? nconv : hconv);
        S.ib = 5; S.ie = 0x7fffffff;
        gemm_phase<EpiProjX, false, true, false>(F.lds, (const char*)F.H, (const char*)F.WIN, 0, DM * 2, S, E, nullptr);
        moe_convert(F, grp == 0 ? nconv : hconv, nconv);
        if (BOTH(1)) GRID_BAR();
    }

    if (IN(2)) {
        for (int u = F.vcu; u < NBATCH * 16 * 8; u += F.G) attn_unit(F, u >> 7, (u >> 3) & 15, u & 7);
        if (BOTH(2)) GRID_BAR();
    }

    if (IN(3)) {
        for (int u = F.vcu; u < NTOK / 128; u += F.G) sgu_unit(F, u);
        if (BOTH(3)) GRID_BAR();
    }

    if (IN(4)) {
        TileOrder S; S.init(NTOK / BM, DM / BM, F.G, (int)blockIdx.x, nullptr);
        EpiResid E{F.x, F.out, DM, F.RA, F.RB, F.SSX};
        gemm_phase<EpiResid, false, true, false>(F.lds, (const char*)F.MIX, (const char*)F.WOUT, 0, DM * 2, S, E, nullptr);
        if (BOTH(4)) GRID_BAR();
    }

    if (IN(5)) {
        for (int u = F.vcu; u < NTOK / 128; u += F.G) router_unit(F, u);
        if (BOTH(5)) GRID_BAR();
    }

    if (IN(6)) {
        const int total = moe_tables(F);
        LAS unsigned short* tokL = (LAS unsigned short*)(F.lds + XT_TOKL); const LAS int* cntL = (const LAS int*)(F.lds + XT_CNT); const LAS int* tstartL = (const LAS int*)(F.lds + XT_TSTART);
        TileOrder S; S.init(total, 16, F.G, (int)blockIdx.x, F.lds + XT_TILEE);
        { Unit u; for (int i = 0; i < 36 && S.next(i, u); ++i) { if (F.tid < 256) { const int lp = (u.pm - tstartL[u.e]) * 256 + F.tid; tokL[i * 256 + F.tid] = (unsigned short)(lp < cntL[u.e] ? (F.LIST[(size_t)u.e * CAP + lp] >> 2) : 0); } } }
        __syncthreads();
        EpiSwiglu E{F.ACT, F.b_gu, (const LAS float*)(F.lds + XT_BIAS), (unsigned)(size_t)(F.lds + XT_BIAS)};
        gemm_phase<EpiSwiglu, true, true, true>(F.lds, (const char*)F.H8, (const char*)F.WGU, (size_t)4096 * DM, DM, S, E, tokL);
        if (BOTH(6)) GRID_BAR();
    }

    if (IN(7)) {
        const int total = moe_tables(F);
        LAS unsigned* dstL = (LAS unsigned*)(F.lds + XT_TOKL); const LAS int* cntL = (const LAS int*)(F.lds + XT_CNT); const LAS int* tstartL = (const LAS int*)(F.lds + XT_TSTART);
        TileOrder S; S.init(total, 8, F.G, (int)blockIdx.x, F.lds + XT_TILEE);
        { Unit u; for (int i = 0; i < 18 && S.next(i, u); ++i) { if (F.tid < 256) { const int lp = (u.pm - tstartL[u.e]) * 256 + F.tid; dstL[i * 256 + F.tid] = lp < cntL[u.e] ? (unsigned)F.LIST[(size_t)u.e * CAP + lp] : (unsigned)(NTOK * TOPK); } } }
        __syncthreads();
        EpiDown E{F.Y, F.b_dn, dstL, (const LAS float*)(F.lds + XT_BIAS), (unsigned)(size_t)(F.lds + XT_BIAS)};
        gemm_phase<EpiDown, false, true, true>(F.lds, (const char*)F.ACT, (const char*)F.WDN, (size_t)DM * DM, DM, S, E, nullptr);
        if (BOTH(7)) GRID_BAR();
    }

    if (IN(8)) {
        const int gw = F.vcu * NWAVES + F.wave, NGW = F.G * NWAVES, lane = F.lane;
        for (int t = gw; t < NTOK; t += NGW) {
            const f32x4 gt = *(const f32x4*)(F.GATE + (size_t)t * 4);
            float* orow = F.out + (size_t)t * DM + 16 * lane; const unsigned char* yrow = F.Y + (size_t)t * 4 * DM + 16 * lane;
#pragma unroll
            for (int j = 0; j < 2; ++j) { f32x4 o[4];
#pragma unroll
                for (int q = 0; q < 4; ++q) o[q] = *(const f32x4*)(orow + 1024 * j + 4 * q);
#pragma unroll
                for (int k = 0; k < 4; ++k) { const u32x4 y = *(const u32x4*)(yrow + (size_t)k * DM + 1024 * j); const float g = gt[k];
#pragma unroll
                    for (int q = 0; q < 4; ++q) { const f32x2 lo = __builtin_amdgcn_cvt_pk_f32_fp8((int)y[q], false), hi = __builtin_amdgcn_cvt_pk_f32_fp8((int)y[q], true);
                        o[q].x += g * lo.x; o[q].y += g * lo.y; o[q].z += g * hi.x; o[q].w += g * hi.y; } }
#pragma unroll
                for (int q = 0; q < 4; ++q) *(f32x4*)(orow + 1024 * j + 4 * q) = o[q]; }
        }
    }
#undef IN
#undef BOTH
}

extern "C" void kernel_launch(void* const* d_in, const int* in_sizes, int n_in, void* d_out, int out_size, void* d_ws, size_t ws_size, hipStream_t stream) {
    static int grid = 0;
    if (grid == 0) {
        if (n_in != 19 || out_size != NTOK * DM || ws_size < WS_END) { fprintf(stderr, "kernel_launch: unexpected problem (n_in %d, out %d, ws %zu)\n", n_in, out_size, ws_size); grid = -1; return; }
        int dev = 0, cus = 0, per_cu = 0;
        if (hipGetDevice(&dev) != hipSuccess || hipDeviceGetAttribute(&cus, hipDeviceAttributeMultiprocessorCount, dev) != hipSuccess) { grid = -1; return; }
        if (hipFuncSetAttribute((const void*)mk_fwd, hipFuncAttributeMaxDynamicSharedMemorySize, LDS_BYTES) != hipSuccess) { fprintf(stderr, "kernel_launch: hipFuncSetAttribute failed\n"); grid = -1; return; }
        if (hipOccupancyMaxActiveBlocksPerMultiprocessor(&per_cu, (const void*)mk_fwd, NWAVES * 64, LDS_BYTES) != hipSuccess || per_cu < 1) { fprintf(stderr, "kernel_launch: occupancy query says %d\n", per_cu); }
        (void)hipGetLastError();
        grid = cus;
    }
    if (grid < 0) return;
    if (hipMemsetAsync((char*)d_ws + WS_CTL, 0, CTL_ZERO_BYTES, stream) != hipSuccess) return;
    Args a{};
    for (int i = 0; i < 19; ++i) a.in[i] = (const float*)d_in[i];
    a.out = (float*)d_out; a.ws = (unsigned char*)d_ws;
    for (int li = 0; li < N_LAUNCHES; ++li) {
        a.ph_lo = (N_LAUNCHES == 1) ? 0 : li; a.ph_hi = (N_LAUNCHES == 1) ? N_PHASES : li + 1;
        hipLaunchKernelGGL(mk_fwd, dim3(grid), dim3(NWAVES * 64), LDS_BYTES, stream, a);
    }
}
```

```cpp
#include <hip/hip_runtime.h>
#include <cstdio>
#include <cstdint>

#ifndef MK_N_LAUNCHES
#define MK_N_LAUNCHES 1
#endif
constexpr int N_LAUNCHES = MK_N_LAUNCHES;
constexpr int N_PHASES = 9;

#define LAS __attribute__((address_space(3)))
#define GAS __attribute__((address_space(1)))
typedef unsigned short bf16;
typedef short bf16x8 __attribute__((ext_vector_type(8)));
typedef short s16x4 __attribute__((ext_vector_type(4)));
typedef float f32x4 __attribute__((ext_vector_type(4)));
typedef float f32x2 __attribute__((ext_vector_type(2)));
typedef unsigned u32x4 __attribute__((ext_vector_type(4)));
typedef unsigned u32x2 __attribute__((ext_vector_type(2)));
typedef GAS unsigned gu32;
typedef int v8i __attribute__((ext_vector_type(8)));
typedef int v4i __attribute__((ext_vector_type(4)));

constexpr int NTOK = 32768, DM = 2048, NPROJ = 5120, SEQ = 8192, NBATCH = 4;
constexpr int NE = 32, TOPK = 4, CAP = 32768;
constexpr int MAXROWS = NTOK * TOPK + NE * 256;
constexpr float EPS = 1e-6f;
constexpr int NWAVES = 8;

constexpr size_t MiB = 1u << 20;
constexpr size_t WS_CTL = 0, CTL_ZERO_BYTES = 1 * MiB;
constexpr size_t WS_WIN = 2 * MiB;
constexpr size_t WS_WOUT = 22 * MiB;
constexpr size_t WS_WSP = 30 * MiB;
constexpr size_t WS_WRH = 31 * MiB;
constexpr size_t WS_WRL = 31 * MiB + 128 * 1024;
constexpr size_t WS_RSTD2 = 31 * MiB + 512 * 1024;
constexpr size_t WS_SLOT = 32 * MiB;
constexpr size_t WS_GATE = 32 * MiB + 512 * 1024;
constexpr size_t WS_LIST = 33 * MiB;
constexpr size_t WS_WGU = 40 * MiB;
constexpr size_t WS_SSQA = 300 * MiB;
constexpr size_t WS_SSG = 304 * MiB;
constexpr size_t WS_RA = 308 * MiB;
constexpr size_t WS_RB = 309 * MiB;
constexpr size_t WS_SSX = 312 * MiB;
constexpr size_t WS_WDN = 552 * MiB;
constexpr size_t WS_H = 808 * MiB;
constexpr size_t WS_PROJ = 936 * MiB;
constexpr size_t WS_MIX = 1256 * MiB;
constexpr size_t WS_ACT = 1384 * MiB;
constexpr size_t WS_Y = 1928 * MiB;
constexpr size_t WS_END = 2472 * MiB;

constexpr int CW_TMO = 0, CW_CODE = 1;
constexpr int CW_BAR = 4096;
constexpr int CW_CNT = 8192;

constexpr int RING_BYTES = 131072;
constexpr int XT_OFF = RING_BYTES;
constexpr int XT_TOKL = XT_OFF;
constexpr int XT_TILEE = XT_OFF + 18432;
constexpr int XT_TSTART = XT_TILEE + 576;
constexpr int XT_CNT = XT_TSTART + 160;
constexpr int XT_BIAS = XT_OFF + 19456;
constexpr int XT_GAINS = XT_BIAS + 2048;
constexpr int XT_MISC2 = XT_GAINS + 512;
constexpr int AT_RPB = 147456;
constexpr int AT_MRG = AT_RPB + 2048;
constexpr int LDSCTL_OFF = AT_MRG + 10240;
constexpr int MISC_OFF = LDSCTL_OFF + 320;
constexpr int LDS_BYTES = LDSCTL_OFF + 1024;
static_assert(XT_CNT + 128 <= XT_BIAS && XT_MISC2 <= LDSCTL_OFF && LDS_BYTES <= 160 * 1024, "LDS map");
constexpr int N_PH = 9;

#define RLX_AGENT __ATOMIC_RELAXED, __HIP_MEMORY_SCOPE_AGENT
#define LDS_WAIT() asm volatile("s_waitcnt lgkmcnt(0)" ::: "memory")
#define VM_WAIT() asm volatile("s_waitcnt vmcnt(0)" ::: "memory")

__device__ __forceinline__ unsigned cvt_pk_bf16(float lo, float hi) { unsigned r; asm volatile("v_cvt_pk_bf16_f32 %0, %1, %2" : "=v"(r) : "v"(lo), "v"(hi)); return r; }
__device__ __forceinline__ unsigned pk4_fp8(float a, float b, float c, float d) { int w = 0; w = __builtin_amdgcn_cvt_pk_fp8_f32(a, b, w, false); w = __builtin_amdgcn_cvt_pk_fp8_f32(c, d, w, true); return (unsigned)w; }
__device__ __forceinline__ v8i cat8(bf16x8 a, bf16x8 b) { const v4i x = __builtin_bit_cast(v4i, a), y = __builtin_bit_cast(v4i, b); return __builtin_shufflevector(x, y, 0, 1, 2, 3, 4, 5, 6, 7); }
__device__ __forceinline__ bf16x8 lo8(v8i a) { return __builtin_bit_cast(bf16x8, (v4i)__builtin_shufflevector(a, a, 0, 1, 2, 3)); }
__device__ __forceinline__ bf16x8 hi8(v8i a) { return __builtin_bit_cast(bf16x8, (v4i)__builtin_shufflevector(a, a, 4, 5, 6, 7)); }
__device__ __forceinline__ void glds16(const void* gsrc, unsigned lds_dst) { unsigned keep;
    asm volatile("s_mov_b32 %0, m0\n\ts_mov_b32 m0, %2\n\ts_nop 0\n\tglobal_load_lds_dwordx4 %1, off\n\ts_mov_b32 m0, %0" : "=&s"(keep) : "v"(gsrc), "s"(lds_dst) : "memory"); }
__device__ __forceinline__ u32x4 pair16(u32x2 a, u32x2 b) { const auto s0 = __builtin_amdgcn_permlane16_swap(a.x, b.x, false, false), s1 = __builtin_amdgcn_permlane16_swap(a.y, b.y, false, false);
    u32x4 w; w.x = s0[0]; w.y = s1[0]; w.z = s0[1]; w.w = s1[1]; return w; }
__device__ __forceinline__ float bflo(unsigned u) { return __uint_as_float(u << 16); }
__device__ __forceinline__ float bfhi(unsigned u) { return __uint_as_float(u & 0xffff0000u); }
__device__ __forceinline__ float wave_sum(float v) {
#pragma unroll
    for (int o = 1; o < 64; o <<= 1) v += __shfl_xor(v, o);
    return v;
}
__device__ __forceinline__ f32x2 gelu_pk(f32x2 v) {
    const f32x2 av = __builtin_elementwise_abs(v), d = av * 0.2316418882f + 1.0f;
    f32x2 t; t.x = __builtin_amdgcn_rcpf(d.x); t.y = __builtin_amdgcn_rcpf(d.y);
    f32x2 q = t * 0.5307027145f + (-0.7265760135f); q = q * t + 0.7107068705f; q = q * t + (-0.142248368f); q = q * t + 0.127414796f; q = q * t;
    const f32x2 s = (v * v) * (-0.72134752044f);
    f32x2 e; e.x = __builtin_amdgcn_exp2f(s.x); e.y = __builtin_amdgcn_exp2f(s.y);
    const f32x2 m = v * (q * e), r = v - m;
    f32x2 o; o.x = v.x < 0.f ? m.x : r.x; o.y = v.y < 0.f ? m.y : r.y; return o;
}
__device__ __forceinline__ float gelu1(float x) { f32x2 r = gelu_pk((f32x2){x, x}); return r.x; }

#define XB_TMO      128
#define XB_XCNT(j)  (256  + 64 * (j))
#define XB_XSUB(j)  (1280 + 64 * (j))
#define XB_XGEN(j)  (2304 + 64 * (j))
#define XB_TOP      3328
#define XB_TOPGEN   3392
#define XCD_BAR_WORDS 3456
#define XB_SPIN_CAP (1u << 18)
__device__ __forceinline__ unsigned xb_ld(unsigned* p)              { return __hip_atomic_load(p, __ATOMIC_RELAXED, __HIP_MEMORY_SCOPE_AGENT); }
__device__ __forceinline__ unsigned xb_add(unsigned* p, unsigned v) { return __hip_atomic_fetch_add(p, v, __ATOMIC_RELAXED, __HIP_MEMORY_SCOPE_AGENT); }
__device__ __forceinline__ unsigned xb_xcc_id() { return (unsigned)__builtin_amdgcn_s_getreg((3 << 11) | 20) & 0xFu; }
#define XB_SPIN(cond, bar) do { unsigned _sp = 0; while (cond) { __builtin_amdgcn_s_sleep(1); \
    if ((++_sp & 255u) == 0u) { if (xb_ld(&(bar)[XB_TMO])) break; if (_sp > XB_SPIN_CAP) { atomicAdd(&(bar)[XB_TMO], 1u); break; } } } } while (0)
struct XcdBarrier { unsigned* bar; unsigned x; volatile LAS unsigned* st; };
__device__ __forceinline__ XcdBarrier xcd_barrier_post(unsigned* bar, volatile LAS unsigned* st) {
    XcdBarrier b; b.bar = bar; b.x = xb_xcc_id(); b.st = st;
    if (threadIdx.x == 0) (void)xb_add(&bar[XB_XCNT(b.x)], 1u);
    return b;
}
__device__ __forceinline__ void xcd_barrier_complete(unsigned* bar, unsigned x, unsigned& nloc, unsigned& nx) {
    const unsigned G = gridDim.x * gridDim.y * gridDim.z;
    unsigned sum, cnt, mine, sp = 0u;
    for (;;) {
        sum = 0u; cnt = 0u; mine = 0u;
#pragma unroll
        for (unsigned j = 0; j < 16; ++j) { const unsigned c = xb_ld(&bar[XB_XCNT(j)]); sum += c; cnt += (c > 0u) ? 1u : 0u; mine = (j == x) ? c : mine; }
        if (sum == G) break;
        __builtin_amdgcn_s_sleep(1);
        if ((++sp & 255u) == 0u) { if (xb_ld(&bar[XB_TMO])) break; if (sp > XB_SPIN_CAP) { atomicAdd(&bar[XB_TMO], 1u); break; } }
    }
    nloc = mine > 0u ? mine : 1u; nx = cnt > 0u ? cnt : 1u;
}
__device__ __forceinline__ void xcd_barrier(const XcdBarrier& b) {
    asm volatile("s_waitcnt vmcnt(0)" ::: "memory");
    __syncthreads();
    if (threadIdx.x == 0) {
        unsigned* bar = b.bar;
        __builtin_amdgcn_s_waitcnt(0);
        unsigned nloc = b.st[0], nx = b.st[1];
        if (nloc == 0u) { xcd_barrier_complete(bar, b.x, nloc, nx); b.st[0] = nloc; b.st[1] = nx; }
        const unsigned old = xb_add(&bar[XB_XSUB(b.x)], 1u);
        const unsigned gen = old / nloc;
        if (old + 1u == (gen + 1u) * nloc) {
            __builtin_amdgcn_fence(__ATOMIC_RELEASE, "agent");
            asm volatile("s_waitcnt vmcnt(0)" ::: "memory");
            const unsigned og = xb_add(&bar[XB_TOP], 1u);
            const unsigned tg = og / nx;
            if (og + 1u == (tg + 1u) * nx) xb_add(&bar[XB_TOPGEN], 1u);
            else XB_SPIN(xb_ld(&bar[XB_TOPGEN]) == tg, bar);
            __builtin_amdgcn_fence(__ATOMIC_ACQUIRE, "agent");
            xb_add(&bar[XB_XGEN(b.x)], 1u);
            asm volatile("s_waitcnt vmcnt(0)" ::: "memory");
        } else {
            XB_SPIN(xb_ld(&bar[XB_XGEN(b.x)]) == gen, bar);
            __builtin_amdgcn_fence(__ATOMIC_ACQUIRE, "agent");
            asm volatile("s_waitcnt vmcnt(0)" ::: "memory");
        }
    }
    __syncthreads();
}

constexpr int BM = 256, BK = 64, HALF = 128, HTB = HALF * BK * 2, NXCD = 8, WGM = 8;
__host__ __device__ __forceinline__ int lds_byte(int r, int c) { const int st = (r >> 4) * 2 + (c >> 5), rr = r & 15, cc = c & 31, ob = rr * 64 + cc * 2; return st * 1024 + (ob ^ (((ob >> 9) & 1) << 5)); }
__host__ __device__ __forceinline__ void stage_rc(int b, int& R, int& C) { const int st = b / 1024, sb = b % 1024, swz = sb ^ (((sb >> 9) & 1) << 5); R = (st >> 1) * 16 + swz / 64; C = (st & 1) * 32 + (swz % 64) / 2; }
__host__ __device__ __forceinline__ int perm32(int rho) { const int n = rho >> 4, i = rho & 15; return 8 * (i >> 2) + 4 * n + (i & 3); }

struct Unit { int pm, pn, e, ui; };
struct TileOrder {
    int nM, nN, nwg, G, c, ib, ie; const LAS unsigned char* tileE;
    __device__ __forceinline__ void init(int nM_, int nN_, int G_, int c_, const LAS unsigned char* te) { nM = nM_; nN = nN_; nwg = nM * nN; G = G_; c = c_; tileE = te; ib = 0; ie = 0x7fffffff; }
    __device__ __forceinline__ bool next(int i_, Unit& u) const {
        const int i = ib + i_; if (i >= ie) return false;
        const long L = (long)i * G + c; if (L >= nwg) return false;
        int wgid = (int)L; { const int q = nwg / NXCD, r = nwg % NXCD, xcd = wgid % NXCD, off = wgid / NXCD; wgid = (xcd < r ? xcd * (q + 1) : r * (q + 1) + (xcd - r) * q) + off; }
        const int nig = WGM * nN, gid = wgid / nig, fm = gid * WGM, gsz = (nM - fm) < WGM ? (nM - fm) : WGM;
        u.pm = fm + ((wgid % nig) % gsz); u.pn = (wgid % nig) / gsz; u.ui = i;
        u.e = tileE ? __builtin_amdgcn_readfirstlane((int)tileE[u.pm]) : 0;
        return true;
    }
};

struct EpiProjX {
    static constexpr bool MIDK = false, BIASL = false;
    static constexpr bool PERM = true;
    bf16* O; const float* gq; const float* gk; float* SSG;
    __device__ __forceinline__ void operator()(const f32x4 (&acc)[2][2][4][2], const Unit& u, int wr, int wc, int fr, int fq) const {
        const int row0 = u.pm * BM + wr * 64 + fr, col0 = u.pn * BM + wc * 64 + 8 * fq, kind = u.pn >> 2;
        if (kind <= 1) {
            const float* gp = (kind == 0 ? gq : gk) + 8 * fq; const float qs = kind == 0 ? 0.125f * 1.4426950408889634f : 1.0f;
            const f32x4 g00 = *(const f32x4*)(gp), g01 = *(const f32x4*)(gp + 4), g10 = *(const f32x4*)(gp + 32), g11 = *(const f32x4*)(gp + 36);
#pragma unroll
            for (int ai = 0; ai < 2; ++ai)
#pragma unroll
                for (int m = 0; m < 4; ++m) { const f32x4 a = acc[ai][0][m][0], b = acc[ai][0][m][1], c = acc[ai][1][m][0], d = acc[ai][1][m][1];
                    float ss = (a.x * a.x + a.y * a.y) + (a.z * a.z + a.w * a.w) + (b.x * b.x + b.y * b.y) + (b.z * b.z + b.w * b.w) + (c.x * c.x + c.y * c.y) + (c.z * c.z + c.w * c.w) + (d.x * d.x + d.y * d.y) + (d.z * d.z + d.w * d.w);
                    ss += __shfl_xor(ss, 16); ss += __shfl_xor(ss, 32);
                    const float r = qs / sqrtf(ss * (1.0f / 64.0f) + EPS);
                    const f32x4 oa = a * r * g00, ob = b * r * g01, oc = c * r * g10, od = d * r * g11;
                    bf16* rowp = O + (size_t)(row0 + ai * HALF + m * 16) * NPROJ + col0;
                    u32x4 w0, w1; w0.x = cvt_pk_bf16(oa.x, oa.y); w0.y = cvt_pk_bf16(oa.z, oa.w); w0.z = cvt_pk_bf16(ob.x, ob.y); w0.w = cvt_pk_bf16(ob.z, ob.w);
                    w1.x = cvt_pk_bf16(oc.x, oc.y); w1.y = cvt_pk_bf16(oc.z, oc.w); w1.z = cvt_pk_bf16(od.x, od.y); w1.w = cvt_pk_bf16(od.z, od.w);
                    *(u32x4*)(rowp) = w0; *(u32x4*)(rowp + 32) = w1; }
        } else if (kind == 2) {
#pragma unroll
            for (int ai = 0; ai < 2; ++ai)
#pragma unroll
                for (int m = 0; m < 4; ++m) { bf16* rowp = O + (size_t)(row0 + ai * HALF + m * 16) * NPROJ + col0;
#pragma unroll
                    for (int bj = 0; bj < 2; ++bj) { const f32x4 v0 = acc[ai][bj][m][0], v1 = acc[ai][bj][m][1];
                        u32x4 w; w.x = cvt_pk_bf16(v0[0], v0[1]); w.y = cvt_pk_bf16(v0[2], v0[3]); w.z = cvt_pk_bf16(v1[0], v1[1]); w.w = cvt_pk_bf16(v1[2], v1[3]);
                        *(u32x4*)(rowp + bj * 32) = w; } }
        } else {
#pragma unroll
            for (int ai = 0; ai < 2; ++ai)
#pragma unroll
                for (int m = 0; m < 4; ++m) { const int row = row0 + ai * HALF + m * 16; bf16* rowp = O + (size_t)row * NPROJ + col0; float ss = 0.f;
#pragma unroll
                    for (int bj = 0; bj < 2; ++bj) { const f32x4 v0 = acc[ai][bj][m][0], v1 = acc[ai][bj][m][1];
                        const f32x2 a = gelu_pk((f32x2){v0[0], v0[1]}), b = gelu_pk((f32x2){v0[2], v0[3]}), c = gelu_pk((f32x2){v1[0], v1[1]}), d = gelu_pk((f32x2){v1[2], v1[3]});
                        ss += (a.x * a.x + a.y * a.y) + (b.x * b.x + b.y * b.y) + (c.x * c.x + c.y * c.y) + (d.x * d.x + d.y * d.y);
                        u32x4 w; w.x = cvt_pk_bf16(a.x, a.y); w.y = cvt_pk_bf16(b.x, b.y); w.z = cvt_pk_bf16(c.x, c.y); w.w = cvt_pk_bf16(d.x, d.y);
                        *(u32x4*)(rowp + bj * 32) = w; }
                    if (kind == 4) { ss += __shfl_xor(ss, 16); ss += __shfl_xor(ss, 32); if (fq == 0) SSG[(size_t)row * 16 + (u.pn - 16) * 4 + wc] = ss; } }
        }
    }
};
struct EpiResid {
    static constexpr bool PERM = true, MIDK = true, BIASL = false;
    const float* base; bf16* x2b; int ldc; const float* RA; const float* RB; float* SSX;
    __device__ __forceinline__ void mid(f32x4 (&acc)[2][2][4][2], const Unit& u, int wr, int fr) const {
        const int row0 = u.pm * BM + wr * 64 + fr;
#pragma unroll
        for (int ai = 0; ai < 2; ++ai)
#pragma unroll
            for (int m = 0; m < 4; ++m) { int row = row0 + ai * HALF + m * 16; asm volatile("" : "+v"(row));
                const float f = RA[row] / RB[row];
#pragma unroll
                for (int bj = 0; bj < 2; ++bj)
#pragma unroll
                    for (int n = 0; n < 2; ++n) acc[ai][bj][m][n] = acc[ai][bj][m][n] * f; }
    }
    __device__ __forceinline__ void operator()(const f32x4 (&acc)[2][2][4][2], const Unit& u, int wr, int wc, int fr, int fq) const {
        const int row0 = u.pm * BM + wr * 64 + fr, col0 = u.pn * BM + wc * 32 + 8 * fq;
#pragma unroll
        for (int ai = 0; ai < 2; ++ai) {
            f32x4 r[4][2][2]; float rb[4];
#pragma unroll
            for (int m = 0; m < 4; ++m) { const int row = row0 + ai * HALF + m * 16; const size_t off = (size_t)row * ldc + col0; rb[m] = RB[row];
#pragma unroll
                for (int bj = 0; bj < 2; ++bj)
#pragma unroll
                    for (int n = 0; n < 2; ++n) r[m][bj][n] = *(const f32x4*)(base + off + bj * HALF + 4 * n); }
#pragma unroll
            for (int m = 0; m < 4; ++m) { const int row = row0 + ai * HALF + m * 16; const size_t off = (size_t)row * ldc + col0;
                float ss = 0.f;
#pragma unroll
                for (int bj = 0; bj < 2; ++bj) { const f32x4 o0 = r[m][bj][0] + acc[ai][bj][m][0] * rb[m], o1 = r[m][bj][1] + acc[ai][bj][m][1] * rb[m];
                    ss += (o0.x * o0.x + o0.y * o0.y) + (o0.z * o0.z + o0.w * o0.w) + (o1.x * o1.x + o1.y * o1.y) + (o1.z * o1.z + o1.w * o1.w);
                    u32x4 w; w.x = cvt_pk_bf16(o0.x, o0.y); w.y = cvt_pk_bf16(o0.z, o0.w); w.z = cvt_pk_bf16(o1.x, o1.y); w.w = cvt_pk_bf16(o1.z, o1.w);
                    *(u32x4*)(x2b + off + bj * HALF) = w; }
                ss += __shfl_xor(ss, 16); ss += __shfl_xor(ss, 32);
                SSX[(size_t)row * 32 + u.pn * 4 + wc] = ss; }
        }
    }
};
struct EpiSwiglu {
    static constexpr bool MIDK = false, BIASL = true;
    static constexpr bool PERM = true;
    unsigned char* act; const float* bgu; const LAS float* biasL; unsigned biasA;
    __device__ __forceinline__ void prefetch(const Unit& u, int wid, int lane) const {
        if (wid == 0) glds16(bgu + (size_t)u.e * 4096 + u.pn * 128 + (lane & 31) * 4 + (lane >> 5) * 2048, biasA + (unsigned)(u.ui & 1) * 1024u); }
    __device__ __forceinline__ void operator()(const f32x4 (&acc)[2][2][4][2], const Unit& u, int wr, int wc, int fr, int fq) const {
        const int jl = wc * 32 + 8 * (2 * (fq & 1) + (fq >> 1));
        const LAS float* bp = biasL + (u.ui & 1) * 256 + jl;
        const f32x4 bg0 = *(const LAS f32x4*)(bp), bg1 = *(const LAS f32x4*)(bp + 4), bl0 = *(const LAS f32x4*)(bp + 128) + 1.0f, bl1 = *(const LAS f32x4*)(bp + 132) + 1.0f;
        const float rs = 1.0f / 64.0f;
        const int hi32 = fq >> 1;
        unsigned char* obase = act + (size_t)(u.pm * BM + wr * 64 + fr) * 2048 + u.pn * 128 + wc * 32 + 16 * (fq & 1);
#pragma unroll
        for (int ai = 0; ai < 2; ++ai)
#pragma unroll
            for (int mp = 0; mp < 2; ++mp) {
                unsigned wv[2][2];
#pragma unroll
                for (int r2 = 0; r2 < 2; ++r2) { const int m = 2 * mp + r2;
#pragma unroll
                    for (int n = 0; n < 2; ++n) { const f32x4 ag = acc[ai][0][m][n], al = acc[ai][1][m][n], bg = n ? bg1 : bg0, bl = n ? bl1 : bl0; f32x2 o2[2];
#pragma unroll
                        for (int hq = 0; hq < 2; ++hq) {
                            f32x2 g = (f32x2){ag[2 * hq], ag[2 * hq + 1]} * rs + (f32x2){bg[2 * hq], bg[2 * hq + 1]};
                            f32x2 l = (f32x2){al[2 * hq], al[2 * hq + 1]} * rs + (f32x2){bl[2 * hq], bl[2 * hq + 1]};
                            g.x = fminf(g.x, 7.0f); g.y = fminf(g.y, 7.0f);
                            l.x = __builtin_amdgcn_fmed3f(l.x, -6.0f, 8.0f); l.y = __builtin_amdgcn_fmed3f(l.y, -6.0f, 8.0f);
                            const f32x2 z = g * (-1.702f * 1.4426950408889634f);
                            f32x2 e; e.x = __builtin_amdgcn_exp2f(z.x); e.y = __builtin_amdgcn_exp2f(z.y);
                            const f32x2 d = e + 1.0f; f32x2 r; r.x = __builtin_amdgcn_rcpf(d.x); r.y = __builtin_amdgcn_rcpf(d.y);
                            o2[hq] = (g * r) * l; }
                        wv[r2][n] = pk4_fp8(o2[0].x, o2[0].y, o2[1].x, o2[1].y); } }
                const auto s0 = __builtin_amdgcn_permlane32_swap(wv[0][0], wv[1][0], false, false), s1 = __builtin_amdgcn_permlane32_swap(wv[0][1], wv[1][1], false, false);
                u32x4 w; w.x = s0[0]; w.y = s1[0]; w.z = s0[1]; w.w = s1[1];
                *(u32x4*)(obase + (size_t)(ai * HALF + (2 * mp + hi32) * 16) * 2048) = w; }
    }
};
struct EpiDown {
    static constexpr bool MIDK = false, BIASL = true;
    static constexpr bool PERM = true;
    unsigned char* Y; const float* bdn; const LAS unsigned* dstL; const LAS float* biasL; unsigned biasA;
    __device__ __forceinline__ void prefetch(const Unit& u, int wid, int lane) const {
        if (wid == 0) glds16(bdn + (size_t)u.e * 2048 + u.pn * 256 + lane * 4, biasA + (unsigned)(u.ui & 1) * 1024u); }
    __device__ __forceinline__ void operator()(const f32x4 (&acc)[2][2][4][2], const Unit& u, int wr, int wc, int fr, int fq) const {
        const int col0 = u.pn * BM + wc * 64 + 16 * fq;
        const LAS float* bp = biasL + (u.ui & 1) * 256 + wc * 64 + 16 * fq;
        f32x4 bv[2][2];
#pragma unroll
        for (int bj = 0; bj < 2; ++bj)
#pragma unroll
            for (int n = 0; n < 2; ++n) bv[bj][n] = *(const LAS f32x4*)(bp + 8 * bj + 4 * n);
#pragma unroll
        for (int ai = 0; ai < 2; ++ai)
#pragma unroll
            for (int m = 0; m < 4; ++m) { const unsigned dst = dstL[u.ui * 256 + ai * HALF + wr * 64 + m * 16 + fr];
                const f32x4 v00 = acc[ai][0][m][0] * (1.0f / 64.0f) + bv[0][0], v01 = acc[ai][0][m][1] * (1.0f / 64.0f) + bv[0][1], v10 = acc[ai][1][m][0] * (1.0f / 64.0f) + bv[1][0], v11 = acc[ai][1][m][1] * (1.0f / 64.0f) + bv[1][1];
                u32x4 w; w.x = pk4_fp8(v00[0], v00[1], v00[2], v00[3]); w.y = pk4_fp8(v01[0], v01[1], v01[2], v01[3]); w.z = pk4_fp8(v10[0], v10[1], v10[2], v10[3]); w.w = pk4_fp8(v11[0], v11[1], v11[2], v11[3]);
                *(u32x4*)(Y + (size_t)dst * 2048 + col0) = w; }
    }
};

template <class Epi, bool GATHER, bool ALIGN_EPI, bool FP8>
__device__ __forceinline__ void gemm_phase(LAS unsigned char* lds, const char* Abase, const char* Bbase, size_t estrideB, int KB, const TileOrder& S, const Epi& E, const LAS unsigned short* tokL) {
    const int tid = threadIdx.x, wid = __builtin_amdgcn_readfirstlane(tid >> 6), lane = tid & 63, wr = wid >> 2, wc = wid & 3, fr = lane & 15, fq = lane >> 4;
    const int nt = KB / 128;
    int Rr[2], Cc[2]; unsigned voffB[2], vA[2][2];
#pragma unroll
    for (int i = 0; i < 2; ++i) { int R, C; stage_rc(tid * 16 + i * 8192, R, C); const int Rb = Epi::PERM ? ((R & ~31) + perm32(R & 31)) : R;
        Rr[i] = R; Cc[i] = C; voffB[i] = (unsigned)(Rb * KB + C * 2); }
    const size_t kstep = (size_t)128;
    const size_t hstep = (size_t)HALF * KB;
    const size_t tstep = 2 * hstep;
    const unsigned ldsw = (unsigned)wid * 1024u;
    const int aoff = lds_byte(wr * 64 + fr, fq * 8), boff = lds_byte(wc * 32 + fr, fq * 8);
#define PG8_SA(b, h) (((b) * 2 + (h)) * HTB)
#define PG8_SB(b, h) ((4 + (b) * 2 + (h)) * HTB)
#define PG8_STAGE(bufoff, gbase, voff) do { _Pragma("unroll") for (int _i = 0; _i < 2; ++_i) \
        __builtin_amdgcn_global_load_lds((const GAS unsigned*)((const char*)(gbase) + (voff)[_i]), (LAS unsigned*)(lds + (bufoff) + ldsw + _i * 8192), 16, 0, 0); } while (0)
#define PG8_LDA(dst, b, h) do { _Pragma("unroll") for (int m = 0; m < 4; ++m) dst[m] = __builtin_shufflevector(*(const LAS v4i*)(lds + PG8_SA(b, h) + aoff + m * 2048), *(const LAS v4i*)(lds + PG8_SA(b, h) + aoff + m * 2048 + 1024), 0, 1, 2, 3, 4, 5, 6, 7); } while (0)
#define PG8_LDB(dst, b, h) do { _Pragma("unroll") for (int n = 0; n < 2; ++n) dst[n] = __builtin_shufflevector(*(const LAS v4i*)(lds + PG8_SB(b, h) + boff + n * 2048), *(const LAS v4i*)(lds + PG8_SB(b, h) + boff + n * 2048 + 1024), 0, 1, 2, 3, 4, 5, 6, 7); } while (0)
#define PG8_MMA(ai, bj, At, Bt) do { __builtin_amdgcn_s_setprio(1); _Pragma("unroll") for (int m = 0; m < 4; ++m) _Pragma("unroll") for (int n = 0; n < 2; ++n) { \
        if constexpr (FP8) acc[ai][bj][m][n] = __builtin_amdgcn_mfma_scale_f32_16x16x128_f8f6f4(Bt[n], At[m], acc[ai][bj][m][n], 0, 0, 0, 0, 0, 0)    ; \
        else { acc[ai][bj][m][n] = __builtin_amdgcn_mfma_f32_16x16x32_bf16(lo8(Bt[n]), lo8(At[m]), acc[ai][bj][m][n], 0, 0, 0); acc[ai][bj][m][n] = __builtin_amdgcn_mfma_f32_16x16x32_bf16(hi8(Bt[n]), hi8(At[m]), acc[ai][bj][m][n], 0, 0, 0); } } __builtin_amdgcn_s_setprio(0); } while (0)
#define PG8_WAIT_V(n) asm volatile("s_waitcnt vmcnt(" #n ")" ::: "memory")
#define PG8_WAIT_L(n) asm volatile("s_waitcnt lgkmcnt(" #n ")" ::: "memory")
#define PG8_BAR __builtin_amdgcn_s_barrier()
#define PG8_SCHED __builtin_amdgcn_sched_barrier(0)
#define PG8_SETVA(u) do { _Pragma("unroll") for (int _h = 0; _h < 2; ++_h) _Pragma("unroll") for (int _i = 0; _i < 2; ++_i) { \
        const int _row = GATHER ? (int)tokL[(u).ui * 256 + _h * HALF + Rr[_i]] : (_h * HALF + Rr[_i]); vA[_h][_i] = (unsigned)(_row * KB + Cc[_i] * 2); asm volatile("" : "+v"(vA[_h][_i])); } } while (0)
    Unit cur, nxt; int ui = 0;
    if (!S.next(0, cur)) return;
    f32x4 acc[2][2][4][2];
#pragma unroll
    for (int a = 0; a < 2; ++a)
#pragma unroll
        for (int b = 0; b < 2; ++b)
#pragma unroll
            for (int m = 0; m < 4; ++m)
#pragma unroll
                for (int n = 0; n < 2; ++n) acc[a][b][m][n] = (f32x4){0.f, 0.f, 0.f, 0.f};
    v8i At[4], B0[2], B1[2];
    const char* cA = GATHER ? Abase : Abase + (size_t)cur.pm * tstep;
    const char* cB = Bbase + (size_t)cur.e * estrideB + (size_t)cur.pn * tstep;
    PG8_SETVA(cur);
    if constexpr (Epi::BIASL) E.prefetch(cur, wid, lane);
    PG8_STAGE(PG8_SB(0, 0), cB, voffB); PG8_STAGE(PG8_SB(0, 1), cB + hstep, voffB); PG8_STAGE(PG8_SA(0, 0), cA, vA[0]); PG8_STAGE(PG8_SA(0, 1), cA, vA[1]);
    if (wr == 1) PG8_BAR;
    PG8_WAIT_V(2); PG8_BAR;
    PG8_STAGE(PG8_SB(1, 0), cB + kstep, voffB); PG8_STAGE(PG8_SA(1, 0), cA + kstep, vA[0]); PG8_STAGE(PG8_SB(1, 1), cB + hstep + kstep, voffB);
    PG8_WAIT_V(6); PG8_BAR;
    for (;;) {
        const bool has_next = S.next(ui + 1, nxt);
        const char* nA = has_next ? (GATHER ? Abase : Abase + (size_t)nxt.pm * tstep) : cA;
        const char* nB = has_next ? Bbase + (size_t)nxt.e * estrideB + (size_t)nxt.pn * tstep : cB;
        for (int t = 0; t < nt; t += 2) {
            if constexpr (Epi::MIDK) { if (t == nt / 2) E.mid(acc, cur, wr, fr); }
            const bool last = (t == nt - 2);
            const char* a1 = cA + (size_t)(t + 1) * kstep;
            const char* a2 = last ? nA : cA + (size_t)(t + 2) * kstep; const char* b2 = last ? nB : cB + (size_t)(t + 2) * kstep;
            const char* a3 = a2 + kstep; const char* b3 = b2 + kstep;
            PG8_LDB(B0, 0, 0); PG8_LDB(B1, 0, 1); PG8_SCHED; PG8_LDA(At, 0, 0); PG8_STAGE(PG8_SA(1, 1), a1, vA[1]);
            if (last && has_next) PG8_SETVA(nxt);
            PG8_WAIT_V(8); PG8_WAIT_L(0); PG8_BAR; PG8_MMA(0, 0, At, B0); PG8_MMA(0, 1, At, B1); PG8_BAR; PG8_SCHED;
            PG8_LDA(At, 0, 1); PG8_STAGE(PG8_SB(0, 0), b2, voffB); PG8_STAGE(PG8_SB(0, 1), b2 + hstep, voffB); PG8_STAGE(PG8_SA(0, 0), a2, vA[0]);
            PG8_WAIT_V(8); PG8_WAIT_L(0); PG8_BAR; PG8_MMA(1, 0, At, B0); PG8_MMA(1, 1, At, B1); PG8_BAR; PG8_SCHED;
            PG8_LDB(B0, 1, 0); PG8_LDB(B1, 1, 1); PG8_SCHED; PG8_LDA(At, 1, 0); PG8_STAGE(PG8_SA(0, 1), a2, vA[1]);
            PG8_WAIT_V(8); PG8_WAIT_L(0); PG8_BAR; PG8_MMA(0, 0, At, B0); PG8_MMA(0, 1, At, B1); PG8_BAR; PG8_SCHED;
            PG8_LDA(At, 1, 1); PG8_STAGE(PG8_SB(1, 0), b3, voffB); PG8_STAGE(PG8_SB(1, 1), b3 + hstep, voffB); PG8_STAGE(PG8_SA(1, 0), a3, vA[0]);
            PG8_WAIT_V(8); PG8_WAIT_L(0); PG8_BAR; PG8_MMA(1, 0, At, B0); PG8_MMA(1, 1, At, B1); PG8_BAR; PG8_SCHED;
        }
        if constexpr (ALIGN_EPI) { if (wr == 0) PG8_BAR; }
        E(acc, cur, wr, wc, fr, fq);
        if (!has_next) break;
#pragma unroll
        for (int a = 0; a < 2; ++a)
#pragma unroll
            for (int b = 0; b < 2; ++b)
#pragma unroll
                for (int m = 0; m < 4; ++m)
#pragma unroll
                    for (int n = 0; n < 2; ++n) acc[a][b][m][n] = (f32x4){0.f, 0.f, 0.f, 0.f};
        cur = nxt; cA = nA; cB = nB; ++ui;
        if constexpr (Epi::BIASL) E.prefetch(cur, wid, lane);
        if constexpr (ALIGN_EPI) { if (wr == 1) PG8_BAR; }
    }
    PG8_WAIT_V(0);
    if constexpr (!ALIGN_EPI) { if (wr == 0) PG8_BAR; }
    PG8_BAR;
#undef PG8_SA
#undef PG8_SB
#undef PG8_STAGE
#undef PG8_LDA
#undef PG8_LDB
#undef PG8_MMA
#undef PG8_WAIT_V
#undef PG8_WAIT_L
#undef PG8_BAR
#undef PG8_SCHED
#undef PG8_SETVA
}

struct Frame {
    LAS unsigned char* lds;
    volatile LAS unsigned* MISC;
    gu32* ctl;
    int tid, lane, wave, vcu, G;
    const float *x, *g1, *w_in, *gq, *gk, *rpb, *gsg, *w_sp, *b_sp, *ga, *gs, *w_out, *g2, *w_r, *b_r, *w_gu, *b_gu, *w_dn, *b_dn;
    float* out;
    bf16 *WIN, *WOUT, *WSP, *WRH, *WRL, *H, *PROJ, *MIX, *X2B; unsigned char *WGU, *WDN, *ACT, *H8, *Y;
    float *RSTD2, *GATE, *SSQA, *SSG, *RA, *RB, *SSX; unsigned* SLOT; int* LIST;
};

__device__ __forceinline__ void p0_transpose_item(const float* W, int N, int K, bf16* WT, int k0, int n0, int out_row0, int hi_off, const float* kgain, LAS float* scr, int lane) {
    const int l16 = lane & 15, lq = lane >> 4;
#pragma unroll 4
    for (int i = 0; i < 16; ++i) { const int kk = 4 * i + lq; f32x4 v = *(const f32x4*)(W + (size_t)(k0 + kk) * N + n0 + 4 * l16); if (kgain) v = v * kgain[k0 + kk];
        LAS float* d = scr + kk * 65 + 4 * l16; d[0] = v.x; d[1] = v.y; d[2] = v.z; d[3] = v.w; }
    LDS_WAIT(); asm volatile("" ::: "memory");
    const int c = lane >> 3, nn = lane & 7;
#pragma unroll
    for (int j = 0; j < 8; ++j) { const int n = nn + 8 * j; const LAS float* s = scr + (8 * c) * 65 + n;
        u32x4 o; o.x = cvt_pk_bf16(s[0], s[65]); o.y = cvt_pk_bf16(s[2 * 65], s[3 * 65]); o.z = cvt_pk_bf16(s[4 * 65], s[5 * 65]); o.w = cvt_pk_bf16(s[6 * 65], s[7 * 65]);
        *(u32x4*)(WT + (size_t)(out_row0 + n + (n >= 32 ? hi_off : 0)) * K + k0 + 8 * c) = o; }
    LDS_WAIT(); asm volatile("" ::: "memory");
}
__device__ __forceinline__ void p0_transpose_item_fp8(const float* W, int N, int K, unsigned char* WT, int k0, int n0, int out_row0, LAS float* scr, int lane) {
    const int l8 = lane & 7, lr = lane >> 3;
#pragma unroll 4
    for (int i = 0; i < 16; ++i) { const int kk = 8 * i + lr; const f32x4 v = *(const f32x4*)(W + (size_t)(k0 + kk) * N + n0 + 4 * l8);
        LAS float* d = scr + kk * 33 + 4 * l8; d[0] = v.x; d[1] = v.y; d[2] = v.z; d[3] = v.w; }
    LDS_WAIT(); asm volatile("" ::: "memory");
    const int n = lane & 31, kh = lane >> 5; const LAS float* s = scr + (64 * kh) * 33 + n;
#pragma unroll
    for (int c4 = 0; c4 < 4; ++c4) { u32x4 o;
        o.x = pk4_fp8(s[(16 * c4 + 0) * 33] * 64.f, s[(16 * c4 + 1) * 33] * 64.f, s[(16 * c4 + 2) * 33] * 64.f, s[(16 * c4 + 3) * 33] * 64.f);
        o.y = pk4_fp8(s[(16 * c4 + 4) * 33] * 64.f, s[(16 * c4 + 5) * 33] * 64.f, s[(16 * c4 + 6) * 33] * 64.f, s[(16 * c4 + 7) * 33] * 64.f);
        o.z = pk4_fp8(s[(16 * c4 + 8) * 33] * 64.f, s[(16 * c4 + 9) * 33] * 64.f, s[(16 * c4 + 10) * 33] * 64.f, s[(16 * c4 + 11) * 33] * 64.f);
        o.w = pk4_fp8(s[(16 * c4 + 12) * 33] * 64.f, s[(16 * c4 + 13) * 33] * 64.f, s[(16 * c4 + 14) * 33] * 64.f, s[(16 * c4 + 15) * 33] * 64.f);
        *(u32x4*)(WT + (size_t)(out_row0 + n) * K + k0 + 64 * kh + 16 * c4) = o; }
    LDS_WAIT(); asm volatile("" ::: "memory");
}
__device__ __forceinline__ void moe_convert(Frame& F, int j0, int j1) {
    LAS float* img = (LAS float*)F.lds;
    constexpr int T_GU = 16 * 16, T_DN = 16 * 8, NT = NE * (T_GU + T_DN);
    const int w = F.wave, lane = F.lane;
    f32x4 v[16];
#define P0_DECODE(t, W_, N_, WT_, k0_, n0_, isgu_) do { int r_ = (t); if (r_ < NE * T_GU) { const int e_ = r_ / T_GU, q_ = r_ % T_GU; W_ = F.w_gu + (size_t)e_ * DM * 4096; N_ = 4096; WT_ = F.WGU + (size_t)e_ * 4096 * DM; k0_ = 128 * (q_ / 16); n0_ = 256 * (q_ % 16); isgu_ = 1; } \
        else { r_ -= NE * T_GU; const int e_ = r_ / T_DN, q_ = r_ % T_DN; W_ = F.w_dn + (size_t)e_ * DM * DM; N_ = DM; WT_ = F.WDN + (size_t)e_ * DM * DM; k0_ = 128 * (q_ / 8); n0_ = 256 * (q_ % 8); isgu_ = 0; } } while (0)
#define P0_LOAD(W_, N_, k0_, n0_) do { _Pragma("unroll") for (int i = 0; i < 16; ++i) v[i] = __builtin_nontemporal_load((const f32x4*)(W_ + (size_t)(k0_ + 16 * w + i) * N_ + n0_ + 4 * lane)); } while (0)
    int j = j0, t = F.vcu + j0 * F.G;
    const float* W = nullptr; unsigned char* WT = nullptr; int N = 0, k0 = 0, n0 = 0, isgu = 0;
    if (j < j1 && t < NT) { P0_DECODE(t, W, N, WT, k0, n0, isgu); P0_LOAD(W, N, k0, n0); }
    while (j < j1 && t < NT) {
#pragma unroll
        for (int i = 0; i < 16; ++i) *(LAS f32x4*)(img + (16 * w + i) * 260 + 4 * lane) = v[i];
        __syncthreads();
        const int tn = t + F.G; const float* Wn = nullptr; unsigned char* WTn = nullptr; int Nn = 0, k0n = 0, n0n = 0, isgun = 0;
        if (j + 1 < j1 && tn < NT) { P0_DECODE(tn, Wn, Nn, WTn, k0n, n0n, isgun); P0_LOAD(Wn, Nn, k0n, n0n); }
        { const int n = 32 * w + (lane & 31), kh = lane >> 5; const LAS float* sp = img + (64 * kh) * 260 + n;
          const int nn = n0 + n; const int ll = nn & 255;
          const int jl = nn & 127, g8 = (jl >> 3) & 3;
          const int orow = isgu ? (((nn & 2047) >> 7) * 256 + (nn >> 11) * 128 + (jl & ~31) + 8 * (2 * (g8 & 1) + (g8 >> 1)) + (jl & 7)) : ((nn & ~255) + 128 * ((ll >> 3) & 1) + 32 * (ll >> 6) + 8 * ((ll >> 4) & 3) + (ll & 7));
          unsigned char* dst = WT + (size_t)orow * DM + k0 + 64 * kh;
#pragma unroll
          for (int c4 = 0; c4 < 4; ++c4) { u32x4 o;
              o.x = pk4_fp8(sp[(16 * c4 + 0) * 260] * 64.f, sp[(16 * c4 + 1) * 260] * 64.f, sp[(16 * c4 + 2) * 260] * 64.f, sp[(16 * c4 + 3) * 260] * 64.f);
              o.y = pk4_fp8(sp[(16 * c4 + 4) * 260] * 64.f, sp[(16 * c4 + 5) * 260] * 64.f, sp[(16 * c4 + 6) * 260] * 64.f, sp[(16 * c4 + 7) * 260] * 64.f);
              o.z = pk4_fp8(sp[(16 * c4 + 8) * 260] * 64.f, sp[(16 * c4 + 9) * 260] * 64.f, sp[(16 * c4 + 10) * 260] * 64.f, sp[(16 * c4 + 11) * 260] * 64.f);
              o.w = pk4_fp8(sp[(16 * c4 + 12) * 260] * 64.f, sp[(16 * c4 + 13) * 260] * 64.f, sp[(16 * c4 + 14) * 260] * 64.f, sp[(16 * c4 + 15) * 260] * 64.f);
              __builtin_nontemporal_store(o, (u32x4*)(dst + 16 * c4)); } }
        __syncthreads();
        ++j; t = tn; W = Wn; WT = WTn; N = Nn; k0 = k0n; n0 = n0n; isgu = isgun;
    }
#undef P0_DECODE
#undef P0_LOAD
}
__device__ __forceinline__ void p0_prologue(Frame& F) {
    LAS float* scr = (LAS float*)(F.lds + F.wave * 16896);
    const int gw = F.vcu * NWAVES + F.wave, NGW = F.G * NWAVES, lane = F.lane;
    constexpr int I_IN = 32 * 80, I_OUT = 32 * 32;
    constexpr int NITEMS = I_IN + I_OUT;
    for (int it = gw; it < NITEMS; it += NGW) {
        int r = it;
        if (r < I_IN) { const int kb = r / 80, nb = r % 80; p0_transpose_item(F.w_in, NPROJ, DM, F.WIN, 64 * kb, 64 * nb, (nb >> 2) * 256 + (nb & 3) * 32, 96, nullptr, scr, lane); continue; } r -= I_IN;
        { const int kb = r / 32, nb = r % 32; p0_transpose_item(F.w_out, DM, DM, F.WOUT, 64 * kb, 64 * nb, 64 * nb, 0, kb < 16 ? F.ga : F.gs - 1024, scr, lane); }
    }
    {
        f32x4 g1v[8];
#pragma unroll
        for (int j = 0; j < 4; ++j) { g1v[2 * j] = *(const f32x4*)(F.g1 + 8 * lane + 512 * j); g1v[2 * j + 1] = *(const f32x4*)(F.g1 + 8 * lane + 512 * j + 4); }
        for (int m = gw; m < NTOK; m += 2 * NGW) {
            const int m2 = m + NGW; const bool has2 = m2 < NTOK;
            const float* xr = F.x + (size_t)m * DM + 8 * lane; const float* xr2 = F.x + (size_t)(has2 ? m2 : m) * DM + 8 * lane;
            f32x4 v[8], u[8]; float s = 0.f, s2 = 0.f;
#pragma unroll
            for (int j = 0; j < 4; ++j) { v[2 * j] = __builtin_nontemporal_load((const f32x4*)(xr + 512 * j)); v[2 * j + 1] = __builtin_nontemporal_load((const f32x4*)(xr + 512 * j + 4)); u[2 * j] = __builtin_nontemporal_load((const f32x4*)(xr2 + 512 * j)); u[2 * j + 1] = __builtin_nontemporal_load((const f32x4*)(xr2 + 512 * j + 4)); }
#pragma unroll
            for (int j = 0; j < 8; ++j) { s += (v[j].x * v[j].x + v[j].y * v[j].y) + (v[j].z * v[j].z + v[j].w * v[j].w); s2 += (u[j].x * u[j].x + u[j].y * u[j].y) + (u[j].z * u[j].z + u[j].w * u[j].w); }
            const float rs = 1.0f / sqrtf(wave_sum(s) * (1.0f / DM) + EPS), rs2 = 1.0f / sqrtf(wave_sum(s2) * (1.0f / DM) + EPS);
#pragma unroll
            for (int j = 0; j < 4; ++j) { const f32x4 a = v[2 * j] * rs * g1v[2 * j], b = v[2 * j + 1] * rs * g1v[2 * j + 1]; u32x4 o; o.x = cvt_pk_bf16(a.x, a.y); o.y = cvt_pk_bf16(a.z, a.w); o.z = cvt_pk_bf16(b.x, b.y); o.w = cvt_pk_bf16(b.z, b.w);
                *(u32x4*)(F.H + (size_t)m * DM + 8 * lane + 512 * j) = o; }
            if (has2) {
#pragma unroll
                for (int j = 0; j < 4; ++j) { const f32x4 a = u[2 * j] * rs2 * g1v[2 * j], b = u[2 * j + 1] * rs2 * g1v[2 * j + 1]; u32x4 o; o.x = cvt_pk_bf16(a.x, a.y); o.y = cvt_pk_bf16(a.z, a.w); o.z = cvt_pk_bf16(b.x, b.y); o.w = cvt_pk_bf16(b.z, b.w);
                    *(u32x4*)(F.H + (size_t)m2 * DM + 8 * lane + 512 * j) = o; } }
        }
    }
    const int gt = F.vcu * 512 + F.tid, NGT = F.G * 512;
    for (int i = gt; i < 16 * 128 * 128; i += NGT) { const float v = F.w_sp[i]; F.WSP[i] = (bf16)(cvt_pk_bf16(v, 0.f) & 0xffffu); }
    for (int i = gt; i < NE * DM; i += NGT) { const int e = i / DM, d = i % DM; const float v = F.w_r[(size_t)d * NE + e]; const unsigned hi = cvt_pk_bf16(v, 0.f) & 0xffffu; const float lo = v - __uint_as_float(hi << 16);
        F.WRH[i] = (bf16)hi; F.WRL[i] = (bf16)(cvt_pk_bf16(lo, 0.f) & 0xffffu); }
}

typedef short v4i16_t __attribute__((ext_vector_type(4)));
__device__ __forceinline__ s16x4 tr_read(const LAS unsigned char* p) { return __builtin_bit_cast(s16x4, __builtin_amdgcn_ds_read_tr16_b64_v4i16((LAS v4i16_t*)p)); }
__device__ __forceinline__ void attn_unit(Frame& F, int b, int h, int band) {
    constexpr int SLOT = 16384;
    LAS unsigned char* ring = F.lds;
    LAS float* rpbL = (LAS float*)(F.lds + AT_RPB);
    LAS unsigned* mrg = (LAS unsigned*)(F.lds + AT_MRG);
    const int tid = F.tid, lane = F.lane, w = F.wave, fr = lane & 15, quad = lane >> 4;
    const int cg = w & 3, hf8 = w >> 2;
    const int c0 = 16 * cg, w0 = (cg == 0) ? 0 : (cg == 1) ? 8 : (cg == 2) ? 24 : 32;
    const int qc = c0 + fr; const int cs = min(max(qc - 8, 0), 48);
    const int R0 = band * 16;
    __syncthreads();
    for (int i = tid; i < 480; i += 512) { const int ro = i >> 5, co = i & 31; rpbL[i] = co < 31 ? F.rpb[h * 465 + ro * 31 + co] * 1.4426950408889634f : -INFINITY; }
    int cooff[2][4];
#pragma unroll
    for (int hf = 0; hf < 2; ++hf)
#pragma unroll
        for (int i = 0; i < 4; ++i) { const int kc = w0 + 16 * hf + 4 * quad + i; const bool valid = (kc >= cs) && (kc < cs + 16); cooff[hf][i] = 4 * (valid ? kc - qc + 15 : 31); }
    const char* projb = (const char*)F.PROJ + (size_t)b * SEQ * NPROJ * 2; const unsigned ringb = (unsigned)(size_t)ring;
    const unsigned lane_src = (unsigned)((8 * w + (lane >> 3)) * NPROJ + 1024 + h * 64) * 2u + (unsigned)(((lane & 7) ^ (lane >> 3)) * 16);
#define ROW_DMA(rowabs) do { const char* src_ = projb + (size_t)(rowabs) * 64 * NPROJ * 2 + lane_src; const unsigned sb_ = ringb + (unsigned)(((rowabs) % 9) * SLOT + w * 1024); \
        glds16(src_, sb_); glds16(src_ + 2048, sb_ + 8192u); } while (0)
    const int rs0 = min(max(R0 - 4, 0), 120);
    for (int j = 0; j < 8; ++j) ROW_DMA(rs0 + j);
    int loaded_hi = rs0 + 7;
    const bf16* qbase = F.PROJ + ((size_t)b * SEQ + qc) * NPROJ + h * 64 + 8 * quad;
    bf16x8 qa = *(const bf16x8*)(qbase + (size_t)R0 * 64 * NPROJ), qb = *(const bf16x8*)(qbase + (size_t)R0 * 64 * NPROJ + 32);
    VM_WAIT(); __syncthreads();
    for (int step = 0; step < 16; ++step) {
        const int r = R0 + step, rs = min(max(r - 4, 0), 120);
        bf16x8 qf0 = qa, qf1 = qb;
        if (step < 15) { const int nh = min(max(r - 3, 0), 120) + 7; if (nh > loaded_hi) { ROW_DMA(nh); loaded_hi = nh; }
            qa = *(const bf16x8*)(qbase + (size_t)(r + 1) * 64 * NPROJ); qb = *(const bf16x8*)(qbase + (size_t)(r + 1) * 64 * NPROJ + 32); }
        f32x4 s[4][2];
#pragma unroll
        for (int kr = 0; kr < 4; ++kr) { const int sb = ((rs + 4 * hf8 + kr) % 9) * SLOT;
#pragma unroll
            for (int hf = 0; hf < 2; ++hf) { const int key = w0 + 16 * hf + fr;
                const bf16x8 a0 = *(const LAS bf16x8*)(ring + sb + key * 128 + ((quad ^ (key & 7)) << 4));
                const bf16x8 a1 = *(const LAS bf16x8*)(ring + sb + key * 128 + (((quad + 4) ^ (key & 7)) << 4));
                f32x4 z = {0.f, 0.f, 0.f, 0.f};
                z = __builtin_amdgcn_mfma_f32_16x16x32_bf16(a0, qf0, z, 0, 0, 0);
                z = __builtin_amdgcn_mfma_f32_16x16x32_bf16(a1, qf1, z, 0, 0, 0);
                s[kr][hf] = z; } }
        float mx = -INFINITY;
        { const LAS unsigned char* bb = (const LAS unsigned char*)rpbL + (rs + 4 * hf8 - r + 7) * 128;
#pragma unroll
            for (int kr = 0; kr < 4; ++kr)
#pragma unroll
                for (int hf = 0; hf < 2; ++hf)
#pragma unroll
                    for (int i = 0; i < 4; ++i) { const float v = s[kr][hf][i] + *(const LAS float*)(bb + kr * 128 + cooff[hf][i]); s[kr][hf][i] = v; mx = fmaxf(mx, v); } }
        mx = fmaxf(mx, __shfl_xor(mx, 16)); mx = fmaxf(mx, __shfl_xor(mx, 32));
        float lsum = 0.f; bf16x8 pf[4];
#pragma unroll
        for (int kr = 0; kr < 4; ++kr) { float p[8];
#pragma unroll
            for (int i = 0; i < 8; ++i) { p[i] = __builtin_amdgcn_exp2f(s[kr][i >> 2][i & 3] - mx); lsum += p[i]; }
            u32x4 pk; pk.x = cvt_pk_bf16(p[0], p[1]); pk.y = cvt_pk_bf16(p[2], p[3]); pk.z = cvt_pk_bf16(p[4], p[5]); pk.w = cvt_pk_bf16(p[6], p[7]); pf[kr] = __builtin_bit_cast(bf16x8, pk); }
        lsum += __shfl_xor(lsum, 16); lsum += __shfl_xor(lsum, 32);
        f32x4 o[4];
#pragma unroll
        for (int dt = 0; dt < 4; ++dt) o[dt] = (f32x4){0.f, 0.f, 0.f, 0.f};
#pragma unroll
        for (int kr = 0; kr < 4; ++kr) { const int sb = ((rs + 4 * hf8 + kr) % 9) * SLOT + 8192; const int key = w0 + 4 * quad + (fr >> 2), pp = fr & 3;
#pragma unroll
            for (int dt = 0; dt < 4; ++dt) { const int c = 2 * dt + (pp >> 1); const int ad = sb + key * 128 + ((c ^ (key & 7)) << 4) + 8 * (pp & 1);
                const s16x4 lo = tr_read(ring + ad), hi = tr_read(ring + ad + 16 * 128);
                const bf16x8 vf = __builtin_shufflevector(lo, hi, 0, 1, 2, 3, 4, 5, 6, 7);
                o[dt] = __builtin_amdgcn_mfma_f32_16x16x32_bf16(vf, pf[kr], o[dt], 0, 0, 0); } }
        if (w >= 4) { LAS unsigned* m = mrg + (w - 4) * 640 + lane; m[0] = __float_as_uint(mx); m[64] = __float_as_uint(lsum);
#pragma unroll
            for (int dt = 0; dt < 4; ++dt) { m[(2 + 2 * dt) * 64] = cvt_pk_bf16(o[dt][0], o[dt][1]); m[(3 + 2 * dt) * 64] = cvt_pk_bf16(o[dt][2], o[dt][3]); } }
        __syncthreads();
        if (w < 4) { const LAS unsigned* m = mrg + w * 640 + lane; const float mx2 = __uint_as_float(m[0]), l2 = __uint_as_float(m[64]);
            const float mm = fmaxf(mx, mx2), a1 = __builtin_amdgcn_exp2f(mx - mm), a2 = __builtin_amdgcn_exp2f(mx2 - mm); const float inv = 1.0f / (lsum * a1 + l2 * a2);
            const float f1 = a1 * inv, f2 = a2 * inv; float ssq = 0.f;
            bf16* op = F.MIX + ((size_t)b * SEQ + (size_t)r * 64 + qc) * DM + h * 64 + 4 * quad;
            u32x2 pk[4];
#pragma unroll
            for (int dt = 0; dt < 4; ++dt) { const unsigned u0 = m[(2 + 2 * dt) * 64], u1 = m[(3 + 2 * dt) * 64];
                const float v0 = o[dt][0] * f1 + bflo(u0) * f2, v1 = o[dt][1] * f1 + bfhi(u0) * f2, v2 = o[dt][2] * f1 + bflo(u1) * f2, v3 = o[dt][3] * f1 + bfhi(u1) * f2;
                ssq += (v0 * v0 + v1 * v1) + (v2 * v2 + v3 * v3);
                pk[dt].x = cvt_pk_bf16(v0, v1); pk[dt].y = cvt_pk_bf16(v2, v3); }
            ssq += __shfl_xor(ssq, 16); ssq += __shfl_xor(ssq, 32);
            VM_WAIT();
#pragma unroll
            for (int dp = 0; dp < 2; ++dp) *(u32x4*)(op + 32 * dp + ((quad & 1) ? 12 : 0)) = pair16(pk[2 * dp], pk[2 * dp + 1]);
            if (quad == 0) F.SSQA[((size_t)b * SEQ + (size_t)r * 64 + qc) * 16 + h] = ssq; }
        else VM_WAIT();
        __syncthreads();
    }
#undef ROW_DMA
}

__device__ __forceinline__ void sgu_unit(Frame& F, int unit) {
    LAS unsigned char* Gn = F.lds;
    LAS float* rsG = (LAS float*)(F.lds + 16384);
    const int tid = F.tid, lane = F.lane, w = F.wave, fr = lane & 15, quad = lane >> 4;
    const size_t tk0 = (size_t)unit * 128;
    __syncthreads();
    if (tid < 128) { const f32x4* sp = (const f32x4*)(F.SSG + (tk0 + tid) * 16); const f32x4 a = sp[0], b2 = sp[1], c = sp[2], d = sp[3];
        const float ss = ((a.x + a.y) + (a.z + a.w)) + ((b2.x + b2.y) + (b2.z + b2.w)) + ((c.x + c.y) + (c.z + c.w)) + ((d.x + d.y) + (d.z + d.w)); rsG[tid] = 1.0f / sqrtf(ss * (1.0f / 1024.0f) + EPS); }
    else if (tid < 256) { const int q = tid - 128; const f32x4* sp = (const f32x4*)(F.SSQA + (tk0 + q) * 16); const f32x4 a = sp[0], b2 = sp[1], c = sp[2], d = sp[3];
        const float ss = ((a.x + a.y) + (a.z + a.w)) + ((b2.x + b2.y) + (b2.z + b2.w)) + ((c.x + c.y) + (c.z + c.w)) + ((d.x + d.y) + (d.z + d.w)); F.RA[tk0 + q] = 1.0f / sqrtf(ss * (1.0f / 1024.0f) + EPS); }
    float ssq = 0.f; const int p = 16 * w + fr;
    const bf16* gsrc0 = F.PROJ + (tk0 + (tid >> 3)) * NPROJ + 4096 + (tid & 7) * 8;
    const bf16* usrc = F.PROJ + (tk0 + p) * NPROJ + 3072 + 4 * quad;
    const bf16* wsrc = F.WSP + (size_t)p * 128 + 8 * quad;
    u32x4 gv0 = *(const u32x4*)(gsrc0), gv1 = *(const u32x4*)(gsrc0 + (size_t)64 * NPROJ);
    u32x2 uv[4]; bf16x8 wv[4];
#pragma unroll
    for (int dt = 0; dt < 4; ++dt) { uv[dt] = *(const u32x2*)(usrc + 16 * dt); wv[dt] = *(const bf16x8*)(wsrc + 32 * dt); }
    for (int gi = 0; gi < 16; ++gi) {
        __syncthreads();
#pragma unroll
        for (int j = 0; j < 2; ++j) { const int q = (tid >> 3) + 64 * j, c = tid & 7; const u32x4 v = j ? gv1 : gv0; const float rr = rsG[q];
            const f32x4 ga = *(const f32x4*)(F.gsg + gi * 64 + c * 8), gb = *(const f32x4*)(F.gsg + gi * 64 + c * 8 + 4);
            u32x4 o; o.x = cvt_pk_bf16(bflo(v.x) * rr * ga.x, bfhi(v.x) * rr * ga.y); o.y = cvt_pk_bf16(bflo(v.y) * rr * ga.z, bfhi(v.y) * rr * ga.w);
            o.z = cvt_pk_bf16(bflo(v.z) * rr * gb.x, bfhi(v.z) * rr * gb.y); o.w = cvt_pk_bf16(bflo(v.w) * rr * gb.z, bfhi(v.w) * rr * gb.w);
            *(LAS u32x4*)(Gn + q * 128 + ((c ^ (q & 7)) << 4)) = o; }
        u32x2 uc[4]; bf16x8 wf[4];
#pragma unroll
        for (int dt = 0; dt < 4; ++dt) { uc[dt] = uv[dt]; wf[dt] = wv[dt]; }
        if (gi < 15) { gv0 = *(const u32x4*)(gsrc0 + (gi + 1) * 64); gv1 = *(const u32x4*)(gsrc0 + (size_t)64 * NPROJ + (gi + 1) * 64);
#pragma unroll
            for (int dt = 0; dt < 4; ++dt) { uv[dt] = *(const u32x2*)(usrc + (gi + 1) * 64 + 16 * dt); wv[dt] = *(const bf16x8*)(wsrc + (size_t)(gi + 1) * 16384 + 32 * dt); } }
        __syncthreads();
        f32x4 acc[4];
#pragma unroll
        for (int dt = 0; dt < 4; ++dt) acc[dt] = (f32x4){0.f, 0.f, 0.f, 0.f};
#pragma unroll
        for (int ks = 0; ks < 4; ++ks) { const int rowA = 32 * ks + 8 * quad + (fr >> 2), rowB = rowA + 4; const int pp = fr & 3;
#pragma unroll
            for (int dt = 0; dt < 4; ++dt) { const int c = 2 * dt + (pp >> 1);
                const s16x4 lo = tr_read(Gn + rowA * 128 + ((c ^ (rowA & 7)) << 4) + 8 * (pp & 1)), hi = tr_read(Gn + rowB * 128 + ((c ^ (rowB & 7)) << 4) + 8 * (pp & 1));
                const bf16x8 af = __builtin_shufflevector(lo, hi, 0, 1, 2, 3, 4, 5, 6, 7);
                acc[dt] = __builtin_amdgcn_mfma_f32_16x16x32_bf16(af, wf[ks], acc[dt], 0, 0, 0); } }
        const float bs = F.b_sp[gi * 128 + p];
        u32x2 pk[4];
#pragma unroll
        for (int dt = 0; dt < 4; ++dt) { const u32x2 uu = uc[dt];
            const float s0 = bflo(uu.x) * (acc[dt][0] + bs), s1 = bfhi(uu.x) * (acc[dt][1] + bs), s2 = bflo(uu.y) * (acc[dt][2] + bs), s3 = bfhi(uu.y) * (acc[dt][3] + bs);
            ssq += (s0 * s0 + s1 * s1) + (s2 * s2 + s3 * s3);
            pk[dt].x = cvt_pk_bf16(s0, s1); pk[dt].y = cvt_pk_bf16(s2, s3); }
#pragma unroll
        for (int dp = 0; dp < 2; ++dp) *(u32x4*)(F.MIX + (tk0 + p) * DM + 1024 + gi * 64 + 32 * dp + 4 * quad + ((quad & 1) ? 12 : 0)) = pair16(pk[2 * dp], pk[2 * dp + 1]);
    }
    ssq += __shfl_xor(ssq, 16); ssq += __shfl_xor(ssq, 32);
    if (quad == 0) F.RB[tk0 + p] = 1.0f / sqrtf(ssq * (1.0f / 1024.0f) + EPS);
}

__device__ __forceinline__ void router_unit(Frame& F, int unit) {
    constexpr int WROW = 544, WBUF = 64 * WROW;
    LAS unsigned char* wimg = F.lds;
    LAS float* lgL = (LAS float*)(F.lds + 2 * WBUF);
    LAS unsigned* histL = (LAS unsigned*)(F.lds + 2 * WBUF + 16896); LAS unsigned* baseL = histL + 32;
    const int tid = F.tid, lane = F.lane, w = F.wave, fr = lane & 15, quad = lane >> 4;
    const int token = unit * 128 + 16 * w + fr;
    __syncthreads();
    if (tid < 32) histL[tid] = 0u;
    const bf16* xrow = F.X2B + (size_t)token * DM + 8 * quad;
    unsigned char* trow = F.H8 + (size_t)token * DM + 8 * quad;
    f32x4 acc[2]; acc[0] = (f32x4){0.f, 0.f, 0.f, 0.f}; acc[1] = acc[0];
    float rstd;
    { const f32x4 p0 = *(const f32x4*)(F.SSX + (size_t)token * 32 + 8 * quad), p1 = *(const f32x4*)(F.SSX + (size_t)token * 32 + 8 * quad + 4);
      float ss = ((p0.x + p0.y) + (p0.z + p0.w)) + ((p1.x + p1.y) + (p1.z + p1.w)); ss += __shfl_xor(ss, 16); ss += __shfl_xor(ss, 32); rstd = 1.0f / sqrtf(ss * (1.0f / DM) + EPS); }
    u32x4 wst[4];
#define RT_WLOAD(c) do { _Pragma("unroll") for (int j = 0; j < 4; ++j) { const int id = j * 512 + tid, row = id >> 5, cc = id & 31; \
        wst[j] = *(const u32x4*)((row < 32 ? F.WRH + (size_t)row * DM : F.WRL + (size_t)(row - 32) * DM) + 256 * (c) + 8 * cc); } } while (0)
#define RT_WSTORE(b) do { _Pragma("unroll") for (int j = 0; j < 4; ++j) { const int id = j * 512 + tid, row = id >> 5, cc = id & 31; *(LAS u32x4*)(wimg + (b) * WBUF + row * WROW + cc * 16) = wst[j]; } } while (0)
    RT_WLOAD(0); RT_WSTORE(0);
    __syncthreads();
    for (int c = 0; c < 8; ++c) {
        if (c < 7) RT_WLOAD(c + 1);
        const LAS unsigned char* wb = wimg + (c & 1) * WBUF + fr * WROW + quad * 16;
#pragma unroll 2
        for (int kp = 0; kp < 4; ++kp) {
            u32x2 t8[2];
#pragma unroll
            for (int h2 = 0; h2 < 2; ++h2) { const int kl = 2 * kp + h2, ks = 8 * c + kl;
                const u32x4 xr = *(const u32x4*)(xrow + 32 * ks); const f32x4 xa = {bflo(xr.x), bfhi(xr.x), bflo(xr.y), bfhi(xr.y)}, xb = {bflo(xr.z), bfhi(xr.z), bflo(xr.w), bfhi(xr.w)};
                const f32x4 ga = *(const f32x4*)(F.g2 + 32 * ks + 8 * quad), gb = *(const f32x4*)(F.g2 + 32 * ks + 8 * quad + 4);
                const f32x4 ya = xa * ga * rstd, yb = xb * gb * rstd;
                u32x4 h; h.x = cvt_pk_bf16(ya.x, ya.y); h.y = cvt_pk_bf16(ya.z, ya.w); h.z = cvt_pk_bf16(yb.x, yb.y); h.w = cvt_pk_bf16(yb.z, yb.w);
                u32x4 l; l.x = cvt_pk_bf16(ya.x - bflo(h.x), ya.y - bfhi(h.x)); l.y = cvt_pk_bf16(ya.z - bflo(h.y), ya.w - bfhi(h.y)); l.z = cvt_pk_bf16(yb.x - bflo(h.z), yb.y - bfhi(h.z)); l.w = cvt_pk_bf16(yb.z - bflo(h.w), yb.w - bfhi(h.w));
                t8[h2].x = pk4_fp8(ya.x, ya.y, ya.z, ya.w); t8[h2].y = pk4_fp8(yb.x, yb.y, yb.z, yb.w);
                const bf16x8 yh = __builtin_bit_cast(bf16x8, h), yl = __builtin_bit_cast(bf16x8, l);
#pragma unroll
                for (int et = 0; et < 2; ++et) {
                    const bf16x8 wh = *(const LAS bf16x8*)(wb + (16 * et) * WROW + kl * 64), wl = *(const LAS bf16x8*)(wb + (32 + 16 * et) * WROW + kl * 64);
                    acc[et] = __builtin_amdgcn_mfma_f32_16x16x32_bf16(wh, yh, acc[et], 0, 0, 0);
                    acc[et] = __builtin_amdgcn_mfma_f32_16x16x32_bf16(wh, yl, acc[et], 0, 0, 0);
                    acc[et] = __builtin_amdgcn_mfma_f32_16x16x32_bf16(wl, yh, acc[et], 0, 0, 0); } }
            *(u32x4*)(trow + 64 * (4 * c + kp) + ((quad & 1) ? 24 : 0)) = pair16(t8[0], t8[1]);
        }
        if (c < 7) RT_WSTORE((c + 1) & 1);
        __syncthreads();
    }
#undef RT_WLOAD
#undef RT_WSTORE
#pragma unroll
    for (int et = 0; et < 2; ++et)
#pragma unroll
        for (int i = 0; i < 4; ++i) { const int e = 16 * et + 4 * quad + i; lgL[(w * 16 + fr) * 33 + e] = acc[et][i] + F.b_r[e]; }
    __syncthreads();
    int ev[4]; float gv[4]; unsigned lp[4];
    const int mytok = unit * 128 + 16 * w + lane;
    if (lane < 16) {
        const LAS float* lg = lgL + (w * 16 + lane) * 33; unsigned mask = 0u; float vv[4];
#pragma unroll
        for (int k = 0; k < 4; ++k) { float best = -INFINITY; int bi = 0;
            for (int e = 0; e < 32; ++e) { const float v = lg[e]; if (!((mask >> e) & 1u) && v > best) { best = v; bi = e; } }
            mask |= 1u << bi; ev[k] = bi; vv[k] = best; }
        const float e1 = __expf(vv[1] - vv[0]), e2 = __expf(vv[2] - vv[0]), e3 = __expf(vv[3] - vv[0]); const float inv = 1.0f / (1.0f + e1 + e2 + e3);
        gv[0] = inv; gv[1] = e1 * inv; gv[2] = e2 * inv; gv[3] = e3 * inv;
#pragma unroll
        for (int k = 0; k < 4; ++k) lp[k] = __hip_atomic_fetch_add(histL + ev[k], 1u, __ATOMIC_RELAXED, __HIP_MEMORY_SCOPE_WORKGROUP);
    }
    __syncthreads();
    if (tid < 32) baseL[tid] = __hip_atomic_fetch_add((unsigned*)(F.ctl + CW_CNT + 64 * tid), histL[tid], RLX_AGENT);
    __syncthreads();
    if (lane < 16) {
#pragma unroll
        for (int k = 0; k < 4; ++k) { const unsigned pos = baseL[ev[k]] + lp[k];
            F.LIST[(size_t)ev[k] * CAP + pos] = mytok * 4 + k; F.GATE[(size_t)mytok * 4 + k] = gv[k]; }
    }
}

__device__ __forceinline__ int moe_tables(Frame& F) {
    LAS int* cntL = (LAS int*)(F.lds + XT_CNT); LAS int* tstartL = (LAS int*)(F.lds + XT_TSTART); LAS unsigned char* tileE = F.lds + XT_TILEE;
    __syncthreads();
    if (F.tid < 32) cntL[F.tid] = (int)__hip_atomic_load((unsigned*)(F.ctl + CW_CNT + 64 * F.tid), RLX_AGENT);
    __syncthreads();
    if (F.tid == 0) { int s = 0; for (int e = 0; e < 32; ++e) { tstartL[e] = s; s += (cntL[e] + 255) >> 8; } tstartL[32] = s; }
    __syncthreads();
    const int total = tstartL[32];
    for (int mt = F.tid; mt < total; mt += 512) { int e = 0; for (int k = 1; k < 32; ++k) e += (tstartL[k] <= mt) ? 1 : 0; tileE[mt] = (unsigned char)e; }
    __syncthreads();
    return __builtin_amdgcn_readfirstlane(total);
}

struct Args { const float* in[19]; float* out; unsigned char* ws; int ph_lo, ph_hi; };
__global__ void __launch_bounds__(NWAVES * 64, 2) mk_fwd(Args args) {
    extern __shared__ __attribute__((aligned(16))) unsigned char lds[];
    Frame F;
    F.lds = (LAS unsigned char*)lds;
    F.MISC = (volatile LAS unsigned*)(F.lds + MISC_OFF);
    F.tid = threadIdx.x; F.lane = F.tid & 63; F.wave = __builtin_amdgcn_readfirstlane(F.tid >> 6);
    F.G = gridDim.x; { const int bx = blockIdx.x; F.vcu = (F.G % 8 == 0) ? (bx % 8) * (F.G / 8) + bx / 8 : bx; }
    unsigned char* ws = args.ws;
    F.ctl = (gu32*)(ws + WS_CTL);
    F.x = args.in[0]; F.g1 = args.in[1]; F.w_in = args.in[2]; F.gq = args.in[3]; F.gk = args.in[4]; F.rpb = args.in[5]; F.gsg = args.in[6]; F.w_sp = args.in[7]; F.b_sp = args.in[8];
    F.ga = args.in[9]; F.gs = args.in[10]; F.w_out = args.in[11]; F.g2 = args.in[12]; F.w_r = args.in[13]; F.b_r = args.in[14]; F.w_gu = args.in[15]; F.b_gu = args.in[16]; F.w_dn = args.in[17]; F.b_dn = args.in[18];
    F.out = args.out;
    F.WIN = (bf16*)(ws + WS_WIN); F.WOUT = (bf16*)(ws + WS_WOUT); F.WSP = (bf16*)(ws + WS_WSP); F.WRH = (bf16*)(ws + WS_WRH); F.WRL = (bf16*)(ws + WS_WRL);
    F.WGU = ws + WS_WGU; F.WDN = ws + WS_WDN; F.H = (bf16*)(ws + WS_H); F.H8 = ws + WS_H; F.PROJ = (bf16*)(ws + WS_PROJ); F.X2B = (bf16*)(ws + WS_PROJ);     F.MIX = (bf16*)(ws + WS_MIX);
    F.ACT = ws + WS_ACT; F.Y = ws + WS_Y; F.SSX = (float*)(ws + WS_SSX); F.RA = (float*)(ws + WS_RA); F.RB = (float*)(ws + WS_RB); F.SSQA = (float*)(ws + WS_SSQA); F.SSG = (float*)(ws + WS_SSG); F.RSTD2 = (float*)(ws + WS_RSTD2); F.GATE = (float*)(ws + WS_GATE); F.SLOT = (unsigned*)(ws + WS_SLOT); F.LIST = (int*)(ws + WS_LIST);
    for (int u = F.tid; u < (LDS_BYTES - LDSCTL_OFF) / 4; u += NWAVES * 64) ((LAS unsigned*)(F.lds + LDSCTL_OFF))[u] = 0u;
    __syncthreads();
    XcdBarrier bar; bar.bar = (unsigned*)(F.ctl + CW_BAR); bar.x = 0; bar.st = nullptr;
    if (N_LAUNCHES == 1) bar = xcd_barrier_post((unsigned*)(F.ctl + CW_BAR), F.MISC + 8);
#define GRID_BAR() do { if (N_LAUNCHES == 1) xcd_barrier(bar); } while (0)
    const int lo = args.ph_lo, hi = args.ph_hi;
#define IN(k) (lo <= (k) && (k) < hi)
#define BOTH(k) (IN(k) && IN((k) + 1))

    if (IN(0)) { p0_prologue(F); if (BOTH(0)) GRID_BAR(); }

    if (IN(1)) {
        TileOrder S; S.init(NTOK / BM, NPROJ / BM, F.G, (int)blockIdx.x, nullptr);
        EpiProjX E{F.PROJ, F.gq, F.gk, F.SSG};
        const int grp = F.vcu & 1, nconv = (NE * (16 * 16 + 16 * 8) - F.vcu + F.G - 1) / F.G, hconv = nconv / 2;
        moe_convert(F, 0, grp == 0 ? hconv : 0);
        S.ib = 0; S.ie = 5;
        gemm_phase<EpiProjX, false, true, false>(F.lds, (const char*)F.H, (const char*)F.WIN, 0, DM * 2, S, E, nullptr);
        moe_convert(F, grp == 0 ? hconv : 0, grp == 0 ? nconv : hconv);
        S.ib = 5; S.ie = 0x7fffffff;
        gemm_phase<EpiProjX, false, true, false>(F.lds, (const char*)F.H, (const char*)F.WIN, 0, DM * 2, S, E, nullptr);
        moe_convert(F, grp == 0 ? nconv : hconv, nconv);
        if (BOTH(1)) GRID_BAR();
    }

    if (IN(2)) {
        for (int u = F.vcu; u < NBATCH * 16 * 8; u += F.G) attn_unit(F, u >> 7, (u >> 3) & 15, u & 7);
        if (BOTH(2)) GRID_BAR();
    }

    if (IN(3)) {
        for (int u = F.vcu; u < NTOK / 128; u += F.G) sgu_unit(F, u);
        if (BOTH(3)) GRID_BAR();
    }

    if (IN(4)) {
        TileOrder S; S.init(NTOK / BM, DM / BM, F.G, (int)blockIdx.x, nullptr);
        EpiResid E{F.x, F.X2B, DM, F.RA, F.RB, F.SSX};
        gemm_phase<EpiResid, false, true, false>(F.lds, (const char*)F.MIX, (const char*)F.WOUT, 0, DM * 2, S, E, nullptr);
        if (BOTH(4)) GRID_BAR();
    }

    if (IN(5)) {
        for (int u = F.vcu; u < NTOK / 128; u += F.G) router_unit(F, u);
        if (BOTH(5)) GRID_BAR();
    }

    if (IN(6)) {
        const int total = moe_tables(F);
        LAS unsigned short* tokL = (LAS unsigned short*)(F.lds + XT_TOKL); const LAS int* cntL = (const LAS int*)(F.lds + XT_CNT); const LAS int* tstartL = (const LAS int*)(F.lds + XT_TSTART);
        TileOrder S; S.init(total, 16, F.G, (int)blockIdx.x, F.lds + XT_TILEE);
        { Unit u; for (int i = 0; i < 36 && S.next(i, u); ++i) { if (F.tid < 256) { const int lp = (u.pm - tstartL[u.e]) * 256 + F.tid; tokL[i * 256 + F.tid] = (unsigned short)(lp < cntL[u.e] ? (F.LIST[(size_t)u.e * CAP + lp] >> 2) : 0); } } }
        __syncthreads();
        EpiSwiglu E{F.ACT, F.b_gu, (const LAS float*)(F.lds + XT_BIAS), (unsigned)(size_t)(F.lds + XT_BIAS)};
        gemm_phase<EpiSwiglu, true, true, true>(F.lds, (const char*)F.H8, (const char*)F.WGU, (size_t)4096 * DM, DM, S, E, tokL);
        if (BOTH(6)) GRID_BAR();
    }

    if (IN(7)) {
        const int total = moe_tables(F);
        LAS unsigned* dstL = (LAS unsigned*)(F.lds + XT_TOKL); const LAS int* cntL = (const LAS int*)(F.lds + XT_CNT); const LAS int* tstartL = (const LAS int*)(F.lds + XT_TSTART);
        TileOrder S; S.init(total, 8, F.G, (int)blockIdx.x, F.lds + XT_TILEE);
        { Unit u; for (int i = 0; i < 18 && S.next(i, u); ++i) { if (F.tid < 256) { const int lp = (u.pm - tstartL[u.e]) * 256 + F.tid; dstL[i * 256 + F.tid] = lp < cntL[u.e] ? (unsigned)F.LIST[(size_t)u.e * CAP + lp] : (unsigned)(NTOK * TOPK); } } }
        __syncthreads();
        EpiDown E{F.Y, F.b_dn, dstL, (const LAS float*)(F.lds + XT_BIAS), (unsigned)(size_t)(F.lds + XT_BIAS)};
        gemm_phase<EpiDown, false, true, true>(F.lds, (const char*)F.ACT, (const char*)F.WDN, (size_t)DM * DM, DM, S, E, nullptr);
        if (BOTH(7)) GRID_BAR();
    }

    if (IN(8)) {
        const int gw = F.vcu * NWAVES + F.wave, NGW = F.G * NWAVES, lane = F.lane;
        for (int t = gw; t < NTOK; t += NGW) {
            const f32x4 gt = *(const f32x4*)(F.GATE + (size_t)t * 4);
            float* orow = F.out + (size_t)t * DM + 16 * lane; const unsigned char* yrow = F.Y + (size_t)t * 4 * DM + 16 * lane; const bf16* xrow = F.X2B + (size_t)t * DM + 16 * lane;
#pragma unroll
            for (int j = 0; j < 2; ++j) { f32x4 o[4];
                const u32x4 xlo = *(const u32x4*)(xrow + 1024 * j), xhi = *(const u32x4*)(xrow + 1024 * j + 8);
                o[0] = (f32x4){bflo(xlo.x), bfhi(xlo.x), bflo(xlo.y), bfhi(xlo.y)}; o[1] = (f32x4){bflo(xlo.z), bfhi(xlo.z), bflo(xlo.w), bfhi(xlo.w)};
                o[2] = (f32x4){bflo(xhi.x), bfhi(xhi.x), bflo(xhi.y), bfhi(xhi.y)}; o[3] = (f32x4){bflo(xhi.z), bfhi(xhi.z), bflo(xhi.w), bfhi(xhi.w)};
#pragma unroll
                for (int k = 0; k < 4; ++k) { const u32x4 y = *(const u32x4*)(yrow + (size_t)k * DM + 1024 * j); const float g = gt[k];
#pragma unroll
                    for (int q = 0; q < 4; ++q) { const f32x2 lo = __builtin_amdgcn_cvt_pk_f32_fp8((int)y[q], false), hi = __builtin_amdgcn_cvt_pk_f32_fp8((int)y[q], true);
                        o[q].x += g * lo.x; o[q].y += g * lo.y; o[q].z += g * hi.x; o[q].w += g * hi.y; } }
#pragma unroll
                for (int q = 0; q < 4; ++q) *(f32x4*)(orow + 1024 * j + 4 * q) = o[q]; }
        }
    }
#undef IN
#undef BOTH
}

extern "C" void kernel_launch(void* const* d_in, const int* in_sizes, int n_in, void* d_out, int out_size, void* d_ws, size_t ws_size, hipStream_t stream) {
    static int grid = 0;
    if (grid == 0) {
        if (n_in != 19 || out_size != NTOK * DM || ws_size < WS_END) { fprintf(stderr, "kernel_launch: unexpected problem (n_in %d, out %d, ws %zu)\n", n_in, out_size, ws_size); grid = -1; return; }
        int dev = 0, cus = 0, per_cu = 0;
        if (hipGetDevice(&dev) != hipSuccess || hipDeviceGetAttribute(&cus, hipDeviceAttributeMultiprocessorCount, dev) != hipSuccess) { grid = -1; return; }
        if (hipFuncSetAttribute((const void*)mk_fwd, hipFuncAttributeMaxDynamicSharedMemorySize, LDS_BYTES) != hipSuccess) { fprintf(stderr, "kernel_launch: hipFuncSetAttribute failed\n"); grid = -1; return; }
        if (hipOccupancyMaxActiveBlocksPerMultiprocessor(&per_cu, (const void*)mk_fwd, NWAVES * 64, LDS_BYTES) != hipSuccess || per_cu < 1) { fprintf(stderr, "kernel_launch: occupancy query says %d\n", per_cu); }
        (void)hipGetLastError();
        grid = cus;
    }
    if (grid < 0) return;
    if (hipMemsetAsync((char*)d_ws + WS_CTL, 0, CTL_ZERO_BYTES, stream) != hipSuccess) return;
    Args a{};
    for (int i = 0; i < 19; ++i) a.in[i] = (const float*)d_in[i];
    a.out = (float*)d_out; a.ws = (unsigned char*)d_ws;
    for (int li = 0; li < N_LAUNCHES; ++li) {
        a.ph_lo = (N_LAUNCHES == 1) ? 0 : li; a.ph_hi = (N_LAUNCHES == 1) ? N_PHASES : li + 1;
        hipLaunchKernelGGL(mk_fwd, dim3(grid), dim3(NWAVES * 64), LDS_BYTES, stream, a);
    }
}
```

```cpp
#include <hip/hip_runtime.h>
#include <cstdio>
#include <cstdint>

#ifndef MK_N_LAUNCHES
#define MK_N_LAUNCHES 1
#endif
constexpr int N_LAUNCHES = MK_N_LAUNCHES;
constexpr int N_PHASES = 9;

#define LAS __attribute__((address_space(3)))
#define GAS __attribute__((address_space(1)))
typedef unsigned short bf16;
typedef short bf16x8 __attribute__((ext_vector_type(8)));
typedef short s16x4 __attribute__((ext_vector_type(4)));
typedef float f32x4 __attribute__((ext_vector_type(4)));
typedef float f32x2 __attribute__((ext_vector_type(2)));
typedef unsigned u32x4 __attribute__((ext_vector_type(4)));
typedef unsigned u32x2 __attribute__((ext_vector_type(2)));
typedef GAS unsigned gu32;
typedef int v8i __attribute__((ext_vector_type(8)));
typedef int v4i __attribute__((ext_vector_type(4)));

constexpr int NTOK = 32768, DM = 2048, NPROJ = 5120, SEQ = 8192, NBATCH = 4;
constexpr int NE = 32, TOPK = 4, CAP = 32768;
constexpr int MAXROWS = NTOK * TOPK + NE * 256;
constexpr float EPS = 1e-6f;
constexpr int NWAVES = 8;

constexpr size_t MiB = 1u << 20;
constexpr size_t WS_CTL = 0, CTL_ZERO_BYTES = 1 * MiB;
constexpr size_t WS_WIN = 2 * MiB;
constexpr size_t WS_WOUT = 22 * MiB;
constexpr size_t WS_WSP = 30 * MiB;
constexpr size_t WS_WRH = 31 * MiB;
constexpr size_t WS_WRL = 31 * MiB + 128 * 1024;
constexpr size_t WS_RSTD2 = 31 * MiB + 512 * 1024;
constexpr size_t WS_SLOT = 32 * MiB;
constexpr size_t WS_GATE = 32 * MiB + 512 * 1024;
constexpr size_t WS_LIST = 33 * MiB;
constexpr size_t WS_WGU = 40 * MiB;
constexpr size_t WS_SSQA = 300 * MiB;
constexpr size_t WS_SSG = 304 * MiB;
constexpr size_t WS_RA = 308 * MiB;
constexpr size_t WS_RB = 309 * MiB;
constexpr size_t WS_SSX = 312 * MiB;
constexpr size_t WS_RMS1 = 310 * MiB;
constexpr size_t WS_IG1 = 311 * MiB;
constexpr size_t WS_WDN = 552 * MiB;
constexpr size_t WS_H = 808 * MiB;
constexpr size_t WS_PROJ = 936 * MiB;
constexpr size_t WS_MIX = 1256 * MiB;
constexpr size_t WS_ACT = 1384 * MiB;
constexpr size_t WS_Y = 1928 * MiB;
constexpr size_t WS_END = 2472 * MiB;

constexpr int CW_TMO = 0, CW_CODE = 1;
constexpr int CW_BAR = 4096;
constexpr int CW_CNT = 8192;

constexpr int RING_BYTES = 131072;
constexpr int XT_OFF = RING_BYTES;
constexpr int XT_TOKL = XT_OFF;
constexpr int XT_TILEE = XT_OFF + 18432;
constexpr int XT_TSTART = XT_TILEE + 576;
constexpr int XT_CNT = XT_TSTART + 160;
constexpr int XT_BIAS = XT_OFF + 19456;
constexpr int XT_GAINS = XT_BIAS + 2048;
constexpr int XT_MISC2 = XT_GAINS + 512;
constexpr int AT_RPB = 147456;
constexpr int AT_MRG = AT_RPB + 2048;
constexpr int LDSCTL_OFF = AT_MRG + 10240;
constexpr int MISC_OFF = LDSCTL_OFF + 320;
constexpr int LDS_BYTES = LDSCTL_OFF + 1024;
static_assert(XT_CNT + 128 <= XT_BIAS && XT_MISC2 <= LDSCTL_OFF && LDS_BYTES <= 160 * 1024, "LDS map");
constexpr int N_PH = 9;

#define RLX_AGENT __ATOMIC_RELAXED, __HIP_MEMORY_SCOPE_AGENT
#define LDS_WAIT() asm volatile("s_waitcnt lgkmcnt(0)" ::: "memory")
#define VM_WAIT() asm volatile("s_waitcnt vmcnt(0)" ::: "memory")

__device__ __forceinline__ unsigned cvt_pk_bf16(float lo, float hi) { unsigned r; asm volatile("v_cvt_pk_bf16_f32 %0, %1, %2" : "=v"(r) : "v"(lo), "v"(hi)); return r; }
__device__ __forceinline__ unsigned pk4_fp8(float a, float b, float c, float d) { int w = 0; w = __builtin_amdgcn_cvt_pk_fp8_f32(a, b, w, false); w = __builtin_amdgcn_cvt_pk_fp8_f32(c, d, w, true); return (unsigned)w; }
__device__ __forceinline__ v8i cat8(bf16x8 a, bf16x8 b) { const v4i x = __builtin_bit_cast(v4i, a), y = __builtin_bit_cast(v4i, b); return __builtin_shufflevector(x, y, 0, 1, 2, 3, 4, 5, 6, 7); }
__device__ __forceinline__ bf16x8 lo8(v8i a) { return __builtin_bit_cast(bf16x8, (v4i)__builtin_shufflevector(a, a, 0, 1, 2, 3)); }
__device__ __forceinline__ bf16x8 hi8(v8i a) { return __builtin_bit_cast(bf16x8, (v4i)__builtin_shufflevector(a, a, 4, 5, 6, 7)); }
__device__ __forceinline__ void glds16(const void* gsrc, unsigned lds_dst) { unsigned keep;
    asm volatile("s_mov_b32 %0, m0\n\ts_mov_b32 m0, %2\n\ts_nop 0\n\tglobal_load_lds_dwordx4 %1, off\n\ts_mov_b32 m0, %0" : "=&s"(keep) : "v"(gsrc), "s"(lds_dst) : "memory"); }
__device__ __forceinline__ u32x4 pair16(u32x2 a, u32x2 b) { const auto s0 = __builtin_amdgcn_permlane16_swap(a.x, b.x, false, false), s1 = __builtin_amdgcn_permlane16_swap(a.y, b.y, false, false);
    u32x4 w; w.x = s0[0]; w.y = s1[0]; w.z = s0[1]; w.w = s1[1]; return w; }
__device__ __forceinline__ float bflo(unsigned u) { return __uint_as_float(u << 16); }
__device__ __forceinline__ float bfhi(unsigned u) { return __uint_as_float(u & 0xffff0000u); }
__device__ __forceinline__ float wave_sum(float v) {
#pragma unroll
    for (int o = 1; o < 64; o <<= 1) v += __shfl_xor(v, o);
    return v;
}
__device__ __forceinline__ f32x2 gelu_pk(f32x2 v) {
    const f32x2 av = __builtin_elementwise_abs(v), d = av * 0.2316418882f + 1.0f;
    f32x2 t; t.x = __builtin_amdgcn_rcpf(d.x); t.y = __builtin_amdgcn_rcpf(d.y);
    f32x2 q = t * 0.5307027145f + (-0.7265760135f); q = q * t + 0.7107068705f; q = q * t + (-0.142248368f); q = q * t + 0.127414796f; q = q * t;
    const f32x2 s = (v * v) * (-0.72134752044f);
    f32x2 e; e.x = __builtin_amdgcn_exp2f(s.x); e.y = __builtin_amdgcn_exp2f(s.y);
    const f32x2 m = v * (q * e), r = v - m;
    f32x2 o; o.x = v.x < 0.f ? m.x : r.x; o.y = v.y < 0.f ? m.y : r.y; return o;
}
__device__ __forceinline__ float gelu1(float x) { f32x2 r = gelu_pk((f32x2){x, x}); return r.x; }

#define XB_TMO      128
#define XB_XCNT(j)  (256  + 64 * (j))
#define XB_XSUB(j)  (1280 + 64 * (j))
#define XB_XGEN(j)  (2304 + 64 * (j))
#define XB_TOP      3328
#define XB_TOPGEN   3392
#define XCD_BAR_WORDS 3456
#define XB_SPIN_CAP (1u << 18)
__device__ __forceinline__ unsigned xb_ld(unsigned* p)              { return __hip_atomic_load(p, __ATOMIC_RELAXED, __HIP_MEMORY_SCOPE_AGENT); }
__device__ __forceinline__ unsigned xb_add(unsigned* p, unsigned v) { return __hip_atomic_fetch_add(p, v, __ATOMIC_RELAXED, __HIP_MEMORY_SCOPE_AGENT); }
__device__ __forceinline__ unsigned xb_xcc_id() { return (unsigned)__builtin_amdgcn_s_getreg((3 << 11) | 20) & 0xFu; }
#define XB_SPIN(cond, bar) do { unsigned _sp = 0; while (cond) { __builtin_amdgcn_s_sleep(1); \
    if ((++_sp & 255u) == 0u) { if (xb_ld(&(bar)[XB_TMO])) break; if (_sp > XB_SPIN_CAP) { atomicAdd(&(bar)[XB_TMO], 1u); break; } } } } while (0)
struct XcdBarrier { unsigned* bar; unsigned x; volatile LAS unsigned* st; };
__device__ __forceinline__ XcdBarrier xcd_barrier_post(unsigned* bar, volatile LAS unsigned* st) {
    XcdBarrier b; b.bar = bar; b.x = xb_xcc_id(); b.st = st;
    if (threadIdx.x == 0) (void)xb_add(&bar[XB_XCNT(b.x)], 1u);
    return b;
}
__device__ __forceinline__ void xcd_barrier_complete(unsigned* bar, unsigned x, unsigned& nloc, unsigned& nx) {
    const unsigned G = gridDim.x * gridDim.y * gridDim.z;
    unsigned sum, cnt, mine, sp = 0u;
    for (;;) {
        sum = 0u; cnt = 0u; mine = 0u;
#pragma unroll
        for (unsigned j = 0; j < 16; ++j) { const unsigned c = xb_ld(&bar[XB_XCNT(j)]); sum += c; cnt += (c > 0u) ? 1u : 0u; mine = (j == x) ? c : mine; }
        if (sum == G) break;
        __builtin_amdgcn_s_sleep(1);
        if ((++sp & 255u) == 0u) { if (xb_ld(&bar[XB_TMO])) break; if (sp > XB_SPIN_CAP) { atomicAdd(&bar[XB_TMO], 1u); break; } }
    }
    nloc = mine > 0u ? mine : 1u; nx = cnt > 0u ? cnt : 1u;
}
__device__ __forceinline__ void xcd_barrier(const XcdBarrier& b) {
    asm volatile("s_waitcnt vmcnt(0)" ::: "memory");
    __syncthreads();
    if (threadIdx.x == 0) {
        unsigned* bar = b.bar;
        __builtin_amdgcn_s_waitcnt(0);
        unsigned nloc = b.st[0], nx = b.st[1];
        if (nloc == 0u) { xcd_barrier_complete(bar, b.x, nloc, nx); b.st[0] = nloc; b.st[1] = nx; }
        const unsigned old = xb_add(&bar[XB_XSUB(b.x)], 1u);
        const unsigned gen = old / nloc;
        if (old + 1u == (gen + 1u) * nloc) {
            __builtin_amdgcn_fence(__ATOMIC_RELEASE, "agent");
            asm volatile("s_waitcnt vmcnt(0)" ::: "memory");
            const unsigned og = xb_add(&bar[XB_TOP], 1u);
            const unsigned tg = og / nx;
            if (og + 1u == (tg + 1u) * nx) xb_add(&bar[XB_TOPGEN], 1u);
            else XB_SPIN(xb_ld(&bar[XB_TOPGEN]) == tg, bar);
            __builtin_amdgcn_fence(__ATOMIC_ACQUIRE, "agent");
            xb_add(&bar[XB_XGEN(b.x)], 1u);
            asm volatile("s_waitcnt vmcnt(0)" ::: "memory");
        } else {
            XB_SPIN(xb_ld(&bar[XB_XGEN(b.x)]) == gen, bar);
            __builtin_amdgcn_fence(__ATOMIC_ACQUIRE, "agent");
            asm volatile("s_waitcnt vmcnt(0)" ::: "memory");
        }
    }
    __syncthreads();
}

constexpr int BM = 256, BK = 64, HALF = 128, HTB = HALF * BK * 2, NXCD = 8, WGM = 8;
__host__ __device__ __forceinline__ int lds_byte(int r, int c) { const int st = (r >> 4) * 2 + (c >> 5), rr = r & 15, cc = c & 31, ob = rr * 64 + cc * 2; return st * 1024 + (ob ^ (((ob >> 9) & 1) << 5)); }
__host__ __device__ __forceinline__ void stage_rc(int b, int& R, int& C) { const int st = b / 1024, sb = b % 1024, swz = sb ^ (((sb >> 9) & 1) << 5); R = (st >> 1) * 16 + swz / 64; C = (st & 1) * 32 + (swz % 64) / 2; }
__host__ __device__ __forceinline__ int perm32(int rho) { const int n = rho >> 4, i = rho & 15; return 8 * (i >> 2) + 4 * n + (i & 3); }

struct Unit { int pm, pn, e, ui; };
struct TileOrder {
    int nM, nN, nwg, G, c, ib, ie; const LAS unsigned char* tileE;
    __device__ __forceinline__ void init(int nM_, int nN_, int G_, int c_, const LAS unsigned char* te) { nM = nM_; nN = nN_; nwg = nM * nN; G = G_; c = c_; tileE = te; ib = 0; ie = 0x7fffffff; }
    __device__ __forceinline__ bool next(int i_, Unit& u) const {
        const int i = ib + i_; if (i >= ie) return false;
        const long L = (long)i * G + c; if (L >= nwg) return false;
        int wgid = (int)L; { const int q = nwg / NXCD, r = nwg % NXCD, xcd = wgid % NXCD, off = wgid / NXCD; wgid = (xcd < r ? xcd * (q + 1) : r * (q + 1) + (xcd - r) * q) + off; }
        const int nig = WGM * nN, gid = wgid / nig, fm = gid * WGM, gsz = (nM - fm) < WGM ? (nM - fm) : WGM;
        u.pm = fm + ((wgid % nig) % gsz); u.pn = (wgid % nig) / gsz; u.ui = i;
        u.e = tileE ? __builtin_amdgcn_readfirstlane((int)tileE[u.pm]) : 0;
        return true;
    }
};

struct EpiProjX {
    static constexpr bool MIDK = false, BIASL = false;
    static constexpr bool PERM = true;
    bf16* O; const float* gq; const float* gk; float* SSG;
    __device__ __forceinline__ void operator()(const f32x4 (&acc)[2][2][4][2], const Unit& u, int wr, int wc, int fr, int fq) const {
        const int row0 = u.pm * BM + wr * 64 + fr, col0 = u.pn * BM + wc * 64 + 8 * fq, kind = u.pn >> 2;
        if (kind <= 1) {
            const float* gp = (kind == 0 ? gq : gk) + 8 * fq; const float qs = kind == 0 ? 0.125f * 1.4426950408889634f : 1.0f;
            const f32x4 g00 = *(const f32x4*)(gp), g01 = *(const f32x4*)(gp + 4), g10 = *(const f32x4*)(gp + 32), g11 = *(const f32x4*)(gp + 36);
#pragma unroll
            for (int ai = 0; ai < 2; ++ai)
#pragma unroll
                for (int m = 0; m < 4; ++m) { const f32x4 a = acc[ai][0][m][0], b = acc[ai][0][m][1], c = acc[ai][1][m][0], d = acc[ai][1][m][1];
                    float ss = (a.x * a.x + a.y * a.y) + (a.z * a.z + a.w * a.w) + (b.x * b.x + b.y * b.y) + (b.z * b.z + b.w * b.w) + (c.x * c.x + c.y * c.y) + (c.z * c.z + c.w * c.w) + (d.x * d.x + d.y * d.y) + (d.z * d.z + d.w * d.w);
                    ss += __shfl_xor(ss, 16); ss += __shfl_xor(ss, 32);
                    const float r = qs / sqrtf(ss * (1.0f / 64.0f) + EPS);
                    const f32x4 oa = a * r * g00, ob = b * r * g01, oc = c * r * g10, od = d * r * g11;
                    bf16* rowp = O + (size_t)(row0 + ai * HALF + m * 16) * NPROJ + col0;
                    u32x4 w0, w1; w0.x = cvt_pk_bf16(oa.x, oa.y); w0.y = cvt_pk_bf16(oa.z, oa.w); w0.z = cvt_pk_bf16(ob.x, ob.y); w0.w = cvt_pk_bf16(ob.z, ob.w);
                    w1.x = cvt_pk_bf16(oc.x, oc.y); w1.y = cvt_pk_bf16(oc.z, oc.w); w1.z = cvt_pk_bf16(od.x, od.y); w1.w = cvt_pk_bf16(od.z, od.w);
                    *(u32x4*)(rowp) = w0; *(u32x4*)(rowp + 32) = w1; }
        } else if (kind == 2) {
#pragma unroll
            for (int ai = 0; ai < 2; ++ai)
#pragma unroll
                for (int m = 0; m < 4; ++m) { bf16* rowp = O + (size_t)(row0 + ai * HALF + m * 16) * NPROJ + col0;
#pragma unroll
                    for (int bj = 0; bj < 2; ++bj) { const f32x4 v0 = acc[ai][bj][m][0], v1 = acc[ai][bj][m][1];
                        u32x4 w; w.x = cvt_pk_bf16(v0[0], v0[1]); w.y = cvt_pk_bf16(v0[2], v0[3]); w.z = cvt_pk_bf16(v1[0], v1[1]); w.w = cvt_pk_bf16(v1[2], v1[3]);
                        *(u32x4*)(rowp + bj * 32) = w; } }
        } else {
#pragma unroll
            for (int ai = 0; ai < 2; ++ai)
#pragma unroll
                for (int m = 0; m < 4; ++m) { const int row = row0 + ai * HALF + m * 16; bf16* rowp = O + (size_t)row * NPROJ + col0; float ss = 0.f;
#pragma unroll
                    for (int bj = 0; bj < 2; ++bj) { const f32x4 v0 = acc[ai][bj][m][0], v1 = acc[ai][bj][m][1];
                        const f32x2 a = gelu_pk((f32x2){v0[0], v0[1]}), b = gelu_pk((f32x2){v0[2], v0[3]}), c = gelu_pk((f32x2){v1[0], v1[1]}), d = gelu_pk((f32x2){v1[2], v1[3]});
                        ss += (a.x * a.x + a.y * a.y) + (b.x * b.x + b.y * b.y) + (c.x * c.x + c.y * c.y) + (d.x * d.x + d.y * d.y);
                        u32x4 w; w.x = cvt_pk_bf16(a.x, a.y); w.y = cvt_pk_bf16(b.x, b.y); w.z = cvt_pk_bf16(c.x, c.y); w.w = cvt_pk_bf16(d.x, d.y);
                        *(u32x4*)(rowp + bj * 32) = w; }
                    if (kind == 4) { ss += __shfl_xor(ss, 16); ss += __shfl_xor(ss, 32); if (fq == 0) SSG[(size_t)row * 16 + (u.pn - 16) * 4 + wc] = ss; } }
        }
    }
};
struct EpiResid {
    static constexpr bool PERM = true, MIDK = true, BIASL = false;
    const bf16* hb; const float* rms1; const float* ig1; bf16* x2b; int ldc; const float* RA; const float* RB; float* SSX;
    __device__ __forceinline__ void mid(f32x4 (&acc)[2][2][4][2], const Unit& u, int wr, int fr) const {
        const int row0 = u.pm * BM + wr * 64 + fr;
#pragma unroll
        for (int ai = 0; ai < 2; ++ai)
#pragma unroll
            for (int m = 0; m < 4; ++m) { int row = row0 + ai * HALF + m * 16; asm volatile("" : "+v"(row));
                const float f = RA[row] / RB[row];
#pragma unroll
                for (int bj = 0; bj < 2; ++bj)
#pragma unroll
                    for (int n = 0; n < 2; ++n) acc[ai][bj][m][n] = acc[ai][bj][m][n] * f; }
    }
    __device__ __forceinline__ void operator()(const f32x4 (&acc)[2][2][4][2], const Unit& u, int wr, int wc, int fr, int fq) const {
        const int row0 = u.pm * BM + wr * 64 + fr, col0 = u.pn * BM + wc * 32 + 8 * fq;
        f32x4 ig[2][2];
#pragma unroll
        for (int bj = 0; bj < 2; ++bj)
#pragma unroll
            for (int n = 0; n < 2; ++n) ig[bj][n] = *(const f32x4*)(ig1 + col0 + bj * HALF + 4 * n);
#pragma unroll
        for (int ai = 0; ai < 2; ++ai) {
            u32x4 hv[4][2]; float rb[4], rm[4];
#pragma unroll
            for (int m = 0; m < 4; ++m) { const int row = row0 + ai * HALF + m * 16; const size_t off = (size_t)row * ldc + col0; rb[m] = RB[row]; rm[m] = rms1[row];
#pragma unroll
                for (int bj = 0; bj < 2; ++bj) hv[m][bj] = *(const u32x4*)(hb + off + bj * HALF); }
#pragma unroll
            for (int m = 0; m < 4; ++m) { const int row = row0 + ai * HALF + m * 16; const size_t off = (size_t)row * ldc + col0;
                float ss = 0.f;
#pragma unroll
                for (int bj = 0; bj < 2; ++bj) { const u32x4 h = hv[m][bj];
                    const f32x4 x0 = (f32x4){bflo(h.x), bfhi(h.x), bflo(h.y), bfhi(h.y)} * ig[bj][0] * rm[m], x1 = (f32x4){bflo(h.z), bfhi(h.z), bflo(h.w), bfhi(h.w)} * ig[bj][1] * rm[m];
                    const f32x4 o0 = x0 + acc[ai][bj][m][0] * rb[m], o1 = x1 + acc[ai][bj][m][1] * rb[m];
                    ss += (o0.x * o0.x + o0.y * o0.y) + (o0.z * o0.z + o0.w * o0.w) + (o1.x * o1.x + o1.y * o1.y) + (o1.z * o1.z + o1.w * o1.w);
                    u32x4 w; w.x = cvt_pk_bf16(o0.x, o0.y); w.y = cvt_pk_bf16(o0.z, o0.w); w.z = cvt_pk_bf16(o1.x, o1.y); w.w = cvt_pk_bf16(o1.z, o1.w);
                    *(u32x4*)(x2b + off + bj * HALF) = w; }
                ss += __shfl_xor(ss, 16); ss += __shfl_xor(ss, 32);
                SSX[(size_t)row * 32 + u.pn * 4 + wc] = ss; }
        }
    }
};
struct EpiSwiglu {
    static constexpr bool MIDK = false, BIASL = true;
    static constexpr bool PERM = true;
    unsigned char* act; const float* bgu; const LAS float* biasL; unsigned biasA;
    __device__ __forceinline__ void prefetch(const Unit& u, int wid, int lane) const {
        if (wid == 0) glds16(bgu + (size_t)u.e * 4096 + u.pn * 128 + (lane & 31) * 4 + (lane >> 5) * 2048, biasA + (unsigned)(u.ui & 1) * 1024u); }
    __device__ __forceinline__ void operator()(const f32x4 (&acc)[2][2][4][2], const Unit& u, int wr, int wc, int fr, int fq) const {
        const int jl = wc * 32 + 8 * (2 * (fq & 1) + (fq >> 1));
        const LAS float* bp = biasL + (u.ui & 1) * 256 + jl;
        const f32x4 bg0 = *(const LAS f32x4*)(bp), bg1 = *(const LAS f32x4*)(bp + 4), bl0 = *(const LAS f32x4*)(bp + 128) + 1.0f, bl1 = *(const LAS f32x4*)(bp + 132) + 1.0f;
        const float rs = 1.0f / 64.0f;
        const int hi32 = fq >> 1;
        unsigned char* obase = act + (size_t)(u.pm * BM + wr * 64 + fr) * 2048 + u.pn * 128 + wc * 32 + 16 * (fq & 1);
#pragma unroll
        for (int ai = 0; ai < 2; ++ai)
#pragma unroll
            for (int mp = 0; mp < 2; ++mp) {
                unsigned wv[2][2];
#pragma unroll
                for (int r2 = 0; r2 < 2; ++r2) { const int m = 2 * mp + r2;
#pragma unroll
                    for (int n = 0; n < 2; ++n) { const f32x4 ag = acc[ai][0][m][n], al = acc[ai][1][m][n], bg = n ? bg1 : bg0, bl = n ? bl1 : bl0; f32x2 o2[2];
#pragma unroll
                        for (int hq = 0; hq < 2; ++hq) {
                            f32x2 g = (f32x2){ag[2 * hq], ag[2 * hq + 1]} * rs + (f32x2){bg[2 * hq], bg[2 * hq + 1]};
                            f32x2 l = (f32x2){al[2 * hq], al[2 * hq + 1]} * rs + (f32x2){bl[2 * hq], bl[2 * hq + 1]};
                            g.x = fminf(g.x, 7.0f); g.y = fminf(g.y, 7.0f);
                            l.x = __builtin_amdgcn_fmed3f(l.x, -6.0f, 8.0f); l.y = __builtin_amdgcn_fmed3f(l.y, -6.0f, 8.0f);
                            const f32x2 z = g * (-1.702f * 1.4426950408889634f);
                            f32x2 e; e.x = __builtin_amdgcn_exp2f(z.x); e.y = __builtin_amdgcn_exp2f(z.y);
                            const f32x2 d = e + 1.0f; f32x2 r; r.x = __builtin_amdgcn_rcpf(d.x); r.y = __builtin_amdgcn_rcpf(d.y);
                            o2[hq] = (g * r) * l; }
                        wv[r2][n] = pk4_fp8(o2[0].x, o2[0].y, o2[1].x, o2[1].y); } }
                const auto s0 = __builtin_amdgcn_permlane32_swap(wv[0][0], wv[1][0], false, false), s1 = __builtin_amdgcn_permlane32_swap(wv[0][1], wv[1][1], false, false);
                u32x4 w; w.x = s0[0]; w.y = s1[0]; w.z = s0[1]; w.w = s1[1];
                *(u32x4*)(obase + (size_t)(ai * HALF + (2 * mp + hi32) * 16) * 2048) = w; }
    }
};
struct EpiDown {
    static constexpr bool MIDK = false, BIASL = true;
    static constexpr bool PERM = true;
    unsigned char* Y; const float* bdn; const LAS unsigned* dstL; const LAS float* biasL; unsigned biasA;
    __device__ __forceinline__ void prefetch(const Unit& u, int wid, int lane) const {
        if (wid == 0) glds16(bdn + (size_t)u.e * 2048 + u.pn * 256 + lane * 4, biasA + (unsigned)(u.ui & 1) * 1024u); }
    __device__ __forceinline__ void operator()(const f32x4 (&acc)[2][2][4][2], const Unit& u, int wr, int wc, int fr, int fq) const {
        const int col0 = u.pn * BM + wc * 64 + 16 * fq;
        const LAS float* bp = biasL + (u.ui & 1) * 256 + wc * 64 + 16 * fq;
        f32x4 bv[2][2];
#pragma unroll
        for (int bj = 0; bj < 2; ++bj)
#pragma unroll
            for (int n = 0; n < 2; ++n) bv[bj][n] = *(const LAS f32x4*)(bp + 8 * bj + 4 * n);
#pragma unroll
        for (int ai = 0; ai < 2; ++ai)
#pragma unroll
            for (int m = 0; m < 4; ++m) { const unsigned dst = dstL[u.ui * 256 + ai * HALF + wr * 64 + m * 16 + fr];
                const f32x4 v00 = acc[ai][0][m][0] * (1.0f / 64.0f) + bv[0][0], v01 = acc[ai][0][m][1] * (1.0f / 64.0f) + bv[0][1], v10 = acc[ai][1][m][0] * (1.0f / 64.0f) + bv[1][0], v11 = acc[ai][1][m][1] * (1.0f / 64.0f) + bv[1][1];
                u32x4 w; w.x = pk4_fp8(v00[0], v00[1], v00[2], v00[3]); w.y = pk4_fp8(v01[0], v01[1], v01[2], v01[3]); w.z = pk4_fp8(v10[0], v10[1], v10[2], v10[3]); w.w = pk4_fp8(v11[0], v11[1], v11[2], v11[3]);
                *(u32x4*)(Y + (size_t)dst * 2048 + col0) = w; }
    }
};

template <class Epi, bool GATHER, bool ALIGN_EPI, bool FP8>
__device__ __forceinline__ void gemm_phase(LAS unsigned char* lds, const char* Abase, const char* Bbase, size_t estrideB, int KB, const TileOrder& S, const Epi& E, const LAS unsigned short* tokL) {
    const int tid = threadIdx.x, wid = __builtin_amdgcn_readfirstlane(tid >> 6), lane = tid & 63, wr = wid >> 2, wc = wid & 3, fr = lane & 15, fq = lane >> 4;
    const int nt = KB / 128;
    int Rr[2], Cc[2]; unsigned voffB[2], vA[2][2];
#pragma unroll
    for (int i = 0; i < 2; ++i) { int R, C; stage_rc(tid * 16 + i * 8192, R, C); const int Rb = Epi::PERM ? ((R & ~31) + perm32(R & 31)) : R;
        Rr[i] = R; Cc[i] = C; voffB[i] = (unsigned)(Rb * KB + C * 2); }
    const size_t kstep = (size_t)128;
    const size_t hstep = (size_t)HALF * KB;
    const size_t tstep = 2 * hstep;
    const unsigned ldsw = (unsigned)wid * 1024u;
    const int aoff = lds_byte(wr * 64 + fr, fq * 8), boff = lds_byte(wc * 32 + fr, fq * 8);
#define PG8_SA(b, h) (((b) * 2 + (h)) * HTB)
#define PG8_SB(b, h) ((4 + (b) * 2 + (h)) * HTB)
#define PG8_STAGE(bufoff, gbase, voff) do { _Pragma("unroll") for (int _i = 0; _i < 2; ++_i) \
        __builtin_amdgcn_global_load_lds((const GAS unsigned*)((const char*)(gbase) + (voff)[_i]), (LAS unsigned*)(lds + (bufoff) + ldsw + _i * 8192), 16, 0, 0); } while (0)
#define PG8_LDA(dst, b, h) do { _Pragma("unroll") for (int m = 0; m < 4; ++m) dst[m] = __builtin_shufflevector(*(const LAS v4i*)(lds + PG8_SA(b, h) + aoff + m * 2048), *(const LAS v4i*)(lds + PG8_SA(b, h) + aoff + m * 2048 + 1024), 0, 1, 2, 3, 4, 5, 6, 7); } while (0)
#define PG8_LDB(dst, b, h) do { _Pragma("unroll") for (int n = 0; n < 2; ++n) dst[n] = __builtin_shufflevector(*(const LAS v4i*)(lds + PG8_SB(b, h) + boff + n * 2048), *(const LAS v4i*)(lds + PG8_SB(b, h) + boff + n * 2048 + 1024), 0, 1, 2, 3, 4, 5, 6, 7); } while (0)
#define PG8_MMA(ai, bj, At, Bt) do { __builtin_amdgcn_s_setprio(1); _Pragma("unroll") for (int m = 0; m < 4; ++m) _Pragma("unroll") for (int n = 0; n < 2; ++n) { \
        if constexpr (FP8) acc[ai][bj][m][n] = __builtin_amdgcn_mfma_scale_f32_16x16x128_f8f6f4(Bt[n], At[m], acc[ai][bj][m][n], 0, 0, 0, 0, 0, 0)    ; \
        else { acc[ai][bj][m][n] = __builtin_amdgcn_mfma_f32_16x16x32_bf16(lo8(Bt[n]), lo8(At[m]), acc[ai][bj][m][n], 0, 0, 0); acc[ai][bj][m][n] = __builtin_amdgcn_mfma_f32_16x16x32_bf16(hi8(Bt[n]), hi8(At[m]), acc[ai][bj][m][n], 0, 0, 0); } } __builtin_amdgcn_s_setprio(0); } while (0)
#define PG8_WAIT_V(n) asm volatile("s_waitcnt vmcnt(" #n ")" ::: "memory")
#define PG8_WAIT_L(n) asm volatile("s_waitcnt lgkmcnt(" #n ")" ::: "memory")
#define PG8_BAR __builtin_amdgcn_s_barrier()
#define PG8_SCHED __builtin_amdgcn_sched_barrier(0)
#define PG8_SETVA(u) do { _Pragma("unroll") for (int _h = 0; _h < 2; ++_h) _Pragma("unroll") for (int _i = 0; _i < 2; ++_i) { \
        const int _row = GATHER ? (int)tokL[(u).ui * 256 + _h * HALF + Rr[_i]] : (_h * HALF + Rr[_i]); vA[_h][_i] = (unsigned)(_row * KB + Cc[_i] * 2); asm volatile("" : "+v"(vA[_h][_i])); } } while (0)
    Unit cur, nxt; int ui = 0;
    if (!S.next(0, cur)) return;
    f32x4 acc[2][2][4][2];
#pragma unroll
    for (int a = 0; a < 2; ++a)
#pragma unroll
        for (int b = 0; b < 2; ++b)
#pragma unroll
            for (int m = 0; m < 4; ++m)
#pragma unroll
                for (int n = 0; n < 2; ++n) acc[a][b][m][n] = (f32x4){0.f, 0.f, 0.f, 0.f};
    v8i At[4], B0[2], B1[2];
    const char* cA = GATHER ? Abase : Abase + (size_t)cur.pm * tstep;
    const char* cB = Bbase + (size_t)cur.e * estrideB + (size_t)cur.pn * tstep;
    PG8_SETVA(cur);
    if constexpr (Epi::BIASL) E.prefetch(cur, wid, lane);
    PG8_STAGE(PG8_SB(0, 0), cB, voffB); PG8_STAGE(PG8_SB(0, 1), cB + hstep, voffB); PG8_STAGE(PG8_SA(0, 0), cA, vA[0]); PG8_STAGE(PG8_SA(0, 1), cA, vA[1]);
    if (wr == 1) PG8_BAR;
    PG8_WAIT_V(2); PG8_BAR;
    PG8_STAGE(PG8_SB(1, 0), cB + kstep, voffB); PG8_STAGE(PG8_SA(1, 0), cA + kstep, vA[0]); PG8_STAGE(PG8_SB(1, 1), cB + hstep + kstep, voffB);
    PG8_WAIT_V(6); PG8_BAR;
    for (;;) {
        const bool has_next = S.next(ui + 1, nxt);
        const char* nA = has_next ? (GATHER ? Abase : Abase + (size_t)nxt.pm * tstep) : cA;
        const char* nB = has_next ? Bbase + (size_t)nxt.e * estrideB + (size_t)nxt.pn * tstep : cB;
        for (int t = 0; t < nt; t += 2) {
            if constexpr (Epi::MIDK) { if (t == nt / 2) E.mid(acc, cur, wr, fr); }
            const bool last = (t == nt - 2);
            const char* a1 = cA + (size_t)(t + 1) * kstep;
            const char* a2 = last ? nA : cA + (size_t)(t + 2) * kstep; const char* b2 = last ? nB : cB + (size_t)(t + 2) * kstep;
            const char* a3 = a2 + kstep; const char* b3 = b2 + kstep;
            PG8_LDB(B0, 0, 0); PG8_LDB(B1, 0, 1); PG8_SCHED; PG8_LDA(At, 0, 0); PG8_STAGE(PG8_SA(1, 1), a1, vA[1]);
            if (last && has_next) PG8_SETVA(nxt);
            PG8_WAIT_V(8); PG8_WAIT_L(0); PG8_BAR; PG8_MMA(0, 0, At, B0); PG8_MMA(0, 1, At, B1); PG8_BAR; PG8_SCHED;
            PG8_LDA(At, 0, 1); PG8_STAGE(PG8_SB(0, 0), b2, voffB); PG8_STAGE(PG8_SB(0, 1), b2 + hstep, voffB); PG8_STAGE(PG8_SA(0, 0), a2, vA[0]);
            PG8_WAIT_V(8); PG8_WAIT_L(0); PG8_BAR; PG8_MMA(1, 0, At, B0); PG8_MMA(1, 1, At, B1); PG8_BAR; PG8_SCHED;
            PG8_LDB(B0, 1, 0); PG8_LDB(B1, 1, 1); PG8_SCHED; PG8_LDA(At, 1, 0); PG8_STAGE(PG8_SA(0, 1), a2, vA[1]);
            PG8_WAIT_V(8); PG8_WAIT_L(0); PG8_BAR; PG8_MMA(0, 0, At, B0); PG8_MMA(0, 1, At, B1); PG8_BAR; PG8_SCHED;
            PG8_LDA(At, 1, 1); PG8_STAGE(PG8_SB(1, 0), b3, voffB); PG8_STAGE(PG8_SB(1, 1), b3 + hstep, voffB); PG8_STAGE(PG8_SA(1, 0), a3, vA[0]);
            PG8_WAIT_V(8); PG8_WAIT_L(0); PG8_BAR; PG8_MMA(1, 0, At, B0); PG8_MMA(1, 1, At, B1); PG8_BAR; PG8_SCHED;
        }
        if constexpr (ALIGN_EPI) { if (wr == 0) PG8_BAR; }
        E(acc, cur, wr, wc, fr, fq);
        if (!has_next) break;
#pragma unroll
        for (int a = 0; a < 2; ++a)
#pragma unroll
            for (int b = 0; b < 2; ++b)
#pragma unroll
                for (int m = 0; m < 4; ++m)
#pragma unroll
                    for (int n = 0; n < 2; ++n) acc[a][b][m][n] = (f32x4){0.f, 0.f, 0.f, 0.f};
        cur = nxt; cA = nA; cB = nB; ++ui;
        if constexpr (Epi::BIASL) E.prefetch(cur, wid, lane);
        if constexpr (ALIGN_EPI) { if (wr == 1) PG8_BAR; }
    }
    PG8_WAIT_V(0);
    if constexpr (!ALIGN_EPI) { if (wr == 0) PG8_BAR; }
    PG8_BAR;
#undef PG8_SA
#undef PG8_SB
#undef PG8_STAGE
#undef PG8_LDA
#undef PG8_LDB
#undef PG8_MMA
#undef PG8_WAIT_V
#undef PG8_WAIT_L
#undef PG8_BAR
#undef PG8_SCHED
#undef PG8_SETVA
}

struct Frame {
    LAS unsigned char* lds;
    volatile LAS unsigned* MISC;
    gu32* ctl;
    int tid, lane, wave, vcu, G;
    const float *x, *g1, *w_in, *gq, *gk, *rpb, *gsg, *w_sp, *b_sp, *ga, *gs, *w_out, *g2, *w_r, *b_r, *w_gu, *b_gu, *w_dn, *b_dn;
    float* out;
    bf16 *WIN, *WOUT, *WSP, *WRH, *WRL, *H, *PROJ, *MIX, *X2B; unsigned char *WGU, *WDN, *ACT, *H8, *Y;
    float *RSTD2, *GATE, *SSQA, *SSG, *RA, *RB, *SSX, *RMS1, *IG1; unsigned* SLOT; int* LIST;
};

__device__ __forceinline__ void p0_transpose_item(const float* W, int N, int K, bf16* WT, int k0, int n0, int out_row0, int hi_off, const float* kgain, LAS float* scr, int lane) {
    const int l16 = lane & 15, lq = lane >> 4;
#pragma unroll 4
    for (int i = 0; i < 16; ++i) { const int kk = 4 * i + lq; f32x4 v = *(const f32x4*)(W + (size_t)(k0 + kk) * N + n0 + 4 * l16); if (kgain) v = v * kgain[k0 + kk];
        LAS float* d = scr + kk * 65 + 4 * l16; d[0] = v.x; d[1] = v.y; d[2] = v.z; d[3] = v.w; }
    LDS_WAIT(); asm volatile("" ::: "memory");
    const int c = lane >> 3, nn = lane & 7;
#pragma unroll
    for (int j = 0; j < 8; ++j) { const int n = nn + 8 * j; const LAS float* s = scr + (8 * c) * 65 + n;
        u32x4 o; o.x = cvt_pk_bf16(s[0], s[65]); o.y = cvt_pk_bf16(s[2 * 65], s[3 * 65]); o.z = cvt_pk_bf16(s[4 * 65], s[5 * 65]); o.w = cvt_pk_bf16(s[6 * 65], s[7 * 65]);
        *(u32x4*)(WT + (size_t)(out_row0 + n + (n >= 32 ? hi_off : 0)) * K + k0 + 8 * c) = o; }
    LDS_WAIT(); asm volatile("" ::: "memory");
}
__device__ __forceinline__ void p0_transpose_item_fp8(const float* W, int N, int K, unsigned char* WT, int k0, int n0, int out_row0, LAS float* scr, int lane) {
    const int l8 = lane & 7, lr = lane >> 3;
#pragma unroll 4
    for (int i = 0; i < 16; ++i) { const int kk = 8 * i + lr; const f32x4 v = *(const f32x4*)(W + (size_t)(k0 + kk) * N + n0 + 4 * l8);
        LAS float* d = scr + kk * 33 + 4 * l8; d[0] = v.x; d[1] = v.y; d[2] = v.z; d[3] = v.w; }
    LDS_WAIT(); asm volatile("" ::: "memory");
    const int n = lane & 31, kh = lane >> 5; const LAS float* s = scr + (64 * kh) * 33 + n;
#pragma unroll
    for (int c4 = 0; c4 < 4; ++c4) { u32x4 o;
        o.x = pk4_fp8(s[(16 * c4 + 0) * 33] * 64.f, s[(16 * c4 + 1) * 33] * 64.f, s[(16 * c4 + 2) * 33] * 64.f, s[(16 * c4 + 3) * 33] * 64.f);
        o.y = pk4_fp8(s[(16 * c4 + 4) * 33] * 64.f, s[(16 * c4 + 5) * 33] * 64.f, s[(16 * c4 + 6) * 33] * 64.f, s[(16 * c4 + 7) * 33] * 64.f);
        o.z = pk4_fp8(s[(16 * c4 + 8) * 33] * 64.f, s[(16 * c4 + 9) * 33] * 64.f, s[(16 * c4 + 10) * 33] * 64.f, s[(16 * c4 + 11) * 33] * 64.f);
        o.w = pk4_fp8(s[(16 * c4 + 12) * 33] * 64.f, s[(16 * c4 + 13) * 33] * 64.f, s[(16 * c4 + 14) * 33] * 64.f, s[(16 * c4 + 15) * 33] * 64.f);
        *(u32x4*)(WT + (size_t)(out_row0 + n) * K + k0 + 64 * kh + 16 * c4) = o; }
    LDS_WAIT(); asm volatile("" ::: "memory");
}
__device__ __forceinline__ void moe_convert(Frame& F, int j0, int j1) {
    LAS float* img = (LAS float*)F.lds;
    constexpr int T_GU = 16 * 16, T_DN = 16 * 8, NT = NE * (T_GU + T_DN);
    const int w = F.wave, lane = F.lane;
    f32x4 v[16];
#define P0_DECODE(t, W_, N_, WT_, k0_, n0_, isgu_) do { int r_ = (t); if (r_ < NE * T_GU) { const int e_ = r_ / T_GU, q_ = r_ % T_GU; W_ = F.w_gu + (size_t)e_ * DM * 4096; N_ = 4096; WT_ = F.WGU + (size_t)e_ * 4096 * DM; k0_ = 128 * (q_ / 16); n0_ = 256 * (q_ % 16); isgu_ = 1; } \
        else { r_ -= NE * T_GU; const int e_ = r_ / T_DN, q_ = r_ % T_DN; W_ = F.w_dn + (size_t)e_ * DM * DM; N_ = DM; WT_ = F.WDN + (size_t)e_ * DM * DM; k0_ = 128 * (q_ / 8); n0_ = 256 * (q_ % 8); isgu_ = 0; } } while (0)
#define P0_LOAD(W_, N_, k0_, n0_) do { _Pragma("unroll") for (int i = 0; i < 16; ++i) v[i] = __builtin_nontemporal_load((const f32x4*)(W_ + (size_t)(k0_ + 16 * w + i) * N_ + n0_ + 4 * lane)); } while (0)
    int j = j0, t = F.vcu + j0 * F.G;
    const float* W = nullptr; unsigned char* WT = nullptr; int N = 0, k0 = 0, n0 = 0, isgu = 0;
    if (j < j1 && t < NT) { P0_DECODE(t, W, N, WT, k0, n0, isgu); P0_LOAD(W, N, k0, n0); }
    while (j < j1 && t < NT) {
#pragma unroll
        for (int i = 0; i < 16; ++i) *(LAS f32x4*)(img + (16 * w + i) * 260 + 4 * lane) = v[i];
        __syncthreads();
        const int tn = t + F.G; const float* Wn = nullptr; unsigned char* WTn = nullptr; int Nn = 0, k0n = 0, n0n = 0, isgun = 0;
        if (j + 1 < j1 && tn < NT) { P0_DECODE(tn, Wn, Nn, WTn, k0n, n0n, isgun); P0_LOAD(Wn, Nn, k0n, n0n); }
        { const int n = 32 * w + (lane & 31), kh = lane >> 5; const LAS float* sp = img + (64 * kh) * 260 + n;
          const int nn = n0 + n; const int ll = nn & 255;
          const int jl = nn & 127, g8 = (jl >> 3) & 3;
          const int orow = isgu ? (((nn & 2047) >> 7) * 256 + (nn >> 11) * 128 + (jl & ~31) + 8 * (2 * (g8 & 1) + (g8 >> 1)) + (jl & 7)) : ((nn & ~255) + 128 * ((ll >> 3) & 1) + 32 * (ll >> 6) + 8 * ((ll >> 4) & 3) + (ll & 7));
          unsigned char* dst = WT + (size_t)orow * DM + k0 + 64 * kh;
#pragma unroll
          for (int c4 = 0; c4 < 4; ++c4) { u32x4 o;
              o.x = pk4_fp8(sp[(16 * c4 + 0) * 260] * 64.f, sp[(16 * c4 + 1) * 260] * 64.f, sp[(16 * c4 + 2) * 260] * 64.f, sp[(16 * c4 + 3) * 260] * 64.f);
              o.y = pk4_fp8(sp[(16 * c4 + 4) * 260] * 64.f, sp[(16 * c4 + 5) * 260] * 64.f, sp[(16 * c4 + 6) * 260] * 64.f, sp[(16 * c4 + 7) * 260] * 64.f);
              o.z = pk4_fp8(sp[(16 * c4 + 8) * 260] * 64.f, sp[(16 * c4 + 9) * 260] * 64.f, sp[(16 * c4 + 10) * 260] * 64.f, sp[(16 * c4 + 11) * 260] * 64.f);
              o.w = pk4_fp8(sp[(16 * c4 + 12) * 260] * 64.f, sp[(16 * c4 + 13) * 260] * 64.f, sp[(16 * c4 + 14) * 260] * 64.f, sp[(16 * c4 + 15) * 260] * 64.f);
              __builtin_nontemporal_store(o, (u32x4*)(dst + 16 * c4)); } }
        __syncthreads();
        ++j; t = tn; W = Wn; WT = WTn; N = Nn; k0 = k0n; n0 = n0n; isgu = isgun;
    }
#undef P0_DECODE
#undef P0_LOAD
}
__device__ __forceinline__ void p0_prologue(Frame& F) {
    LAS float* scr = (LAS float*)(F.lds + F.wave * 16896);
    const int gw = F.vcu * NWAVES + F.wave, NGW = F.G * NWAVES, lane = F.lane;
    constexpr int I_IN = 32 * 80, I_OUT = 32 * 32;
    constexpr int NITEMS = I_IN + I_OUT;
    for (int it = gw; it < NITEMS; it += NGW) {
        int r = it;
        if (r < I_IN) { const int kb = r / 80, nb = r % 80; p0_transpose_item(F.w_in, NPROJ, DM, F.WIN, 64 * kb, 64 * nb, (nb >> 2) * 256 + (nb & 3) * 32, 96, nullptr, scr, lane); continue; } r -= I_IN;
        { const int kb = r / 32, nb = r % 32; p0_transpose_item(F.w_out, DM, DM, F.WOUT, 64 * kb, 64 * nb, 64 * nb, 0, kb < 16 ? F.ga : F.gs - 1024, scr, lane); }
    }
    {
        f32x4 g1v[8];
#pragma unroll
        for (int j = 0; j < 4; ++j) { g1v[2 * j] = *(const f32x4*)(F.g1 + 8 * lane + 512 * j); g1v[2 * j + 1] = *(const f32x4*)(F.g1 + 8 * lane + 512 * j + 4); }
        for (int m = gw; m < NTOK; m += 2 * NGW) {
            const int m2 = m + NGW; const bool has2 = m2 < NTOK;
            const float* xr = F.x + (size_t)m * DM + 8 * lane; const float* xr2 = F.x + (size_t)(has2 ? m2 : m) * DM + 8 * lane;
            f32x4 v[8], u[8]; float s = 0.f, s2 = 0.f;
#pragma unroll
            for (int j = 0; j < 4; ++j) { v[2 * j] = __builtin_nontemporal_load((const f32x4*)(xr + 512 * j)); v[2 * j + 1] = __builtin_nontemporal_load((const f32x4*)(xr + 512 * j + 4)); u[2 * j] = __builtin_nontemporal_load((const f32x4*)(xr2 + 512 * j)); u[2 * j + 1] = __builtin_nontemporal_load((const f32x4*)(xr2 + 512 * j + 4)); }
#pragma unroll
            for (int j = 0; j < 8; ++j) { s += (v[j].x * v[j].x + v[j].y * v[j].y) + (v[j].z * v[j].z + v[j].w * v[j].w); s2 += (u[j].x * u[j].x + u[j].y * u[j].y) + (u[j].z * u[j].z + u[j].w * u[j].w); }
            const float rm = sqrtf(wave_sum(s) * (1.0f / DM) + EPS), rm2 = sqrtf(wave_sum(s2) * (1.0f / DM) + EPS); const float rs = 1.0f / rm, rs2 = 1.0f / rm2;
            if (lane == 0) { F.RMS1[m] = rm; if (has2) F.RMS1[m2] = rm2; }
#pragma unroll
            for (int j = 0; j < 4; ++j) { const f32x4 a = v[2 * j] * rs * g1v[2 * j], b = v[2 * j + 1] * rs * g1v[2 * j + 1]; u32x4 o; o.x = cvt_pk_bf16(a.x, a.y); o.y = cvt_pk_bf16(a.z, a.w); o.z = cvt_pk_bf16(b.x, b.y); o.w = cvt_pk_bf16(b.z, b.w);
                *(u32x4*)(F.H + (size_t)m * DM + 8 * lane + 512 * j) = o; }
            if (has2) {
#pragma unroll
                for (int j = 0; j < 4; ++j) { const f32x4 a = u[2 * j] * rs2 * g1v[2 * j], b = u[2 * j + 1] * rs2 * g1v[2 * j + 1]; u32x4 o; o.x = cvt_pk_bf16(a.x, a.y); o.y = cvt_pk_bf16(a.z, a.w); o.z = cvt_pk_bf16(b.x, b.y); o.w = cvt_pk_bf16(b.z, b.w);
                    *(u32x4*)(F.H + (size_t)m2 * DM + 8 * lane + 512 * j) = o; } }
        }
    }
    const int gt = F.vcu * 512 + F.tid, NGT = F.G * 512;
    for (int i = gt; i < DM; i += NGT) F.IG1[i] = 1.0f / F.g1[i];
    for (int i = gt; i < 16 * 128 * 128; i += NGT) { const float v = F.w_sp[i]; F.WSP[i] = (bf16)(cvt_pk_bf16(v, 0.f) & 0xffffu); }
    for (int i = gt; i < NE * DM; i += NGT) { const int e = i / DM, d = i % DM; const float v = F.w_r[(size_t)d * NE + e]; const unsigned hi = cvt_pk_bf16(v, 0.f) & 0xffffu; const float lo = v - __uint_as_float(hi << 16);
        F.WRH[i] = (bf16)hi; F.WRL[i] = (bf16)(cvt_pk_bf16(lo, 0.f) & 0xffffu); }
}

typedef short v4i16_t __attribute__((ext_vector_type(4)));
__device__ __forceinline__ s16x4 tr_read(const LAS unsigned char* p) { return __builtin_bit_cast(s16x4, __builtin_amdgcn_ds_read_tr16_b64_v4i16((LAS v4i16_t*)p)); }
__device__ __forceinline__ void attn_unit(Frame& F, int b, int h, int band) {
    constexpr int SLOT = 16384;
    LAS unsigned char* ring = F.lds;
    LAS float* rpbL = (LAS float*)(F.lds + AT_RPB);
    LAS unsigned* mrg = (LAS unsigned*)(F.lds + AT_MRG);
    const int tid = F.tid, lane = F.lane, w = F.wave, fr = lane & 15, quad = lane >> 4;
    const int cg = w & 3, hf8 = w >> 2;
    const int c0 = 16 * cg, w0 = (cg == 0) ? 0 : (cg == 1) ? 8 : (cg == 2) ? 24 : 32;
    const int qc = c0 + fr; const int cs = min(max(qc - 8, 0), 48);
    const int R0 = band * 16;
    __syncthreads();
    for (int i = tid; i < 480; i += 512) { const int ro = i >> 5, co = i & 31; rpbL[i] = co < 31 ? F.rpb[h * 465 + ro * 31 + co] * 1.4426950408889634f : -INFINITY; }
    int cooff[2][4];
#pragma unroll
    for (int hf = 0; hf < 2; ++hf)
#pragma unroll
        for (int i = 0; i < 4; ++i) { const int kc = w0 + 16 * hf + 4 * quad + i; const bool valid = (kc >= cs) && (kc < cs + 16); cooff[hf][i] = 4 * (valid ? kc - qc + 15 : 31); }
    const char* projb = (const char*)F.PROJ + (size_t)b * SEQ * NPROJ * 2; const unsigned ringb = (unsigned)(size_t)ring;
    const unsigned lane_src = (unsigned)((8 * w + (lane >> 3)) * NPROJ + 1024 + h * 64) * 2u + (unsigned)(((lane & 7) ^ (lane >> 3)) * 16);
#define ROW_DMA(rowabs) do { const char* src_ = projb + (size_t)(rowabs) * 64 * NPROJ * 2 + lane_src; const unsigned sb_ = ringb + (unsigned)(((rowabs) % 9) * SLOT + w * 1024); \
        glds16(src_, sb_); glds16(src_ + 2048, sb_ + 8192u); } while (0)
    const int rs0 = min(max(R0 - 4, 0), 120);
    for (int j = 0; j < 8; ++j) ROW_DMA(rs0 + j);
    int loaded_hi = rs0 + 7;
    const bf16* qbase = F.PROJ + ((size_t)b * SEQ + qc) * NPROJ + h * 64 + 8 * quad;
    bf16x8 qa = *(const bf16x8*)(qbase + (size_t)R0 * 64 * NPROJ), qb = *(const bf16x8*)(qbase + (size_t)R0 * 64 * NPROJ + 32);
    VM_WAIT(); __syncthreads();
    for (int step = 0; step < 16; ++step) {
        const int r = R0 + step, rs = min(max(r - 4, 0), 120);
        bf16x8 qf0 = qa, qf1 = qb;
        if (step < 15) { const int nh = min(max(r - 3, 0), 120) + 7; if (nh > loaded_hi) { ROW_DMA(nh); loaded_hi = nh; }
            qa = *(const bf16x8*)(qbase + (size_t)(r + 1) * 64 * NPROJ); qb = *(const bf16x8*)(qbase + (size_t)(r + 1) * 64 * NPROJ + 32); }
        f32x4 s[4][2];
#pragma unroll
        for (int kr = 0; kr < 4; ++kr) { const int sb = ((rs + 4 * hf8 + kr) % 9) * SLOT;
#pragma unroll
            for (int hf = 0; hf < 2; ++hf) { const int key = w0 + 16 * hf + fr;
                const bf16x8 a0 = *(const LAS bf16x8*)(ring + sb + key * 128 + ((quad ^ (key & 7)) << 4));
                const bf16x8 a1 = *(const LAS bf16x8*)(ring + sb + key * 128 + (((quad + 4) ^ (key & 7)) << 4));
                f32x4 z = {0.f, 0.f, 0.f, 0.f};
                z = __builtin_amdgcn_mfma_f32_16x16x32_bf16(a0, qf0, z, 0, 0, 0);
                z = __builtin_amdgcn_mfma_f32_16x16x32_bf16(a1, qf1, z, 0, 0, 0);
                s[kr][hf] = z; } }
        float mx = -INFINITY;
        { const LAS unsigned char* bb = (const LAS unsigned char*)rpbL + (rs + 4 * hf8 - r + 7) * 128;
#pragma unroll
            for (int kr = 0; kr < 4; ++kr)
#pragma unroll
                for (int hf = 0; hf < 2; ++hf)
#pragma unroll
                    for (int i = 0; i < 4; ++i) { const float v = s[kr][hf][i] + *(const LAS float*)(bb + kr * 128 + cooff[hf][i]); s[kr][hf][i] = v; mx = fmaxf(mx, v); } }
        mx = fmaxf(mx, __shfl_xor(mx, 16)); mx = fmaxf(mx, __shfl_xor(mx, 32));
        float lsum = 0.f; bf16x8 pf[4];
#pragma unroll
        for (int kr = 0; kr < 4; ++kr) { float p[8];
#pragma unroll
            for (int i = 0; i < 8; ++i) { p[i] = __builtin_amdgcn_exp2f(s[kr][i >> 2][i & 3] - mx); lsum += p[i]; }
            u32x4 pk; pk.x = cvt_pk_bf16(p[0], p[1]); pk.y = cvt_pk_bf16(p[2], p[3]); pk.z = cvt_pk_bf16(p[4], p[5]); pk.w = cvt_pk_bf16(p[6], p[7]); pf[kr] = __builtin_bit_cast(bf16x8, pk); }
        lsum += __shfl_xor(lsum, 16); lsum += __shfl_xor(lsum, 32);
        f32x4 o[4];
#pragma unroll
        for (int dt = 0; dt < 4; ++dt) o[dt] = (f32x4){0.f, 0.f, 0.f, 0.f};
#pragma unroll
        for (int kr = 0; kr < 4; ++kr) { const int sb = ((rs + 4 * hf8 + kr) % 9) * SLOT + 8192; const int key = w0 + 4 * quad + (fr >> 2), pp = fr & 3;
#pragma unroll
            for (int dt = 0; dt < 4; ++dt) { const int c = 2 * dt + (pp >> 1); const int ad = sb + key * 128 + ((c ^ (key & 7)) << 4) + 8 * (pp & 1);
                const s16x4 lo = tr_read(ring + ad), hi = tr_read(ring + ad + 16 * 128);
                const bf16x8 vf = __builtin_shufflevector(lo, hi, 0, 1, 2, 3, 4, 5, 6, 7);
                o[dt] = __builtin_amdgcn_mfma_f32_16x16x32_bf16(vf, pf[kr], o[dt], 0, 0, 0); } }
        if (w >= 4) { LAS unsigned* m = mrg + (w - 4) * 640 + lane; m[0] = __float_as_uint(mx); m[64] = __float_as_uint(lsum);
#pragma unroll
            for (int dt = 0; dt < 4; ++dt) { m[(2 + 2 * dt) * 64] = cvt_pk_bf16(o[dt][0], o[dt][1]); m[(3 + 2 * dt) * 64] = cvt_pk_bf16(o[dt][2], o[dt][3]); } }
        __syncthreads();
        if (w < 4) { const LAS unsigned* m = mrg + w * 640 + lane; const float mx2 = __uint_as_float(m[0]), l2 = __uint_as_float(m[64]);
            const float mm = fmaxf(mx, mx2), a1 = __builtin_amdgcn_exp2f(mx - mm), a2 = __builtin_amdgcn_exp2f(mx2 - mm); const float inv = 1.0f / (lsum * a1 + l2 * a2);
            const float f1 = a1 * inv, f2 = a2 * inv; float ssq = 0.f;
            bf16* op = F.MIX + ((size_t)b * SEQ + (size_t)r * 64 + qc) * DM + h * 64 + 4 * quad;
            u32x2 pk[4];
#pragma unroll
            for (int dt = 0; dt < 4; ++dt) { const unsigned u0 = m[(2 + 2 * dt) * 64], u1 = m[(3 + 2 * dt) * 64];
                const float v0 = o[dt][0] * f1 + bflo(u0) * f2, v1 = o[dt][1] * f1 + bfhi(u0) * f2, v2 = o[dt][2] * f1 + bflo(u1) * f2, v3 = o[dt][3] * f1 + bfhi(u1) * f2;
                ssq += (v0 * v0 + v1 * v1) + (v2 * v2 + v3 * v3);
                pk[dt].x = cvt_pk_bf16(v0, v1); pk[dt].y = cvt_pk_bf16(v2, v3); }
            ssq += __shfl_xor(ssq, 16); ssq += __shfl_xor(ssq, 32);
            VM_WAIT();
#pragma unroll
            for (int dp = 0; dp < 2; ++dp) *(u32x4*)(op + 32 * dp + ((quad & 1) ? 12 : 0)) = pair16(pk[2 * dp], pk[2 * dp + 1]);
            if (quad == 0) F.SSQA[((size_t)b * SEQ + (size_t)r * 64 + qc) * 16 + h] = ssq; }
        else VM_WAIT();
        __syncthreads();
    }
#undef ROW_DMA
}

__device__ __forceinline__ void sgu_unit(Frame& F, int unit) {
    LAS unsigned char* Gn = F.lds;
    LAS float* rsG = (LAS float*)(F.lds + 16384);
    const int tid = F.tid, lane = F.lane, w = F.wave, fr = lane & 15, quad = lane >> 4;
    const size_t tk0 = (size_t)unit * 128;
    __syncthreads();
    if (tid < 128) { const f32x4* sp = (const f32x4*)(F.SSG + (tk0 + tid) * 16); const f32x4 a = sp[0], b2 = sp[1], c = sp[2], d = sp[3];
        const float ss = ((a.x + a.y) + (a.z + a.w)) + ((b2.x + b2.y) + (b2.z + b2.w)) + ((c.x + c.y) + (c.z + c.w)) + ((d.x + d.y) + (d.z + d.w)); rsG[tid] = 1.0f / sqrtf(ss * (1.0f / 1024.0f) + EPS); }
    else if (tid < 256) { const int q = tid - 128; const f32x4* sp = (const f32x4*)(F.SSQA + (tk0 + q) * 16); const f32x4 a = sp[0], b2 = sp[1], c = sp[2], d = sp[3];
        const float ss = ((a.x + a.y) + (a.z + a.w)) + ((b2.x + b2.y) + (b2.z + b2.w)) + ((c.x + c.y) + (c.z + c.w)) + ((d.x + d.y) + (d.z + d.w)); F.RA[tk0 + q] = 1.0f / sqrtf(ss * (1.0f / 1024.0f) + EPS); }
    float ssq = 0.f; const int p = 16 * w + fr;
    const bf16* gsrc0 = F.PROJ + (tk0 + (tid >> 3)) * NPROJ + 4096 + (tid & 7) * 8;
    const bf16* usrc = F.PROJ + (tk0 + p) * NPROJ + 3072 + 4 * quad;
    const bf16* wsrc = F.WSP + (size_t)p * 128 + 8 * quad;
    u32x4 gv0 = *(const u32x4*)(gsrc0), gv1 = *(const u32x4*)(gsrc0 + (size_t)64 * NPROJ);
    u32x2 uv[4]; bf16x8 wv[4];
#pragma unroll
    for (int dt = 0; dt < 4; ++dt) { uv[dt] = *(const u32x2*)(usrc + 16 * dt); wv[dt] = *(const bf16x8*)(wsrc + 32 * dt); }
    for (int gi = 0; gi < 16; ++gi) {
        __syncthreads();
#pragma unroll
        for (int j = 0; j < 2; ++j) { const int q = (tid >> 3) + 64 * j, c = tid & 7; const u32x4 v = j ? gv1 : gv0; const float rr = rsG[q];
            const f32x4 ga = *(const f32x4*)(F.gsg + gi * 64 + c * 8), gb = *(const f32x4*)(F.gsg + gi * 64 + c * 8 + 4);
            u32x4 o; o.x = cvt_pk_bf16(bflo(v.x) * rr * ga.x, bfhi(v.x) * rr * ga.y); o.y = cvt_pk_bf16(bflo(v.y) * rr * ga.z, bfhi(v.y) * rr * ga.w);
            o.z = cvt_pk_bf16(bflo(v.z) * rr * gb.x, bfhi(v.z) * rr * gb.y); o.w = cvt_pk_bf16(bflo(v.w) * rr * gb.z, bfhi(v.w) * rr * gb.w);
            *(LAS u32x4*)(Gn + q * 128 + ((c ^ (q & 7)) << 4)) = o; }
        u32x2 uc[4]; bf16x8 wf[4];
#pragma unroll
        for (int dt = 0; dt < 4; ++dt) { uc[dt] = uv[dt]; wf[dt] = wv[dt]; }
        if (gi < 15) { gv0 = *(const u32x4*)(gsrc0 + (gi + 1) * 64); gv1 = *(const u32x4*)(gsrc0 + (size_t)64 * NPROJ + (gi + 1) * 64);
#pragma unroll
            for (int dt = 0; dt < 4; ++dt) { uv[dt] = *(const u32x2*)(usrc + (gi + 1) * 64 + 16 * dt); wv[dt] = *(const bf16x8*)(wsrc + (size_t)(gi + 1) * 16384 + 32 * dt); } }
        __syncthreads();
        f32x4 acc[4];
#pragma unroll
        for (int dt = 0; dt < 4; ++dt) acc[dt] = (f32x4){0.f, 0.f, 0.f, 0.f};
#pragma unroll
        for (int ks = 0; ks < 4; ++ks) { const int rowA = 32 * ks + 8 * quad + (fr >> 2), rowB = rowA + 4; const int pp = fr & 3;
#pragma unroll
            for (int dt = 0; dt < 4; ++dt) { const int c = 2 * dt + (pp >> 1);
                const s16x4 lo = tr_read(Gn + rowA * 128 + ((c ^ (rowA & 7)) << 4) + 8 * (pp & 1)), hi = tr_read(Gn + rowB * 128 + ((c ^ (rowB & 7)) << 4) + 8 * (pp & 1));
                const bf16x8 af = __builtin_shufflevector(lo, hi, 0, 1, 2, 3, 4, 5, 6, 7);
                acc[dt] = __builtin_amdgcn_mfma_f32_16x16x32_bf16(af, wf[ks], acc[dt], 0, 0, 0); } }
        const float bs = F.b_sp[gi * 128 + p];
        u32x2 pk[4];
#pragma unroll
        for (int dt = 0; dt < 4; ++dt) { const u32x2 uu = uc[dt];
            const float s0 = bflo(uu.x) * (acc[dt][0] + bs), s1 = bfhi(uu.x) * (acc[dt][1] + bs), s2 = bflo(uu.y) * (acc[dt][2] + bs), s3 = bfhi(uu.y) * (acc[dt][3] + bs);
            ssq += (s0 * s0 + s1 * s1) + (s2 * s2 + s3 * s3);
            pk[dt].x = cvt_pk_bf16(s0, s1); pk[dt].y = cvt_pk_bf16(s2, s3); }
#pragma unroll
        for (int dp = 0; dp < 2; ++dp) *(u32x4*)(F.MIX + (tk0 + p) * DM + 1024 + gi * 64 + 32 * dp + 4 * quad + ((quad & 1) ? 12 : 0)) = pair16(pk[2 * dp], pk[2 * dp + 1]);
    }
    ssq += __shfl_xor(ssq, 16); ssq += __shfl_xor(ssq, 32);
    if (quad == 0) F.RB[tk0 + p] = 1.0f / sqrtf(ssq * (1.0f / 1024.0f) + EPS);
}

__device__ __forceinline__ void router_unit(Frame& F, int unit) {
    constexpr int WROW = 544, WBUF = 64 * WROW;
    LAS unsigned char* wimg = F.lds;
    LAS float* lgL = (LAS float*)(F.lds + 2 * WBUF);
    LAS unsigned* histL = (LAS unsigned*)(F.lds + 2 * WBUF + 16896); LAS unsigned* baseL = histL + 32;
    const int tid = F.tid, lane = F.lane, w = F.wave, fr = lane & 15, quad = lane >> 4;
    const int token = unit * 128 + 16 * w + fr;
    __syncthreads();
    if (tid < 32) histL[tid] = 0u;
    const bf16* xrow = F.X2B + (size_t)token * DM + 8 * quad;
    unsigned char* trow = F.H8 + (size_t)token * DM + 8 * quad;
    f32x4 acc[2]; acc[0] = (f32x4){0.f, 0.f, 0.f, 0.f}; acc[1] = acc[0];
    float rstd;
    { const f32x4 p0 = *(const f32x4*)(F.SSX + (size_t)token * 32 + 8 * quad), p1 = *(const f32x4*)(F.SSX + (size_t)token * 32 + 8 * quad + 4);
      float ss = ((p0.x + p0.y) + (p0.z + p0.w)) + ((p1.x + p1.y) + (p1.z + p1.w)); ss += __shfl_xor(ss, 16); ss += __shfl_xor(ss, 32); rstd = 1.0f / sqrtf(ss * (1.0f / DM) + EPS); }
    u32x4 wst[4];
#define RT_WLOAD(c) do { _Pragma("unroll") for (int j = 0; j < 4; ++j) { const int id = j * 512 + tid, row = id >> 5, cc = id & 31; \
        wst[j] = *(const u32x4*)((row < 32 ? F.WRH + (size_t)row * DM : F.WRL + (size_t)(row - 32) * DM) + 256 * (c) + 8 * cc); } } while (0)
#define RT_WSTORE(b) do { _Pragma("unroll") for (int j = 0; j < 4; ++j) { const int id = j * 512 + tid, row = id >> 5, cc = id & 31; *(LAS u32x4*)(wimg + (b) * WBUF + row * WROW + cc * 16) = wst[j]; } } while (0)
    RT_WLOAD(0); RT_WSTORE(0);
    __syncthreads();
    for (int c = 0; c < 8; ++c) {
        if (c < 7) RT_WLOAD(c + 1);
        const LAS unsigned char* wb = wimg + (c & 1) * WBUF + fr * WROW + quad * 16;
#pragma unroll 2
        for (int kp = 0; kp < 4; ++kp) {
            u32x2 t8[2];
#pragma unroll
            for (int h2 = 0; h2 < 2; ++h2) { const int kl = 2 * kp + h2, ks = 8 * c + kl;
                const u32x4 xr = *(const u32x4*)(xrow + 32 * ks); const f32x4 xa = {bflo(xr.x), bfhi(xr.x), bflo(xr.y), bfhi(xr.y)}, xb = {bflo(xr.z), bfhi(xr.z), bflo(xr.w), bfhi(xr.w)};
                const f32x4 ga = *(const f32x4*)(F.g2 + 32 * ks + 8 * quad), gb = *(const f32x4*)(F.g2 + 32 * ks + 8 * quad + 4);
                const f32x4 ya = xa * ga * rstd, yb = xb * gb * rstd;
                u32x4 h; h.x = cvt_pk_bf16(ya.x, ya.y); h.y = cvt_pk_bf16(ya.z, ya.w); h.z = cvt_pk_bf16(yb.x, yb.y); h.w = cvt_pk_bf16(yb.z, yb.w);
                u32x4 l; l.x = cvt_pk_bf16(ya.x - bflo(h.x), ya.y - bfhi(h.x)); l.y = cvt_pk_bf16(ya.z - bflo(h.y), ya.w - bfhi(h.y)); l.z = cvt_pk_bf16(yb.x - bflo(h.z), yb.y - bfhi(h.z)); l.w = cvt_pk_bf16(yb.z - bflo(h.w), yb.w - bfhi(h.w));
                t8[h2].x = pk4_fp8(ya.x, ya.y, ya.z, ya.w); t8[h2].y = pk4_fp8(yb.x, yb.y, yb.z, yb.w);
                const bf16x8 yh = __builtin_bit_cast(bf16x8, h), yl = __builtin_bit_cast(bf16x8, l);
#pragma unroll
                for (int et = 0; et < 2; ++et) {
                    const bf16x8 wh = *(const LAS bf16x8*)(wb + (16 * et) * WROW + kl * 64), wl = *(const LAS bf16x8*)(wb + (32 + 16 * et) * WROW + kl * 64);
                    acc[et] = __builtin_amdgcn_mfma_f32_16x16x32_bf16(wh, yh, acc[et], 0, 0, 0);
                    acc[et] = __builtin_amdgcn_mfma_f32_16x16x32_bf16(wh, yl, acc[et], 0, 0, 0);
                    acc[et] = __builtin_amdgcn_mfma_f32_16x16x32_bf16(wl, yh, acc[et], 0, 0, 0); } }
            *(u32x4*)(trow + 64 * (4 * c + kp) + ((quad & 1) ? 24 : 0)) = pair16(t8[0], t8[1]);
        }
        if (c < 7) RT_WSTORE((c + 1) & 1);
        __syncthreads();
    }
#undef RT_WLOAD
#undef RT_WSTORE
#pragma unroll
    for (int et = 0; et < 2; ++et)
#pragma unroll
        for (int i = 0; i < 4; ++i) { const int e = 16 * et + 4 * quad + i; lgL[(w * 16 + fr) * 33 + e] = acc[et][i] + F.b_r[e]; }
    __syncthreads();
    int ev[4]; float gv[4]; unsigned lp[4];
    const int mytok = unit * 128 + 16 * w + lane;
    if (lane < 16) {
        const LAS float* lg = lgL + (w * 16 + lane) * 33; unsigned mask = 0u; float vv[4];
#pragma unroll
        for (int k = 0; k < 4; ++k) { float best = -INFINITY; int bi = 0;
            for (int e = 0; e < 32; ++e) { const float v = lg[e]; if (!((mask >> e) & 1u) && v > best) { best = v; bi = e; } }
            mask |= 1u << bi; ev[k] = bi; vv[k] = best; }
        const float e1 = __expf(vv[1] - vv[0]), e2 = __expf(vv[2] - vv[0]), e3 = __expf(vv[3] - vv[0]); const float inv = 1.0f / (1.0f + e1 + e2 + e3);
        gv[0] = inv; gv[1] = e1 * inv; gv[2] = e2 * inv; gv[3] = e3 * inv;
#pragma unroll
        for (int k = 0; k < 4; ++k) lp[k] = __hip_atomic_fetch_add(histL + ev[k], 1u, __ATOMIC_RELAXED, __HIP_MEMORY_SCOPE_WORKGROUP);
    }
    __syncthreads();
    if (tid < 32) baseL[tid] = __hip_atomic_fetch_add((unsigned*)(F.ctl + CW_CNT + 64 * tid), histL[tid], RLX_AGENT);
    __syncthreads();
    if (lane < 16) {
#pragma unroll
        for (int k = 0; k < 4; ++k) { const unsigned pos = baseL[ev[k]] + lp[k];
            F.LIST[(size_t)ev[k] * CAP + pos] = mytok * 4 + k; F.GATE[(size_t)mytok * 4 + k] = gv[k]; }
    }
}

__device__ __forceinline__ int moe_tables(Frame& F) {
    LAS int* cntL = (LAS int*)(F.lds + XT_CNT); LAS int* tstartL = (LAS int*)(F.lds + XT_TSTART); LAS unsigned char* tileE = F.lds + XT_TILEE;
    __syncthreads();
    if (F.tid < 32) cntL[F.tid] = (int)__hip_atomic_load((unsigned*)(F.ctl + CW_CNT + 64 * F.tid), RLX_AGENT);
    __syncthreads();
    if (F.tid == 0) { int s = 0; for (int e = 0; e < 32; ++e) { tstartL[e] = s; s += (cntL[e] + 255) >> 8; } tstartL[32] = s; }
    __syncthreads();
    const int total = tstartL[32];
    for (int mt = F.tid; mt < total; mt += 512) { int e = 0; for (int k = 1; k < 32; ++k) e += (tstartL[k] <= mt) ? 1 : 0; tileE[mt] = (unsigned char)e; }
    __syncthreads();
    return __builtin_amdgcn_readfirstlane(total);
}

struct Args { const float* in[19]; float* out; unsigned char* ws; int ph_lo, ph_hi; };
__global__ void __launch_bounds__(NWAVES * 64, 2) mk_fwd(Args args) {
    extern __shared__ __attribute__((aligned(16))) unsigned char lds[];
    Frame F;
    F.lds = (LAS unsigned char*)lds;
    F.MISC = (volatile LAS unsigned*)(F.lds + MISC_OFF);
    F.tid = threadIdx.x; F.lane = F.tid & 63; F.wave = __builtin_amdgcn_readfirstlane(F.tid >> 6);
    F.G = gridDim.x; { const int bx = blockIdx.x; F.vcu = (F.G % 8 == 0) ? (bx % 8) * (F.G / 8) + bx / 8 : bx; }
    unsigned char* ws = args.ws;
    F.ctl = (gu32*)(ws + WS_CTL);
    F.x = args.in[0]; F.g1 = args.in[1]; F.w_in = args.in[2]; F.gq = args.in[3]; F.gk = args.in[4]; F.rpb = args.in[5]; F.gsg = args.in[6]; F.w_sp = args.in[7]; F.b_sp = args.in[8];
    F.ga = args.in[9]; F.gs = args.in[10]; F.w_out = args.in[11]; F.g2 = args.in[12]; F.w_r = args.in[13]; F.b_r = args.in[14]; F.w_gu = args.in[15]; F.b_gu = args.in[16]; F.w_dn = args.in[17]; F.b_dn = args.in[18];
    F.out = args.out;
    F.WIN = (bf16*)(ws + WS_WIN); F.WOUT = (bf16*)(ws + WS_WOUT); F.WSP = (bf16*)(ws + WS_WSP); F.WRH = (bf16*)(ws + WS_WRH); F.WRL = (bf16*)(ws + WS_WRL);
    F.WGU = ws + WS_WGU; F.WDN = ws + WS_WDN; F.H = (bf16*)(ws + WS_H); F.H8 = ws + WS_H; F.PROJ = (bf16*)(ws + WS_PROJ); F.X2B = (bf16*)(ws + WS_PROJ);     F.MIX = (bf16*)(ws + WS_MIX);
    F.ACT = ws + WS_ACT; F.Y = ws + WS_Y; F.RMS1 = (float*)(ws + WS_RMS1); F.IG1 = (float*)(ws + WS_IG1); F.SSX = (float*)(ws + WS_SSX); F.RA = (float*)(ws + WS_RA); F.RB = (float*)(ws + WS_RB); F.SSQA = (float*)(ws + WS_SSQA); F.SSG = (float*)(ws + WS_SSG); F.RSTD2 = (float*)(ws + WS_RSTD2); F.GATE = (float*)(ws + WS_GATE); F.SLOT = (unsigned*)(ws + WS_SLOT); F.LIST = (int*)(ws + WS_LIST);
    for (int u = F.tid; u < (LDS_BYTES - LDSCTL_OFF) / 4; u += NWAVES * 64) ((LAS unsigned*)(F.lds + LDSCTL_OFF))[u] = 0u;
    __syncthreads();
    XcdBarrier bar; bar.bar = (unsigned*)(F.ctl + CW_BAR); bar.x = 0; bar.st = nullptr;
    if (N_LAUNCHES == 1) bar = xcd_barrier_post((unsigned*)(F.ctl + CW_BAR), F.MISC + 8);
#define GRID_BAR() do { if (N_LAUNCHES == 1) xcd_barrier(bar); } while (0)
    const int lo = args.ph_lo, hi = args.ph_hi;
#define IN(k) (lo <= (k) && (k) < hi)
#define BOTH(k) (IN(k) && IN((k) + 1))

    if (IN(0)) { p0_prologue(F); if (BOTH(0)) GRID_BAR(); }

    if (IN(1)) {
        TileOrder S; S.init(NTOK / BM, NPROJ / BM, F.G, (int)blockIdx.x, nullptr);
        EpiProjX E{F.PROJ, F.gq, F.gk, F.SSG};
        const int grp = F.vcu & 1, nconv = (NE * (16 * 16 + 16 * 8) - F.vcu + F.G - 1) / F.G, hconv = nconv / 2;
        moe_convert(F, 0, grp == 0 ? hconv : 0);
        S.ib = 0; S.ie = 5;
        gemm_phase<EpiProjX, false, true, false>(F.lds, (const char*)F.H, (const char*)F.WIN, 0, DM * 2, S, E, nullptr);
        moe_convert(F, grp == 0 ? hconv : 0, grp == 0 ? nconv : hconv);
        S.ib = 5; S.ie = 0x7fffffff;
        gemm_phase<EpiProjX, false, true, false>(F.lds, (const char*)F.H, (const char*)F.WIN, 0, DM * 2, S, E, nullptr);
        moe_convert(F, grp == 0 ? nconv : hconv, nconv);
        if (BOTH(1)) GRID_BAR();
    }

    if (IN(2)) {
        for (int u = F.vcu; u < NBATCH * 16 * 8; u += F.G) attn_unit(F, u >> 7, (u >> 3) & 15, u & 7);
        if (BOTH(2)) GRID_BAR();
    }

    if (IN(3)) {
        for (int u = F.vcu; u < NTOK / 128; u += F.G) sgu_unit(F, u);
        if (BOTH(3)) GRID_BAR();
    }

    if (IN(4)) {
        TileOrder S; S.init(NTOK / BM, DM / BM, F.G, (int)blockIdx.x, nullptr);
        EpiResid E{F.H, F.RMS1, F.IG1, F.X2B, DM, F.RA, F.RB, F.SSX};
        gemm_phase<EpiResid, false, true, false>(F.lds, (const char*)F.MIX, (const char*)F.WOUT, 0, DM * 2, S, E, nullptr);
        if (BOTH(4)) GRID_BAR();
    }

    if (IN(5)) {
        for (int u = F.vcu; u < NTOK / 128; u += F.G) router_unit(F, u);
        if (BOTH(5)) GRID_BAR();
    }

    if (IN(6)) {
        const int total = moe_tables(F);
        LAS unsigned short* tokL = (LAS unsigned short*)(F.lds + XT_TOKL); const LAS int* cntL = (const LAS int*)(F.lds + XT_CNT); const LAS int* tstartL = (const LAS int*)(F.lds + XT_TSTART);
        TileOrder S; S.init(total, 16, F.G, (int)blockIdx.x, F.lds + XT_TILEE);
        { Unit u; for (int i = 0; i < 36 && S.next(i, u); ++i) { if (F.tid < 256) { const int lp = (u.pm - tstartL[u.e]) * 256 + F.tid; tokL[i * 256 + F.tid] = (unsigned short)(lp < cntL[u.e] ? (F.LIST[(size_t)u.e * CAP + lp] >> 2) : 0); } } }
        __syncthreads();
        EpiSwiglu E{F.ACT, F.b_gu, (const LAS float*)(F.lds + XT_BIAS), (unsigned)(size_t)(F.lds + XT_BIAS)};
        gemm_phase<EpiSwiglu, true, true, true>(F.lds, (const char*)F.H8, (const char*)F.WGU, (size_t)4096 * DM, DM, S, E, tokL);
        if (BOTH(6)) GRID_BAR();
    }

    if (IN(7)) {
        const int total = moe_tables(F);
        LAS unsigned* dstL = (LAS unsigned*)(F.lds + XT_TOKL); const LAS int* cntL = (const LAS int*)(F.lds + XT_CNT); const LAS int* tstartL = (const LAS int*)(F.lds + XT_TSTART);
        TileOrder S; S.init(total, 8, F.G, (int)blockIdx.x, F.lds + XT_TILEE);
        { Unit u; for (int i = 0; i < 18 && S.next(i, u); ++i) { if (F.tid < 256) { const int lp = (u.pm - tstartL[u.e]) * 256 + F.tid; dstL[i * 256 + F.tid] = lp < cntL[u.e] ? (unsigned)F.LIST[(size_t)u.e * CAP + lp] : (unsigned)(NTOK * TOPK); } } }
        __syncthreads();
        EpiDown E{F.Y, F.b_dn, dstL, (const LAS float*)(F.lds + XT_BIAS), (unsigned)(size_t)(F.lds + XT_BIAS)};
        gemm_phase<EpiDown, false, true, true>(F.lds, (const char*)F.ACT, (const char*)F.WDN, (size_t)DM * DM, DM, S, E, nullptr);
        if (BOTH(7)) GRID_BAR();
    }

    if (IN(8)) {
        const int gw = F.vcu * NWAVES + F.wave, NGW = F.G * NWAVES, lane = F.lane;
        for (int t = gw; t < NTOK; t += NGW) {
            const f32x4 gt = *(const f32x4*)(F.GATE + (size_t)t * 4);
            float* orow = F.out + (size_t)t * DM + 16 * lane; const unsigned char* yrow = F.Y + (size_t)t * 4 * DM + 16 * lane; const bf16* xrow = F.X2B + (size_t)t * DM + 16 * lane;
#pragma unroll
            for (int j = 0; j < 2; ++j) { f32x4 o[4];
                const u32x4 xlo = *(const u32x4*)(xrow + 1024 * j), xhi = *(const u32x4*)(xrow + 1024 * j + 8);
                o[0] = (f32x4){bflo(xlo.x), bfhi(xlo.x), bflo(xlo.y), bfhi(xlo.y)}; o[1] = (f32x4){bflo(xlo.z), bfhi(xlo.z), bflo(xlo.w), bfhi(xlo.w)};
                o[2] = (f32x4){bflo(xhi.x), bfhi(xhi.x), bflo(xhi.y), bfhi(xhi.y)}; o[3] = (f32x4){bflo(xhi.z), bfhi(xhi.z), bflo(xhi.w), bfhi(xhi.w)};
#pragma unroll
                for (int k = 0; k < 4; ++k) { const u32x4 y = *(const u32x4*)(yrow + (size_t)k * DM + 1024 * j); const float g = gt[k];
#pragma unroll
                    for (int q = 0; q < 4; ++q) { const f32x2 lo = __builtin_amdgcn_cvt_pk_f32_fp8((int)y[q], false), hi = __builtin_amdgcn_cvt_pk_f32_fp8((int)y[q], true);
                        o[q].x += g * lo.x; o[q].y += g * lo.y; o[q].z += g * hi.x; o[q].w += g * hi.y; } }
#pragma unroll
                for (int q = 0; q < 4; ++q) *(f32x4*)(orow + 1024 * j + 4 * q) = o[q]; }
        }
    }
#undef IN
#undef BOTH
}

extern "C" void kernel_launch(void* const* d_in, const int* in_sizes, int n_in, void* d_out, int out_size, void* d_ws, size_t ws_size, hipStream_t stream) {
    static int grid = 0;
    if (grid == 0) {
        if (n_in != 19 || out_size != NTOK * DM || ws_size < WS_END) { fprintf(stderr, "kernel_launch: unexpected problem (n_in %d, out %d, ws %zu)\n", n_in, out_size, ws_size); grid = -1; return; }
        int dev = 0, cus = 0, per_cu = 0;
        if (hipGetDevice(&dev) != hipSuccess || hipDeviceGetAttribute(&cus, hipDeviceAttributeMultiprocessorCount, dev) != hipSuccess) { grid = -1; return; }
        if (hipFuncSetAttribute((const void*)mk_fwd, hipFuncAttributeMaxDynamicSharedMemorySize, LDS_BYTES) != hipSuccess) { fprintf(stderr, "kernel_launch: hipFuncSetAttribute failed\n"); grid = -1; return; }
        if (hipOccupancyMaxActiveBlocksPerMultiprocessor(&per_cu, (const void*)mk_fwd, NWAVES * 64, LDS_BYTES) != hipSuccess || per_cu < 1) { fprintf(stderr, "kernel_launch: occupancy query says %d\n", per_cu); }
        (void)hipGetLastError();
        grid = cus;
    }
    if (grid < 0) return;
    if (hipMemsetAsync((char*)d_ws + WS_CTL, 0, CTL_ZERO_BYTES, stream) != hipSuccess) return;
    Args a{};
    for (int i = 0; i < 19; ++i) a.in[i] = (const float*)d_in[i];
    a.out = (float*)d_out; a.ws = (unsigned char*)d_ws;
    for (int li = 0; li < N_LAUNCHES; ++li) {
        a.ph_lo = (N_LAUNCHES == 1) ? 0 : li; a.ph_hi = (N_LAUNCHES == 1) ? N_PHASES : li + 1;
        hipLaunchKernelGGL(mk_fwd, dim3(grid), dim3(NWAVES * 64), LDS_BYTES, stream, a);
    }
}
```

```cpp
#include <hip/hip_runtime.h>
#include <cstdio>
#include <cstdint>

#ifndef MK_N_LAUNCHES
#define MK_N_LAUNCHES 1
#endif
constexpr int N_LAUNCHES = MK_N_LAUNCHES;
constexpr int N_PHASES = 9;

#define LAS __attribute__((address_space(3)))
#define GAS __attribute__((address_space(1)))
typedef unsigned short bf16;
typedef short bf16x8 __attribute__((ext_vector_type(8)));
typedef short s16x4 __attribute__((ext_vector_type(4)));
typedef float f32x4 __attribute__((ext_vector_type(4)));
typedef float f32x2 __attribute__((ext_vector_type(2)));
typedef unsigned u32x4 __attribute__((ext_vector_type(4)));
typedef unsigned u32x2 __attribute__((ext_vector_type(2)));
typedef GAS unsigned gu32;
typedef int v8i __attribute__((ext_vector_type(8)));
typedef int v4i __attribute__((ext_vector_type(4)));
typedef int v6i __attribute__((ext_vector_type(6)));
typedef float v16f __attribute__((ext_vector_type(16)));

constexpr int NTOK = 32768, DM = 2048, NPROJ = 5120, SEQ = 8192, NBATCH = 4;
constexpr int NE = 32, TOPK = 4, CAP = 32768;
constexpr int MAXROWS = NTOK * TOPK + NE * 256;
constexpr float EPS = 1e-6f;
constexpr int NWAVES = 8;

constexpr size_t MiB = 1u << 20;
constexpr size_t WS_CTL = 0, CTL_ZERO_BYTES = 1 * MiB;
constexpr size_t WS_WIN = 2 * MiB;
constexpr size_t WS_WOUT = 22 * MiB;
constexpr size_t WS_WSP = 30 * MiB;
constexpr size_t WS_WRH = 31 * MiB;
constexpr size_t WS_WRL = 31 * MiB + 128 * 1024;
constexpr size_t WS_RSTD2 = 31 * MiB + 512 * 1024;
constexpr size_t WS_SLOT = 32 * MiB;
constexpr size_t WS_GATE = 32 * MiB + 512 * 1024;
constexpr size_t WS_LIST = 33 * MiB;
constexpr size_t WS_WGU = 40 * MiB;
constexpr size_t WS_SSQA = 300 * MiB;
constexpr size_t WS_SSG = 304 * MiB;
constexpr size_t WS_RA = 308 * MiB;
constexpr size_t WS_RB = 309 * MiB;
constexpr size_t WS_SSX = 312 * MiB;
constexpr size_t WS_RMS1 = 310 * MiB;
constexpr size_t WS_IG1 = 311 * MiB;
constexpr size_t WS_WDN = 552 * MiB;
constexpr size_t WS_H = 808 * MiB;
constexpr size_t WS_PROJ = 936 * MiB;
constexpr size_t WS_MIX = 1256 * MiB;
constexpr size_t WS_ACT = 1384 * MiB;
constexpr size_t WS_Y = 1928 * MiB;
constexpr size_t WS_END = 2472 * MiB;

constexpr int CW_TMO = 0, CW_CODE = 1;
constexpr int CW_BAR = 4096;
constexpr int CW_CNT = 8192;

constexpr int RING_BYTES = 131072;
constexpr int XT_OFF = RING_BYTES;
constexpr int XT_TOKL = XT_OFF;
constexpr int XT_TILEE = XT_OFF + 18432;
constexpr int XT_TSTART = XT_TILEE + 576;
constexpr int XT_CNT = XT_TSTART + 160;
constexpr int XT_BIAS = XT_OFF + 19456;
constexpr int XT_GAINS = XT_BIAS + 2048;
constexpr int XT_MISC2 = XT_GAINS + 512;
constexpr int AT_RPB = 147456;
constexpr int AT_MRG = AT_RPB + 2048;
constexpr int LDSCTL_OFF = AT_MRG + 10240;
constexpr int MISC_OFF = LDSCTL_OFF + 320;
constexpr int LDS_BYTES = LDSCTL_OFF + 1024;
static_assert(XT_CNT + 128 <= XT_BIAS && XT_MISC2 <= LDSCTL_OFF && LDS_BYTES <= 160 * 1024, "LDS map");
constexpr int N_PH = 9;

#define RLX_AGENT __ATOMIC_RELAXED, __HIP_MEMORY_SCOPE_AGENT
#define LDS_WAIT() asm volatile("s_waitcnt lgkmcnt(0)" ::: "memory")
#define VM_WAIT() asm volatile("s_waitcnt vmcnt(0)" ::: "memory")

__device__ __forceinline__ unsigned cvt_pk_bf16(float lo, float hi) { unsigned r; asm volatile("v_cvt_pk_bf16_f32 %0, %1, %2" : "=v"(r) : "v"(lo), "v"(hi)); return r; }
__device__ __forceinline__ unsigned pk4_fp8(float a, float b, float c, float d) { int w = 0; w = __builtin_amdgcn_cvt_pk_fp8_f32(a, b, w, false); w = __builtin_amdgcn_cvt_pk_fp8_f32(c, d, w, true); return (unsigned)w; }
__device__ __forceinline__ v8i cat8(bf16x8 a, bf16x8 b) { const v4i x = __builtin_bit_cast(v4i, a), y = __builtin_bit_cast(v4i, b); return __builtin_shufflevector(x, y, 0, 1, 2, 3, 4, 5, 6, 7); }
__device__ __forceinline__ bf16x8 lo8(v8i a) { return __builtin_bit_cast(bf16x8, (v4i)__builtin_shufflevector(a, a, 0, 1, 2, 3)); }
__device__ __forceinline__ bf16x8 hi8(v8i a) { return __builtin_bit_cast(bf16x8, (v4i)__builtin_shufflevector(a, a, 4, 5, 6, 7)); }
__device__ __forceinline__ void glds16(const void* gsrc, unsigned lds_dst) { unsigned keep;
    asm volatile("s_mov_b32 %0, m0\n\ts_mov_b32 m0, %2\n\ts_nop 0\n\tglobal_load_lds_dwordx4 %1, off\n\ts_mov_b32 m0, %0" : "=&s"(keep) : "v"(gsrc), "s"(lds_dst) : "memory"); }
__device__ __forceinline__ u32x4 pair16(u32x2 a, u32x2 b) { const auto s0 = __builtin_amdgcn_permlane16_swap(a.x, b.x, false, false), s1 = __builtin_amdgcn_permlane16_swap(a.y, b.y, false, false);
    u32x4 w; w.x = s0[0]; w.y = s1[0]; w.z = s0[1]; w.w = s1[1]; return w; }
__device__ __forceinline__ void mx6_pack(v16f a, v16f b, u32x4& w0, u32x4& w1) {
    float m0 = 0.f, m1 = 0.f;
#pragma unroll
    for (int i = 0; i < 16; ++i) { m0 = fmaxf(m0, fabsf(a[i])); m1 = fmaxf(m1, fabsf(b[i])); }
    const float mx = fmaxf(m0, m1);
    int sb = (int)(((__float_as_uint(mx) + 0x00100000u) >> 23) & 0xffu) - 2;
    sb = sb < 2 ? 2 : (sb > 250 ? 250 : sb);
    const float inv = __uint_as_float((unsigned)(254 - sb) << 23);
    a = a * inv; b = b * inv;
    v6i r; asm volatile("v_cvt_scalef32_2xpk16_fp6_f32 %0, %1, %2, 1.0" : "=&v"(r) : "v"(a), "v"(b));
    w0.x = (unsigned)r[0]; w0.y = (unsigned)r[1]; w0.z = (unsigned)r[2]; w0.w = (unsigned)r[3];
    w1.x = (unsigned)r[4]; w1.y = (unsigned)r[5]; w1.z = (unsigned)sb; w1.w = 0u;
}
__device__ __forceinline__ float bflo(unsigned u) { return __uint_as_float(u << 16); }
__device__ __forceinline__ float bfhi(unsigned u) { return __uint_as_float(u & 0xffff0000u); }
__device__ __forceinline__ float wave_sum(float v) {
#pragma unroll
    for (int o = 1; o < 64; o <<= 1) v += __shfl_xor(v, o);
    return v;
}
__device__ __forceinline__ f32x2 gelu_pk(f32x2 v) {
    const f32x2 av = __builtin_elementwise_abs(v), d = av * 0.2316418882f + 1.0f;
    f32x2 t; t.x = __builtin_amdgcn_rcpf(d.x); t.y = __builtin_amdgcn_rcpf(d.y);
    f32x2 q = t * 0.5307027145f + (-0.7265760135f); q = q * t + 0.7107068705f; q = q * t + (-0.142248368f); q = q * t + 0.127414796f; q = q * t;
    const f32x2 s = (v * v) * (-0.72134752044f);
    f32x2 e; e.x = __builtin_amdgcn_exp2f(s.x); e.y = __builtin_amdgcn_exp2f(s.y);
    const f32x2 m = v * (q * e), r = v - m;
    f32x2 o; o.x = v.x < 0.f ? m.x : r.x; o.y = v.y < 0.f ? m.y : r.y; return o;
}
__device__ __forceinline__ float gelu1(float x) { f32x2 r = gelu_pk((f32x2){x, x}); return r.x; }

#define XB_TMO      128
#define XB_XCNT(j)  (256  + 64 * (j))
#define XB_XSUB(j)  (1280 + 64 * (j))
#define XB_XGEN(j)  (2304 + 64 * (j))
#define XB_TOP      3328
#define XB_TOPGEN   3392
#define XCD_BAR_WORDS 3456
#define XB_SPIN_CAP (1u << 18)
__device__ __forceinline__ unsigned xb_ld(unsigned* p)              { return __hip_atomic_load(p, __ATOMIC_RELAXED, __HIP_MEMORY_SCOPE_AGENT); }
__device__ __forceinline__ unsigned xb_add(unsigned* p, unsigned v) { return __hip_atomic_fetch_add(p, v, __ATOMIC_RELAXED, __HIP_MEMORY_SCOPE_AGENT); }
__device__ __forceinline__ unsigned xb_xcc_id() { return (unsigned)__builtin_amdgcn_s_getreg((3 << 11) | 20) & 0xFu; }
#define XB_SPIN(cond, bar) do { unsigned _sp = 0; while (cond) { __builtin_amdgcn_s_sleep(1); \
    if ((++_sp & 255u) == 0u) { if (xb_ld(&(bar)[XB_TMO])) break; if (_sp > XB_SPIN_CAP) { atomicAdd(&(bar)[XB_TMO], 1u); break; } } } } while (0)
struct XcdBarrier { unsigned* bar; unsigned x; volatile LAS unsigned* st; };
__device__ __forceinline__ XcdBarrier xcd_barrier_post(unsigned* bar, volatile LAS unsigned* st) {
    XcdBarrier b; b.bar = bar; b.x = xb_xcc_id(); b.st = st;
    if (threadIdx.x == 0) (void)xb_add(&bar[XB_XCNT(b.x)], 1u);
    return b;
}
__device__ __forceinline__ void xcd_barrier_complete(unsigned* bar, unsigned x, unsigned& nloc, unsigned& nx) {
    const unsigned G = gridDim.x * gridDim.y * gridDim.z;
    unsigned sum, cnt, mine, sp = 0u;
    for (;;) {
        sum = 0u; cnt = 0u; mine = 0u;
#pragma unroll
        for (unsigned j = 0; j < 16; ++j) { const unsigned c = xb_ld(&bar[XB_XCNT(j)]); sum += c; cnt += (c > 0u) ? 1u : 0u; mine = (j == x) ? c : mine; }
        if (sum == G) break;
        __builtin_amdgcn_s_sleep(1);
        if ((++sp & 255u) == 0u) { if (xb_ld(&bar[XB_TMO])) break; if (sp > XB_SPIN_CAP) { atomicAdd(&bar[XB_TMO], 1u); break; } }
    }
    nloc = mine > 0u ? mine : 1u; nx = cnt > 0u ? cnt : 1u;
}
__device__ __forceinline__ void xcd_barrier(const XcdBarrier& b) {
    asm volatile("s_waitcnt vmcnt(0)" ::: "memory");
    __syncthreads();
    if (threadIdx.x == 0) {
        unsigned* bar = b.bar;
        __builtin_amdgcn_s_waitcnt(0);
        unsigned nloc = b.st[0], nx = b.st[1];
        if (nloc == 0u) { xcd_barrier_complete(bar, b.x, nloc, nx); b.st[0] = nloc; b.st[1] = nx; }
        const unsigned old = xb_add(&bar[XB_XSUB(b.x)], 1u);
        const unsigned gen = old / nloc;
        if (old + 1u == (gen + 1u) * nloc) {
            __builtin_amdgcn_fence(__ATOMIC_RELEASE, "agent");
            asm volatile("s_waitcnt vmcnt(0)" ::: "memory");
            const unsigned og = xb_add(&bar[XB_TOP], 1u);
            const unsigned tg = og / nx;
            if (og + 1u == (tg + 1u) * nx) xb_add(&bar[XB_TOPGEN], 1u);
            else XB_SPIN(xb_ld(&bar[XB_TOPGEN]) == tg, bar);
            __builtin_amdgcn_fence(__ATOMIC_ACQUIRE, "agent");
            xb_add(&bar[XB_XGEN(b.x)], 1u);
            asm volatile("s_waitcnt vmcnt(0)" ::: "memory");
        } else {
            XB_SPIN(xb_ld(&bar[XB_XGEN(b.x)]) == gen, bar);
            __builtin_amdgcn_fence(__ATOMIC_ACQUIRE, "agent");
            asm volatile("s_waitcnt vmcnt(0)" ::: "memory");
        }
    }
    __syncthreads();
}

constexpr int BM = 256, BK = 64, HALF = 128, HTB = HALF * BK * 2, NXCD = 8, WGM = 8;
__host__ __device__ __forceinline__ int lds_byte(int r, int c) { const int st = (r >> 4) * 2 + (c >> 5), rr = r & 15, cc = c & 31, ob = rr * 64 + cc * 2; return st * 1024 + (ob ^ (((ob >> 9) & 1) << 5)); }
__host__ __device__ __forceinline__ void stage_rc(int b, int& R, int& C) { const int st = b / 1024, sb = b % 1024, swz = sb ^ (((sb >> 9) & 1) << 5); R = (st >> 1) * 16 + swz / 64; C = (st & 1) * 32 + (swz % 64) / 2; }
__host__ __device__ __forceinline__ int perm32(int rho) { const int n = rho >> 4, i = rho & 15; return 8 * (i >> 2) + 4 * n + (i & 3); }

struct Unit { int pm, pn, e, ui; };
struct TileOrder {
    int nM, nN, nwg, G, c, ib, ie; const LAS unsigned char* tileE;
    __device__ __forceinline__ void init(int nM_, int nN_, int G_, int c_, const LAS unsigned char* te) { nM = nM_; nN = nN_; nwg = nM * nN; G = G_; c = c_; tileE = te; ib = 0; ie = 0x7fffffff; }
    __device__ __forceinline__ bool next(int i_, Unit& u) const {
        const int i = ib + i_; if (i >= ie) return false;
        const long L = (long)i * G + c; if (L >= nwg) return false;
        int wgid = (int)L; { const int q = nwg / NXCD, r = nwg % NXCD, xcd = wgid % NXCD, off = wgid / NXCD; wgid = (xcd < r ? xcd * (q + 1) : r * (q + 1) + (xcd - r) * q) + off; }
        const int nig = WGM * nN, gid = wgid / nig, fm = gid * WGM, gsz = (nM - fm) < WGM ? (nM - fm) : WGM;
        u.pm = fm + ((wgid % nig) % gsz); u.pn = (wgid % nig) / gsz; u.ui = i;
        u.e = tileE ? __builtin_amdgcn_readfirstlane((int)tileE[u.pm]) : 0;
        return true;
    }
};

struct EpiProjX {
    static constexpr bool MIDK = false, BIASL = false;
    static constexpr bool PERM = true;
    bf16* O; const float* gq; const float* gk; float* SSG;
    __device__ __forceinline__ void operator()(const f32x4 (&acc)[2][2][4][2], const Unit& u, int wr, int wc, int fr, int fq) const {
        const int row0 = u.pm * BM + wr * 64 + fr, col0 = u.pn * BM + wc * 64 + 8 * fq, kind = u.pn >> 2;
        if (kind <= 1) {
            const float* gp = (kind == 0 ? gq : gk) + 8 * fq; const float qs = kind == 0 ? 0.125f * 1.4426950408889634f : 1.0f;
            const f32x4 g00 = *(const f32x4*)(gp), g01 = *(const f32x4*)(gp + 4), g10 = *(const f32x4*)(gp + 32), g11 = *(const f32x4*)(gp + 36);
#pragma unroll
            for (int ai = 0; ai < 2; ++ai)
#pragma unroll
                for (int m = 0; m < 4; ++m) { const f32x4 a = acc[ai][0][m][0], b = acc[ai][0][m][1], c = acc[ai][1][m][0], d = acc[ai][1][m][1];
                    float ss = (a.x * a.x + a.y * a.y) + (a.z * a.z + a.w * a.w) + (b.x * b.x + b.y * b.y) + (b.z * b.z + b.w * b.w) + (c.x * c.x + c.y * c.y) + (c.z * c.z + c.w * c.w) + (d.x * d.x + d.y * d.y) + (d.z * d.z + d.w * d.w);
                    ss += __shfl_xor(ss, 16); ss += __shfl_xor(ss, 32);
                    const float r = qs / sqrtf(ss * (1.0f / 64.0f) + EPS);
                    const f32x4 oa = a * r * g00, ob = b * r * g01, oc = c * r * g10, od = d * r * g11;
                    bf16* rowp = O + (size_t)(row0 + ai * HALF + m * 16) * NPROJ + col0;
                    u32x4 w0, w1; w0.x = cvt_pk_bf16(oa.x, oa.y); w0.y = cvt_pk_bf16(oa.z, oa.w); w0.z = cvt_pk_bf16(ob.x, ob.y); w0.w = cvt_pk_bf16(ob.z, ob.w);
                    w1.x = cvt_pk_bf16(oc.x, oc.y); w1.y = cvt_pk_bf16(oc.z, oc.w); w1.z = cvt_pk_bf16(od.x, od.y); w1.w = cvt_pk_bf16(od.z, od.w);
                    *(u32x4*)(rowp) = w0; *(u32x4*)(rowp + 32) = w1; }
        } else if (kind == 2) {
#pragma unroll
            for (int ai = 0; ai < 2; ++ai)
#pragma unroll
                for (int m = 0; m < 4; ++m) { bf16* rowp = O + (size_t)(row0 + ai * HALF + m * 16) * NPROJ + col0;
#pragma unroll
                    for (int bj = 0; bj < 2; ++bj) { const f32x4 v0 = acc[ai][bj][m][0], v1 = acc[ai][bj][m][1];
                        u32x4 w; w.x = cvt_pk_bf16(v0[0], v0[1]); w.y = cvt_pk_bf16(v0[2], v0[3]); w.z = cvt_pk_bf16(v1[0], v1[1]); w.w = cvt_pk_bf16(v1[2], v1[3]);
                        *(u32x4*)(rowp + bj * 32) = w; } }
        } else {
#pragma unroll
            for (int ai = 0; ai < 2; ++ai)
#pragma unroll
                for (int m = 0; m < 4; ++m) { const int row = row0 + ai * HALF + m * 16; bf16* rowp = O + (size_t)row * NPROJ + col0; float ss = 0.f;
#pragma unroll
                    for (int bj = 0; bj < 2; ++bj) { const f32x4 v0 = acc[ai][bj][m][0], v1 = acc[ai][bj][m][1];
                        const f32x2 a = gelu_pk((f32x2){v0[0], v0[1]}), b = gelu_pk((f32x2){v0[2], v0[3]}), c = gelu_pk((f32x2){v1[0], v1[1]}), d = gelu_pk((f32x2){v1[2], v1[3]});
                        ss += (a.x * a.x + a.y * a.y) + (b.x * b.x + b.y * b.y) + (c.x * c.x + c.y * c.y) + (d.x * d.x + d.y * d.y);
                        u32x4 w; w.x = cvt_pk_bf16(a.x, a.y); w.y = cvt_pk_bf16(b.x, b.y); w.z = cvt_pk_bf16(c.x, c.y); w.w = cvt_pk_bf16(d.x, d.y);
                        *(u32x4*)(rowp + bj * 32) = w; }
                    if (kind == 4) { ss += __shfl_xor(ss, 16); ss += __shfl_xor(ss, 32); if (fq == 0) SSG[(size_t)row * 16 + (u.pn - 16) * 4 + wc] = ss; } }
        }
    }
};
struct EpiResid {
    static constexpr bool PERM = true, MIDK = true, BIASL = false;
    const bf16* hb; const float* rms1; const float* ig1; bf16* x2b; int ldc; const float* RA; const float* RB; float* SSX;
    __device__ __forceinline__ void mid(f32x4 (&acc)[2][2][4][2], const Unit& u, int wr, int fr) const {
        const int row0 = u.pm * BM + wr * 64 + fr;
#pragma unroll
        for (int ai = 0; ai < 2; ++ai)
#pragma unroll
            for (int m = 0; m < 4; ++m) { int row = row0 + ai * HALF + m * 16; asm volatile("" : "+v"(row));
                const float f = RA[row] / RB[row];
#pragma unroll
                for (int bj = 0; bj < 2; ++bj)
#pragma unroll
                    for (int n = 0; n < 2; ++n) acc[ai][bj][m][n] = acc[ai][bj][m][n] * f; }
    }
    __device__ __forceinline__ void operator()(const f32x4 (&acc)[2][2][4][2], const Unit& u, int wr, int wc, int fr, int fq) const {
        const int row0 = u.pm * BM + wr * 64 + fr, col0 = u.pn * BM + wc * 32 + 8 * fq;
        f32x4 ig[2][2];
#pragma unroll
        for (int bj = 0; bj < 2; ++bj)
#pragma unroll
            for (int n = 0; n < 2; ++n) ig[bj][n] = *(const f32x4*)(ig1 + col0 + bj * HALF + 4 * n);
#pragma unroll
        for (int ai = 0; ai < 2; ++ai) {
            u32x4 hv[4][2]; float rb[4], rm[4];
#pragma unroll
            for (int m = 0; m < 4; ++m) { const int row = row0 + ai * HALF + m * 16; const size_t off = (size_t)row * ldc + col0; rb[m] = RB[row]; rm[m] = rms1[row];
#pragma unroll
                for (int bj = 0; bj < 2; ++bj) hv[m][bj] = *(const u32x4*)(hb + off + bj * HALF); }
#pragma unroll
            for (int m = 0; m < 4; ++m) { const int row = row0 + ai * HALF + m * 16; const size_t off = (size_t)row * ldc + col0;
                float ss = 0.f;
#pragma unroll
                for (int bj = 0; bj < 2; ++bj) { const u32x4 h = hv[m][bj];
                    const f32x4 x0 = (f32x4){bflo(h.x), bfhi(h.x), bflo(h.y), bfhi(h.y)} * ig[bj][0] * rm[m], x1 = (f32x4){bflo(h.z), bfhi(h.z), bflo(h.w), bfhi(h.w)} * ig[bj][1] * rm[m];
                    const f32x4 o0 = x0 + acc[ai][bj][m][0] * rb[m], o1 = x1 + acc[ai][bj][m][1] * rb[m];
                    ss += (o0.x * o0.x + o0.y * o0.y) + (o0.z * o0.z + o0.w * o0.w) + (o1.x * o1.x + o1.y * o1.y) + (o1.z * o1.z + o1.w * o1.w);
                    u32x4 w; w.x = cvt_pk_bf16(o0.x, o0.y); w.y = cvt_pk_bf16(o0.z, o0.w); w.z = cvt_pk_bf16(o1.x, o1.y); w.w = cvt_pk_bf16(o1.z, o1.w);
                    *(u32x4*)(x2b + off + bj * HALF) = w; }
                ss += __shfl_xor(ss, 16); ss += __shfl_xor(ss, 32);
                SSX[(size_t)row * 32 + u.pn * 4 + wc] = ss; }
        }
    }
};
struct EpiSwiglu {
    static constexpr bool MIDK = false, BIASL = true;
    static constexpr bool PERM = true;
    unsigned char* act; const float* bgu; const LAS float* biasL; unsigned biasA;
    __device__ __forceinline__ void prefetch(const Unit& u, int wid, int lane) const {
        if (wid == 0) glds16(bgu + (size_t)u.e * 4096 + u.pn * 128 + (lane & 31) * 4 + (lane >> 5) * 2048, biasA + (unsigned)(u.ui & 1) * 1024u); }
    __device__ __forceinline__ void operator()(const f32x4 (&acc)[2][2][4][2], const Unit& u, int wr, int wc, int fr, int fq) const {
        const int jl = wc * 32 + 8 * fq;
        const LAS float* bp = biasL + (u.ui & 1) * 256 + jl;
        const f32x4 bg0 = *(const LAS f32x4*)(bp), bg1 = *(const LAS f32x4*)(bp + 4), bl0 = *(const LAS f32x4*)(bp + 128) + 1.0f, bl1 = *(const LAS f32x4*)(bp + 132) + 1.0f;
        unsigned char* obase = act + (size_t)(u.pm * BM + wr * 64 + 16 * (2 * (fq & 1) + (fq >> 1)) + fr) * 2048 + u.pn * 128 + wc * 16;
#pragma unroll
        for (int ai = 0; ai < 2; ++ai) {
            float o[4][8];
#pragma unroll
            for (int m = 0; m < 4; ++m)
#pragma unroll
                for (int n = 0; n < 2; ++n) { const f32x4 ag = acc[ai][0][m][n], al = acc[ai][1][m][n], bg = n ? bg1 : bg0, bl = n ? bl1 : bl0;
#pragma unroll
                    for (int hq = 0; hq < 2; ++hq) {
                        f32x2 g = (f32x2){ag[2 * hq], ag[2 * hq + 1]} + (f32x2){bg[2 * hq], bg[2 * hq + 1]};
                        f32x2 l = (f32x2){al[2 * hq], al[2 * hq + 1]} + (f32x2){bl[2 * hq], bl[2 * hq + 1]};
                        g.x = fminf(g.x, 7.0f); g.y = fminf(g.y, 7.0f);
                        l.x = __builtin_amdgcn_fmed3f(l.x, -6.0f, 8.0f); l.y = __builtin_amdgcn_fmed3f(l.y, -6.0f, 8.0f);
                        const f32x2 z = g * (-1.702f * 1.4426950408889634f);
                        f32x2 e; e.x = __builtin_amdgcn_exp2f(z.x); e.y = __builtin_amdgcn_exp2f(z.y);
                        const f32x2 d = e + 1.0f; f32x2 r; r.x = __builtin_amdgcn_rcpf(d.x); r.y = __builtin_amdgcn_rcpf(d.y);
                        const f32x2 oo = (g * r) * l; o[m][4 * n + 2 * hq] = oo.x; o[m][4 * n + 2 * hq + 1] = oo.y; } }
            v16f va, vb;
#pragma unroll
            for (int j = 0; j < 8; ++j) {
                const auto x0 = __builtin_amdgcn_permlane32_swap(__float_as_uint(o[0][j]), __float_as_uint(o[1][j]), false, false);
                const auto x1 = __builtin_amdgcn_permlane32_swap(__float_as_uint(o[2][j]), __float_as_uint(o[3][j]), false, false);
                const auto px = __builtin_amdgcn_permlane16_swap(x0[0], x1[0], false, false), py = __builtin_amdgcn_permlane16_swap(x0[1], x1[1], false, false);
                va[j] = __uint_as_float(px[0]); va[8 + j] = __uint_as_float(px[1]); vb[j] = __uint_as_float(py[0]); vb[8 + j] = __uint_as_float(py[1]); }
            u32x4 w0, w1; mx6_pack(va, vb, w0, w1);
            *(u32x4*)(obase + (size_t)(ai * HALF) * 2048) = w0; *(u32x4*)(obase + (size_t)(ai * HALF) * 2048 + 64) = w1; }
    }
};
struct EpiDown {
    static constexpr bool MIDK = false, BIASL = true;
    static constexpr bool PERM = true;
    unsigned char* Y; const float* bdn; const LAS unsigned* dstL; const LAS float* biasL; unsigned biasA;
    __device__ __forceinline__ void prefetch(const Unit& u, int wid, int lane) const {
        if (wid == 0) glds16(bdn + (size_t)u.e * 2048 + u.pn * 256 + lane * 4, biasA + (unsigned)(u.ui & 1) * 1024u); }
    __device__ __forceinline__ void operator()(const f32x4 (&acc)[2][2][4][2], const Unit& u, int wr, int wc, int fr, int fq) const {
        const int col0 = u.pn * BM + wc * 64 + 16 * fq;
        const LAS float* bp = biasL + (u.ui & 1) * 256 + wc * 64 + 16 * fq;
        f32x4 bv[2][2];
#pragma unroll
        for (int bj = 0; bj < 2; ++bj)
#pragma unroll
            for (int n = 0; n < 2; ++n) bv[bj][n] = *(const LAS f32x4*)(bp + 8 * bj + 4 * n);
#pragma unroll
        for (int ai = 0; ai < 2; ++ai)
#pragma unroll
            for (int m = 0; m < 4; ++m) { const unsigned dst = dstL[u.ui * 256 + ai * HALF + wr * 64 + m * 16 + fr];
                const f32x4 v00 = acc[ai][0][m][0] + bv[0][0], v01 = acc[ai][0][m][1] + bv[0][1], v10 = acc[ai][1][m][0] + bv[1][0], v11 = acc[ai][1][m][1] + bv[1][1];
                u32x4 w; w.x = pk4_fp8(v00[0], v00[1], v00[2], v00[3]); w.y = pk4_fp8(v01[0], v01[1], v01[2], v01[3]); w.z = pk4_fp8(v10[0], v10[1], v10[2], v10[3]); w.w = pk4_fp8(v11[0], v11[1], v11[2], v11[3]);
                *(u32x4*)(Y + (size_t)dst * 2048 + col0) = w; }
    }
};

template <class Epi, bool GATHER, bool ALIGN_EPI, bool FP8>
__device__ __forceinline__ void gemm_phase(LAS unsigned char* lds, const char* Abase, const char* Bbase, size_t estrideB, int KB, const TileOrder& S, const Epi& E, const LAS unsigned short* tokL) {
    const int tid = threadIdx.x, wid = __builtin_amdgcn_readfirstlane(tid >> 6), lane = tid & 63, wr = wid >> 2, wc = wid & 3, fr = lane & 15, fq = lane >> 4;
    const int nt = KB / 128;
    int Rr[2], Cc[2]; unsigned voffB[2], vA[2][2];
#pragma unroll
    for (int i = 0; i < 2; ++i) { int R, C; stage_rc(tid * 16 + i * 8192, R, C); const int Rb = Epi::PERM ? ((R & ~31) + perm32(R & 31)) : R;
        Rr[i] = R; Cc[i] = C; voffB[i] = (unsigned)(Rb * KB + C * 2); }
    const size_t kstep = (size_t)128;
    const size_t hstep = (size_t)HALF * KB;
    const size_t tstep = 2 * hstep;
    const unsigned ldsw = (unsigned)wid * 1024u;
    const int aoff = lds_byte(wr * 64 + fr, fq * 8), boff = lds_byte(wc * 32 + fr, fq * 8);
#define PG8_SA(b, h) (((b) * 2 + (h)) * HTB)
#define PG8_SB(b, h) ((4 + (b) * 2 + (h)) * HTB)
#define PG8_STAGE(bufoff, gbase, voff) do { _Pragma("unroll") for (int _i = 0; _i < 2; ++_i) \
        __builtin_amdgcn_global_load_lds((const GAS unsigned*)((const char*)(gbase) + (voff)[_i]), (LAS unsigned*)(lds + (bufoff) + ldsw + _i * 8192), 16, 0, 0); } while (0)
#define PG8_LDA(dst, b, h) do { _Pragma("unroll") for (int m = 0; m < 4; ++m) dst[m] = __builtin_shufflevector(*(const LAS v4i*)(lds + PG8_SA(b, h) + aoff + m * 2048), *(const LAS v4i*)(lds + PG8_SA(b, h) + aoff + m * 2048 + 1024), 0, 1, 2, 3, 4, 5, 6, 7); } while (0)
#define PG8_LDB(dst, b, h) do { _Pragma("unroll") for (int n = 0; n < 2; ++n) dst[n] = __builtin_shufflevector(*(const LAS v4i*)(lds + PG8_SB(b, h) + boff + n * 2048), *(const LAS v4i*)(lds + PG8_SB(b, h) + boff + n * 2048 + 1024), 0, 1, 2, 3, 4, 5, 6, 7); } while (0)
#define PG8_MMA(ai, bj, At, Bt) do { __builtin_amdgcn_s_setprio(1); _Pragma("unroll") for (int m = 0; m < 4; ++m) _Pragma("unroll") for (int n = 0; n < 2; ++n) { \
        if constexpr (FP8) acc[ai][bj][m][n] = __builtin_amdgcn_mfma_scale_f32_16x16x128_f8f6f4(Bt[n], At[m], acc[ai][bj][m][n], 2, 2, 0, Bt[n][6], 0, At[m][6])    ; \
        else { acc[ai][bj][m][n] = __builtin_amdgcn_mfma_f32_16x16x32_bf16(lo8(Bt[n]), lo8(At[m]), acc[ai][bj][m][n], 0, 0, 0); acc[ai][bj][m][n] = __builtin_amdgcn_mfma_f32_16x16x32_bf16(hi8(Bt[n]), hi8(At[m]), acc[ai][bj][m][n], 0, 0, 0); } } __builtin_amdgcn_s_setprio(0); } while (0)
#define PG8_WAIT_V(n) asm volatile("s_waitcnt vmcnt(" #n ")" ::: "memory")
#define PG8_WAIT_L(n) asm volatile("s_waitcnt lgkmcnt(" #n ")" ::: "memory")
#define PG8_BAR __builtin_amdgcn_s_barrier()
#define PG8_SCHED __builtin_amdgcn_sched_barrier(0)
#define PG8_SETVA(u) do { _Pragma("unroll") for (int _h = 0; _h < 2; ++_h) _Pragma("unroll") for (int _i = 0; _i < 2; ++_i) { \
        const int _row = GATHER ? (int)tokL[(u).ui * 256 + _h * HALF + Rr[_i]] : (_h * HALF + Rr[_i]); vA[_h][_i] = (unsigned)(_row * KB + Cc[_i] * 2); asm volatile("" : "+v"(vA[_h][_i])); } } while (0)
    Unit cur, nxt; int ui = 0;
    if (!S.next(0, cur)) return;
    f32x4 acc[2][2][4][2];
#pragma unroll
    for (int a = 0; a < 2; ++a)
#pragma unroll
        for (int b = 0; b < 2; ++b)
#pragma unroll
            for (int m = 0; m < 4; ++m)
#pragma unroll
                for (int n = 0; n < 2; ++n) acc[a][b][m][n] = (f32x4){0.f, 0.f, 0.f, 0.f};
    v8i At[4], B0[2], B1[2];
    const char* cA = GATHER ? Abase : Abase + (size_t)cur.pm * tstep;
    const char* cB = Bbase + (size_t)cur.e * estrideB + (size_t)cur.pn * tstep;
    PG8_SETVA(cur);
    if constexpr (Epi::BIASL) E.prefetch(cur, wid, lane);
    PG8_STAGE(PG8_SB(0, 0), cB, voffB); PG8_STAGE(PG8_SB(0, 1), cB + hstep, voffB); PG8_STAGE(PG8_SA(0, 0), cA, vA[0]); PG8_STAGE(PG8_SA(0, 1), cA, vA[1]);
    if (wr == 1) PG8_BAR;
    PG8_WAIT_V(2); PG8_BAR;
    PG8_STAGE(PG8_SB(1, 0), cB + kstep, voffB); PG8_STAGE(PG8_SA(1, 0), cA + kstep, vA[0]); PG8_STAGE(PG8_SB(1, 1), cB + hstep + kstep, voffB);
    PG8_WAIT_V(6); PG8_BAR;
    for (;;) {
        const bool has_next = S.next(ui + 1, nxt);
        const char* nA = has_next ? (GATHER ? Abase : Abase + (size_t)nxt.pm * tstep) : cA;
        const char* nB = has_next ? Bbase + (size_t)nxt.e * estrideB + (size_t)nxt.pn * tstep : cB;
        for (int t = 0; t < nt; t += 2) {
            if constexpr (Epi::MIDK) { if (t == nt / 2) E.mid(acc, cur, wr, fr); }
            const bool last = (t == nt - 2);
            const char* a1 = cA + (size_t)(t + 1) * kstep;
            const char* a2 = last ? nA : cA + (size_t)(t + 2) * kstep; const char* b2 = last ? nB : cB + (size_t)(t + 2) * kstep;
            const char* a3 = a2 + kstep; const char* b3 = b2 + kstep;
            PG8_LDB(B0, 0, 0); PG8_LDB(B1, 0, 1); PG8_SCHED; PG8_LDA(At, 0, 0); PG8_STAGE(PG8_SA(1, 1), a1, vA[1]);
            if (last && has_next) PG8_SETVA(nxt);
            PG8_WAIT_V(8); PG8_WAIT_L(0); PG8_BAR; PG8_MMA(0, 0, At, B0); PG8_MMA(0, 1, At, B1); PG8_BAR; PG8_SCHED;
            PG8_LDA(At, 0, 1); PG8_STAGE(PG8_SB(0, 0), b2, voffB); PG8_STAGE(PG8_SB(0, 1), b2 + hstep, voffB); PG8_STAGE(PG8_SA(0, 0), a2, vA[0]);
            PG8_WAIT_V(8); PG8_WAIT_L(0); PG8_BAR; PG8_MMA(1, 0, At, B0); PG8_MMA(1, 1, At, B1); PG8_BAR; PG8_SCHED;
            PG8_LDB(B0, 1, 0); PG8_LDB(B1, 1, 1); PG8_SCHED; PG8_LDA(At, 1, 0); PG8_STAGE(PG8_SA(0, 1), a2, vA[1]);
            PG8_WAIT_V(8); PG8_WAIT_L(0); PG8_BAR; PG8_MMA(0, 0, At, B0); PG8_MMA(0, 1, At, B1); PG8_BAR; PG8_SCHED;
            PG8_LDA(At, 1, 1); PG8_STAGE(PG8_SB(1, 0), b3, voffB); PG8_STAGE(PG8_SB(1, 1), b3 + hstep, voffB); PG8_STAGE(PG8_SA(1, 0), a3, vA[0]);
            PG8_WAIT_V(8); PG8_WAIT_L(0); PG8_BAR; PG8_MMA(1, 0, At, B0); PG8_MMA(1, 1, At, B1); PG8_BAR; PG8_SCHED;
        }
        if constexpr (ALIGN_EPI) { if (wr == 0) PG8_BAR; }
        E(acc, cur, wr, wc, fr, fq);
        if (!has_next) break;
#pragma unroll
        for (int a = 0; a < 2; ++a)
#pragma unroll
            for (int b = 0; b < 2; ++b)
#pragma unroll
                for (int m = 0; m < 4; ++m)
#pragma unroll
                    for (int n = 0; n < 2; ++n) acc[a][b][m][n] = (f32x4){0.f, 0.f, 0.f, 0.f};
        cur = nxt; cA = nA; cB = nB; ++ui;
        if constexpr (Epi::BIASL) E.prefetch(cur, wid, lane);
        if constexpr (ALIGN_EPI) { if (wr == 1) PG8_BAR; }
    }
    PG8_WAIT_V(0);
    if constexpr (!ALIGN_EPI) { if (wr == 0) PG8_BAR; }
    PG8_BAR;
#undef PG8_SA
#undef PG8_SB
#undef PG8_STAGE
#undef PG8_LDA
#undef PG8_LDB
#undef PG8_MMA
#undef PG8_WAIT_V
#undef PG8_WAIT_L
#undef PG8_BAR
#undef PG8_SCHED
#undef PG8_SETVA
}

struct Frame {
    LAS unsigned char* lds;
    volatile LAS unsigned* MISC;
    gu32* ctl;
    int tid, lane, wave, vcu, G;
    const float *x, *g1, *w_in, *gq, *gk, *rpb, *gsg, *w_sp, *b_sp, *ga, *gs, *w_out, *g2, *w_r, *b_r, *w_gu, *b_gu, *w_dn, *b_dn;
    float* out;
    bf16 *WIN, *WOUT, *WSP, *WRH, *WRL, *H, *PROJ, *MIX, *X2B; unsigned char *WGU, *WDN, *ACT, *H8, *Y;
    float *RSTD2, *GATE, *SSQA, *SSG, *RA, *RB, *SSX, *RMS1, *IG1; unsigned* SLOT; int* LIST;
};

__device__ __forceinline__ void p0_transpose_item(const float* W, int N, int K, bf16* WT, int k0, int n0, int out_row0, int hi_off, const float* kgain, LAS float* scr, int lane) {
    const int l16 = lane & 15, lq = lane >> 4;
#pragma unroll 4
    for (int i = 0; i < 16; ++i) { const int kk = 4 * i + lq; f32x4 v = *(const f32x4*)(W + (size_t)(k0 + kk) * N + n0 + 4 * l16); if (kgain) v = v * kgain[k0 + kk];
        LAS float* d = scr + kk * 65 + 4 * l16; d[0] = v.x; d[1] = v.y; d[2] = v.z; d[3] = v.w; }
    LDS_WAIT(); asm volatile("" ::: "memory");
    const int c = lane >> 3, nn = lane & 7;
#pragma unroll
    for (int j = 0; j < 8; ++j) { const int n = nn + 8 * j; const LAS float* s = scr + (8 * c) * 65 + n;
        u32x4 o; o.x = cvt_pk_bf16(s[0], s[65]); o.y = cvt_pk_bf16(s[2 * 65], s[3 * 65]); o.z = cvt_pk_bf16(s[4 * 65], s[5 * 65]); o.w = cvt_pk_bf16(s[6 * 65], s[7 * 65]);
        *(u32x4*)(WT + (size_t)(out_row0 + n + (n >= 32 ? hi_off : 0)) * K + k0 + 8 * c) = o; }
    LDS_WAIT(); asm volatile("" ::: "memory");
}
__device__ __forceinline__ void p0_transpose_item_fp8(const float* W, int N, int K, unsigned char* WT, int k0, int n0, int out_row0, LAS float* scr, int lane) {
    const int l8 = lane & 7, lr = lane >> 3;
#pragma unroll 4
    for (int i = 0; i < 16; ++i) { const int kk = 8 * i + lr; const f32x4 v = *(const f32x4*)(W + (size_t)(k0 + kk) * N + n0 + 4 * l8);
        LAS float* d = scr + kk * 33 + 4 * l8; d[0] = v.x; d[1] = v.y; d[2] = v.z; d[3] = v.w; }
    LDS_WAIT(); asm volatile("" ::: "memory");
    const int n = lane & 31, kh = lane >> 5; const LAS float* s = scr + (64 * kh) * 33 + n;
#pragma unroll
    for (int c4 = 0; c4 < 4; ++c4) { u32x4 o;
        o.x = pk4_fp8(s[(16 * c4 + 0) * 33] * 64.f, s[(16 * c4 + 1) * 33] * 64.f, s[(16 * c4 + 2) * 33] * 64.f, s[(16 * c4 + 3) * 33] * 64.f);
        o.y = pk4_fp8(s[(16 * c4 + 4) * 33] * 64.f, s[(16 * c4 + 5) * 33] * 64.f, s[(16 * c4 + 6) * 33] * 64.f, s[(16 * c4 + 7) * 33] * 64.f);
        o.z = pk4_fp8(s[(16 * c4 + 8) * 33] * 64.f, s[(16 * c4 + 9) * 33] * 64.f, s[(16 * c4 + 10) * 33] * 64.f, s[(16 * c4 + 11) * 33] * 64.f);
        o.w = pk4_fp8(s[(16 * c4 + 12) * 33] * 64.f, s[(16 * c4 + 13) * 33] * 64.f, s[(16 * c4 + 14) * 33] * 64.f, s[(16 * c4 + 15) * 33] * 64.f);
        *(u32x4*)(WT + (size_t)(out_row0 + n) * K + k0 + 64 * kh + 16 * c4) = o; }
    LDS_WAIT(); asm volatile("" ::: "memory");
}
__device__ __forceinline__ void moe_convert(Frame& F, int j0, int j1) {
    LAS float* img = (LAS float*)F.lds;
    constexpr int T_GU = 16 * 16, T_DN = 16 * 8, NT = NE * (T_GU + T_DN);
    const int w = F.wave, lane = F.lane;
    f32x4 v0[16], v1[16];
#define P0_DECODE(t, W_, N_, WT_, k0_, n0_, isgu_) do { int r_ = (t); if (r_ < NE * T_GU) { const int e_ = r_ / T_GU, q_ = r_ % T_GU; W_ = F.w_gu + (size_t)e_ * DM * 4096; N_ = 4096; WT_ = F.WGU + (size_t)e_ * 4096 * DM; k0_ = 128 * (q_ / 16); n0_ = 256 * (q_ % 16); isgu_ = 1; } \
        else { r_ -= NE * T_GU; const int e_ = r_ / T_DN, q_ = r_ % T_DN; W_ = F.w_dn + (size_t)e_ * DM * DM; N_ = DM; WT_ = F.WDN + (size_t)e_ * DM * DM; k0_ = 128 * (q_ / 8); n0_ = 256 * (q_ % 8); isgu_ = 0; } } while (0)
#define P0_VALID(jj) ((jj) < j1 && F.vcu + (jj) * F.G < NT)
#define P0_LOAD(v_, jj) do { const float* W_ = nullptr; unsigned char* WT_ = nullptr; int N_ = 0, k0_ = 0, n0_ = 0, ig_ = 0; P0_DECODE(F.vcu + (jj) * F.G, W_, N_, WT_, k0_, n0_, ig_); (void)WT_; (void)ig_; \
        _Pragma("unroll") for (int i = 0; i < 16; ++i) v_[i] = __builtin_nontemporal_load((const f32x4*)(W_ + (size_t)(k0_ + 16 * w + i) * N_ + n0_ + 4 * lane)); } while (0)
#define P0_IMG(v_) do { _Pragma("unroll") for (int i = 0; i < 16; ++i) *(LAS f32x4*)(img + (16 * w + i) * 260 + 4 * lane) = v_[i]; } while (0)
#define P0_CONVERT(jj) do { const float* W_ = nullptr; unsigned char* WT = nullptr; int N_ = 0, k0 = 0, n0 = 0, isgu = 0; P0_DECODE(F.vcu + (jj) * F.G, W_, N_, WT, k0, n0, isgu); (void)W_; (void)N_; \
          const int n = 32 * w + (lane & 31), kh = lane >> 5; \
          const int nn = n0 + n; const int ll = nn & 255;                \
          const int jl = nn & 127;                                       \
          const int orow = isgu ? (((nn & 2047) >> 7) * 256 + (nn >> 11) * 128 + jl) : ((nn & ~255) + 128 * ((ll >> 3) & 1) + 32 * (ll >> 6) + 8 * ((ll >> 4) & 3) + (ll & 7)); \
          unsigned char* dst = WT + (size_t)orow * DM + k0 + 32 * kh;    \
          _Pragma("unroll") for (int s2 = 0; s2 < 2; ++s2) { const LAS float* sp = img + (32 * (2 * kh + s2)) * 260 + n; v16f va, vb; \
              _Pragma("unroll") for (int p = 0; p < 16; ++p) { va[p] = sp[p * 260]; vb[p] = sp[(16 + p) * 260]; } \
              u32x4 w0, w1; mx6_pack(va, vb, w0, w1); \
              __builtin_nontemporal_store(w0, (u32x4*)(dst + 16 * s2)); __builtin_nontemporal_store(w1, (u32x4*)(dst + 64 + 16 * s2)); } } while (0)
    if (P0_VALID(j0)) P0_LOAD(v0, j0);
    if (P0_VALID(j0 + 1)) P0_LOAD(v1, j0 + 1);
    for (int j = j0; P0_VALID(j); j += 2) {
        P0_IMG(v0); __syncthreads();
        if (P0_VALID(j + 2)) P0_LOAD(v0, j + 2);
        P0_CONVERT(j); __syncthreads();
        if (!P0_VALID(j + 1)) break;
        P0_IMG(v1); __syncthreads();
        if (P0_VALID(j + 3)) P0_LOAD(v1, j + 3);
        P0_CONVERT(j + 1); __syncthreads();
    }
#undef P0_DECODE
#undef P0_VALID
#undef P0_LOAD
#undef P0_IMG
#undef P0_CONVERT
}
__device__ __forceinline__ void p0_prologue(Frame& F) {
    LAS float* scr = (LAS float*)(F.lds + F.wave * 16896);
    const int gw = F.vcu * NWAVES + F.wave, NGW = F.G * NWAVES, lane = F.lane;
    constexpr int I_IN = 32 * 80, I_OUT = 32 * 32;
    constexpr int NITEMS = I_IN + I_OUT;
    for (int it = gw; it < NITEMS; it += NGW) {
        int r = it;
        if (r < I_IN) { const int kb = r / 80, nb = r % 80; p0_transpose_item(F.w_in, NPROJ, DM, F.WIN, 64 * kb, 64 * nb, (nb >> 2) * 256 + (nb & 3) * 32, 96, nullptr, scr, lane); continue; } r -= I_IN;
        { const int kb = r / 32, nb = r % 32; p0_transpose_item(F.w_out, DM, DM, F.WOUT, 64 * kb, 64 * nb, 64 * nb, 0, kb < 16 ? F.ga : F.gs - 1024, scr, lane); }
    }
    {
        f32x4 g1v[8];
#pragma unroll
        for (int j = 0; j < 4; ++j) { g1v[2 * j] = *(const f32x4*)(F.g1 + 8 * lane + 512 * j); g1v[2 * j + 1] = *(const f32x4*)(F.g1 + 8 * lane + 512 * j + 4); }
        for (int m = gw; m < NTOK; m += 2 * NGW) {
            const int m2 = m + NGW; const bool has2 = m2 < NTOK;
            const float* xr = F.x + (size_t)m * DM + 8 * lane; const float* xr2 = F.x + (size_t)(has2 ? m2 : m) * DM + 8 * lane;
            f32x4 v[8], u[8]; float s = 0.f, s2 = 0.f;
#pragma unroll
            for (int j = 0; j < 4; ++j) { v[2 * j] = __builtin_nontemporal_load((const f32x4*)(xr + 512 * j)); v[2 * j + 1] = __builtin_nontemporal_load((const f32x4*)(xr + 512 * j + 4)); u[2 * j] = __builtin_nontemporal_load((const f32x4*)(xr2 + 512 * j)); u[2 * j + 1] = __builtin_nontemporal_load((const f32x4*)(xr2 + 512 * j + 4)); }
#pragma unroll
            for (int j = 0; j < 8; ++j) { s += (v[j].x * v[j].x + v[j].y * v[j].y) + (v[j].z * v[j].z + v[j].w * v[j].w); s2 += (u[j].x * u[j].x + u[j].y * u[j].y) + (u[j].z * u[j].z + u[j].w * u[j].w); }
            const float rm = sqrtf(wave_sum(s) * (1.0f / DM) + EPS), rm2 = sqrtf(wave_sum(s2) * (1.0f / DM) + EPS); const float rs = 1.0f / rm, rs2 = 1.0f / rm2;
            if (lane == 0) { F.RMS1[m] = rm; if (has2) F.RMS1[m2] = rm2; }
#pragma unroll
            for (int j = 0; j < 4; ++j) { const f32x4 a = v[2 * j] * rs * g1v[2 * j], b = v[2 * j + 1] * rs * g1v[2 * j + 1]; u32x4 o; o.x = cvt_pk_bf16(a.x, a.y); o.y = cvt_pk_bf16(a.z, a.w); o.z = cvt_pk_bf16(b.x, b.y); o.w = cvt_pk_bf16(b.z, b.w);
                *(u32x4*)(F.H + (size_t)m * DM + 8 * lane + 512 * j) = o; }
            if (has2) {
#pragma unroll
                for (int j = 0; j < 4; ++j) { const f32x4 a = u[2 * j] * rs2 * g1v[2 * j], b = u[2 * j + 1] * rs2 * g1v[2 * j + 1]; u32x4 o; o.x = cvt_pk_bf16(a.x, a.y); o.y = cvt_pk_bf16(a.z, a.w); o.z = cvt_pk_bf16(b.x, b.y); o.w = cvt_pk_bf16(b.z, b.w);
                    *(u32x4*)(F.H + (size_t)m2 * DM + 8 * lane + 512 * j) = o; } }
        }
    }
    const int gt = F.vcu * 512 + F.tid, NGT = F.G * 512;
    for (int i = gt; i < DM; i += NGT) F.IG1[i] = 1.0f / F.g1[i];
    for (int i = gt; i < 16 * 128 * 128; i += NGT) { const float v = F.w_sp[i]; F.WSP[i] = (bf16)(cvt_pk_bf16(v, 0.f) & 0xffffu); }
    for (int i = gt; i < NE * DM; i += NGT) { const int e = i / DM, d = i % DM; const float v = F.w_r[(size_t)d * NE + e]; const unsigned hi = cvt_pk_bf16(v, 0.f) & 0xffffu; const float lo = v - __uint_as_float(hi << 16);
        F.WRH[i] = (bf16)hi; F.WRL[i] = (bf16)(cvt_pk_bf16(lo, 0.f) & 0xffffu); }
}

typedef short v4i16_t __attribute__((ext_vector_type(4)));
__device__ __forceinline__ s16x4 tr_read(const LAS unsigned char* p) { return __builtin_bit_cast(s16x4, __builtin_amdgcn_ds_read_tr16_b64_v4i16((LAS v4i16_t*)p)); }
__device__ __forceinline__ void attn_unit(Frame& F, int b, int h, int band) {
    constexpr int SLOT = 16384;
    LAS unsigned char* ring = F.lds;
    LAS float* rpbL = (LAS float*)(F.lds + AT_RPB);
    LAS unsigned* mrg = (LAS unsigned*)(F.lds + AT_MRG);
    const int tid = F.tid, lane = F.lane, w = F.wave, fr = lane & 15, quad = lane >> 4;
    const int cg = w & 3, hf8 = w >> 2;
    const int c0 = 16 * cg, w0 = (cg == 0) ? 0 : (cg == 1) ? 8 : (cg == 2) ? 24 : 32;
    const int qc = c0 + fr; const int cs = min(max(qc - 8, 0), 48);
    const int R0 = band * 16;
    __syncthreads();
    for (int i = tid; i < 480; i += 512) { const int ro = i >> 5, co = i & 31; rpbL[i] = co < 31 ? F.rpb[h * 465 + ro * 31 + co] * 1.4426950408889634f : -INFINITY; }
    int cooff[2][4];
#pragma unroll
    for (int hf = 0; hf < 2; ++hf)
#pragma unroll
        for (int i = 0; i < 4; ++i) { const int kc = w0 + 16 * hf + 4 * quad + i; const bool valid = (kc >= cs) && (kc < cs + 16); cooff[hf][i] = 4 * (valid ? kc - qc + 15 : 31); }
    const char* projb = (const char*)F.PROJ + (size_t)b * SEQ * NPROJ * 2; const unsigned ringb = (unsigned)(size_t)ring;
    const unsigned lane_src = (unsigned)((8 * w + (lane >> 3)) * NPROJ + 1024 + h * 64) * 2u + (unsigned)(((lane & 7) ^ (lane >> 3)) * 16);
#define ROW_DMA(rowabs) do { const char* src_ = projb + (size_t)(rowabs) * 64 * NPROJ * 2 + lane_src; const unsigned sb_ = ringb + (unsigned)(((rowabs) % 9) * SLOT + w * 1024); \
        glds16(src_, sb_); glds16(src_ + 2048, sb_ + 8192u); } while (0)
    const int rs0 = min(max(R0 - 4, 0), 120);
    for (int j = 0; j < 8; ++j) ROW_DMA(rs0 + j);
    int loaded_hi = rs0 + 7;
    const bf16* qbase = F.PROJ + ((size_t)b * SEQ + qc) * NPROJ + h * 64 + 8 * quad;
    bf16x8 qa = *(const bf16x8*)(qbase + (size_t)R0 * 64 * NPROJ), qb = *(const bf16x8*)(qbase + (size_t)R0 * 64 * NPROJ + 32);
    VM_WAIT(); __syncthreads();
    for (int step = 0; step < 16; ++step) {
        const int r = R0 + step, rs = min(max(r - 4, 0), 120);
        bf16x8 qf0 = qa, qf1 = qb;
        if (step < 15) { const int nh = min(max(r - 3, 0), 120) + 7; if (nh > loaded_hi) { ROW_DMA(nh); loaded_hi = nh; }
            qa = *(const bf16x8*)(qbase + (size_t)(r + 1) * 64 * NPROJ); qb = *(const bf16x8*)(qbase + (size_t)(r + 1) * 64 * NPROJ + 32); }
        f32x4 s[4][2];
#pragma unroll
        for (int kr = 0; kr < 4; ++kr) { const int sb = ((rs + 4 * hf8 + kr) % 9) * SLOT;
#pragma unroll
            for (int hf = 0; hf < 2; ++hf) { const int key = w0 + 16 * hf + fr;
                const bf16x8 a0 = *(const LAS bf16x8*)(ring + sb + key * 128 + ((quad ^ (key & 7)) << 4));
                const bf16x8 a1 = *(const LAS bf16x8*)(ring + sb + key * 128 + (((quad + 4) ^ (key & 7)) << 4));
                f32x4 z = {0.f, 0.f, 0.f, 0.f};
                z = __builtin_amdgcn_mfma_f32_16x16x32_bf16(a0, qf0, z, 0, 0, 0);
                z = __builtin_amdgcn_mfma_f32_16x16x32_bf16(a1, qf1, z, 0, 0, 0);
                s[kr][hf] = z; } }
        float mx = -INFINITY;
        { const LAS unsigned char* bb = (const LAS unsigned char*)rpbL + (rs + 4 * hf8 - r + 7) * 128;
#pragma unroll
            for (int kr = 0; kr < 4; ++kr)
#pragma unroll
                for (int hf = 0; hf < 2; ++hf)
#pragma unroll
                    for (int i = 0; i < 4; ++i) { const float v = s[kr][hf][i] + *(const LAS float*)(bb + kr * 128 + cooff[hf][i]); s[kr][hf][i] = v; mx = fmaxf(mx, v); } }
        mx = fmaxf(mx, __shfl_xor(mx, 16)); mx = fmaxf(mx, __shfl_xor(mx, 32));
        float lsum = 0.f; bf16x8 pf[4];
#pragma unroll
        for (int kr = 0; kr < 4; ++kr) { float p[8];
#pragma unroll
            for (int i = 0; i < 8; ++i) { p[i] = __builtin_amdgcn_exp2f(s[kr][i >> 2][i & 3] - mx); lsum += p[i]; }
            u32x4 pk; pk.x = cvt_pk_bf16(p[0], p[1]); pk.y = cvt_pk_bf16(p[2], p[3]); pk.z = cvt_pk_bf16(p[4], p[5]); pk.w = cvt_pk_bf16(p[6], p[7]); pf[kr] = __builtin_bit_cast(bf16x8, pk); }
        lsum += __shfl_xor(lsum, 16); lsum += __shfl_xor(lsum, 32);
        f32x4 o[4];
#pragma unroll
        for (int dt = 0; dt < 4; ++dt) o[dt] = (f32x4){0.f, 0.f, 0.f, 0.f};
#pragma unroll
        for (int kr = 0; kr < 4; ++kr) { const int sb = ((rs + 4 * hf8 + kr) % 9) * SLOT + 8192; const int key = w0 + 4 * quad + (fr >> 2), pp = fr & 3;
#pragma unroll
            for (int dt = 0; dt < 4; ++dt) { const int c = 2 * dt + (pp >> 1); const int ad = sb + key * 128 + ((c ^ (key & 7)) << 4) + 8 * (pp & 1);
                const s16x4 lo = tr_read(ring + ad), hi = tr_read(ring + ad + 16 * 128);
                const bf16x8 vf = __builtin_shufflevector(lo, hi, 0, 1, 2, 3, 4, 5, 6, 7);
                o[dt] = __builtin_amdgcn_mfma_f32_16x16x32_bf16(vf, pf[kr], o[dt], 0, 0, 0); } }
        if (w >= 4) { LAS unsigned* m = mrg + (w - 4) * 640 + lane; m[0] = __float_as_uint(mx); m[64] = __float_as_uint(lsum);
#pragma unroll
            for (int dt = 0; dt < 4; ++dt) { m[(2 + 2 * dt) * 64] = cvt_pk_bf16(o[dt][0], o[dt][1]); m[(3 + 2 * dt) * 64] = cvt_pk_bf16(o[dt][2], o[dt][3]); } }
        __syncthreads();
        if (w < 4) { const LAS unsigned* m = mrg + w * 640 + lane; const float mx2 = __uint_as_float(m[0]), l2 = __uint_as_float(m[64]);
            const float mm = fmaxf(mx, mx2), a1 = __builtin_amdgcn_exp2f(mx - mm), a2 = __builtin_amdgcn_exp2f(mx2 - mm); const float inv = 1.0f / (lsum * a1 + l2 * a2);
            const float f1 = a1 * inv, f2 = a2 * inv; float ssq = 0.f;
            bf16* op = F.MIX + ((size_t)b * SEQ + (size_t)r * 64 + qc) * DM + h * 64 + 4 * quad;
            u32x2 pk[4];
#pragma unroll
            for (int dt = 0; dt < 4; ++dt) { const unsigned u0 = m[(2 + 2 * dt) * 64], u1 = m[(3 + 2 * dt) * 64];
                const float v0 = o[dt][0] * f1 + bflo(u0) * f2, v1 = o[dt][1] * f1 + bfhi(u0) * f2, v2 = o[dt][2] * f1 + bflo(u1) * f2, v3 = o[dt][3] * f1 + bfhi(u1) * f2;
                ssq += (v0 * v0 + v1 * v1) + (v2 * v2 + v3 * v3);
                pk[dt].x = cvt_pk_bf16(v0, v1); pk[dt].y = cvt_pk_bf16(v2, v3); }
            ssq += __shfl_xor(ssq, 16); ssq += __shfl_xor(ssq, 32);
            VM_WAIT();
#pragma unroll
            for (int dp = 0; dp < 2; ++dp) *(u32x4*)(op + 32 * dp + ((quad & 1) ? 12 : 0)) = pair16(pk[2 * dp], pk[2 * dp + 1]);
            if (quad == 0) F.SSQA[((size_t)b * SEQ + (size_t)r * 64 + qc) * 16 + h] = ssq; }
        else VM_WAIT();
        __syncthreads();
    }
#undef ROW_DMA
}

__device__ __forceinline__ void sgu_unit(Frame& F, int unit) {
    LAS unsigned char* Gn = F.lds;
    LAS float* rsG = (LAS float*)(F.lds + 16384);
    const int tid = F.tid, lane = F.lane, w = F.wave, fr = lane & 15, quad = lane >> 4;
    const size_t tk0 = (size_t)unit * 128;
    __syncthreads();
    if (tid < 128) { const f32x4* sp = (const f32x4*)(F.SSG + (tk0 + tid) * 16); const f32x4 a = sp[0], b2 = sp[1], c = sp[2], d = sp[3];
        const float ss = ((a.x + a.y) + (a.z + a.w)) + ((b2.x + b2.y) + (b2.z + b2.w)) + ((c.x + c.y) + (c.z + c.w)) + ((d.x + d.y) + (d.z + d.w)); rsG[tid] = 1.0f / sqrtf(ss * (1.0f / 1024.0f) + EPS); }
    else if (tid < 256) { const int q = tid - 128; const f32x4* sp = (const f32x4*)(F.SSQA + (tk0 + q) * 16); const f32x4 a = sp[0], b2 = sp[1], c = sp[2], d = sp[3];
        const float ss = ((a.x + a.y) + (a.z + a.w)) + ((b2.x + b2.y) + (b2.z + b2.w)) + ((c.x + c.y) + (c.z + c.w)) + ((d.x + d.y) + (d.z + d.w)); F.RA[tk0 + q] = 1.0f / sqrtf(ss * (1.0f / 1024.0f) + EPS); }
    float ssq = 0.f; const int p = 16 * w + fr;
    const bf16* gsrc0 = F.PROJ + (tk0 + (tid >> 3)) * NPROJ + 4096 + (tid & 7) * 8;
    const bf16* usrc = F.PROJ + (tk0 + p) * NPROJ + 3072 + 4 * quad;
    const bf16* wsrc = F.WSP + (size_t)p * 128 + 8 * quad;
    u32x4 gv0 = *(const u32x4*)(gsrc0), gv1 = *(const u32x4*)(gsrc0 + (size_t)64 * NPROJ);
    u32x2 uv[4]; bf16x8 wv[4];
#pragma unroll
    for (int dt = 0; dt < 4; ++dt) { uv[dt] = *(const u32x2*)(usrc + 16 * dt); wv[dt] = *(const bf16x8*)(wsrc + 32 * dt); }
    for (int gi = 0; gi < 16; ++gi) {
        __syncthreads();
#pragma unroll
        for (int j = 0; j < 2; ++j) { const int q = (tid >> 3) + 64 * j, c = tid & 7; const u32x4 v = j ? gv1 : gv0; const float rr = rsG[q];
            const f32x4 ga = *(const f32x4*)(F.gsg + gi * 64 + c * 8), gb = *(const f32x4*)(F.gsg + gi * 64 + c * 8 + 4);
            u32x4 o; o.x = cvt_pk_bf16(bflo(v.x) * rr * ga.x, bfhi(v.x) * rr * ga.y); o.y = cvt_pk_bf16(bflo(v.y) * rr * ga.z, bfhi(v.y) * rr * ga.w);
            o.z = cvt_pk_bf16(bflo(v.z) * rr * gb.x, bfhi(v.z) * rr * gb.y); o.w = cvt_pk_bf16(bflo(v.w) * rr * gb.z, bfhi(v.w) * rr * gb.w);
            *(LAS u32x4*)(Gn + q * 128 + ((c ^ (q & 7)) << 4)) = o; }
        u32x2 uc[4]; bf16x8 wf[4];
#pragma unroll
        for (int dt = 0; dt < 4; ++dt) { uc[dt] = uv[dt]; wf[dt] = wv[dt]; }
        if (gi < 15) { gv0 = *(const u32x4*)(gsrc0 + (gi + 1) * 64); gv1 = *(const u32x4*)(gsrc0 + (size_t)64 * NPROJ + (gi + 1) * 64);
#pragma unroll
            for (int dt = 0; dt < 4; ++dt) { uv[dt] = *(const u32x2*)(usrc + (gi + 1) * 64 + 16 * dt); wv[dt] = *(const bf16x8*)(wsrc + (size_t)(gi + 1) * 16384 + 32 * dt); } }
        __syncthreads();
        f32x4 acc[4];
#pragma unroll
        for (int dt = 0; dt < 4; ++dt) acc[dt] = (f32x4){0.f, 0.f, 0.f, 0.f};
#pragma unroll
        for (int ks = 0; ks < 4; ++ks) { const int rowA = 32 * ks + 8 * quad + (fr >> 2), rowB = rowA + 4; const int pp = fr & 3;
#pragma unroll
            for (int dt = 0; dt < 4; ++dt) { const int c = 2 * dt + (pp >> 1);
                const s16x4 lo = tr_read(Gn + rowA * 128 + ((c ^ (rowA & 7)) << 4) + 8 * (pp & 1)), hi = tr_read(Gn + rowB * 128 + ((c ^ (rowB & 7)) << 4) + 8 * (pp & 1));
                const bf16x8 af = __builtin_shufflevector(lo, hi, 0, 1, 2, 3, 4, 5, 6, 7);
                acc[dt] = __builtin_amdgcn_mfma_f32_16x16x32_bf16(af, wf[ks], acc[dt], 0, 0, 0); } }
        const float bs = F.b_sp[gi * 128 + p];
        u32x2 pk[4];
#pragma unroll
        for (int dt = 0; dt < 4; ++dt) { const u32x2 uu = uc[dt];
            const float s0 = bflo(uu.x) * (acc[dt][0] + bs), s1 = bfhi(uu.x) * (acc[dt][1] + bs), s2 = bflo(uu.y) * (acc[dt][2] + bs), s3 = bfhi(uu.y) * (acc[dt][3] + bs);
            ssq += (s0 * s0 + s1 * s1) + (s2 * s2 + s3 * s3);
            pk[dt].x = cvt_pk_bf16(s0, s1); pk[dt].y = cvt_pk_bf16(s2, s3); }
#pragma unroll
        for (int dp = 0; dp < 2; ++dp) *(u32x4*)(F.MIX + (tk0 + p) * DM + 1024 + gi * 64 + 32 * dp + 4 * quad + ((quad & 1) ? 12 : 0)) = pair16(pk[2 * dp], pk[2 * dp + 1]);
    }
    ssq += __shfl_xor(ssq, 16); ssq += __shfl_xor(ssq, 32);
    if (quad == 0) F.RB[tk0 + p] = 1.0f / sqrtf(ssq * (1.0f / 1024.0f) + EPS);
}

__device__ __forceinline__ void router_unit(Frame& F, int unit) {
    constexpr int WROW = 544, WBUF = 64 * WROW;
    LAS unsigned char* wimg = F.lds;
    LAS float* lgL = (LAS float*)(F.lds + 2 * WBUF);
    LAS unsigned* histL = (LAS unsigned*)(F.lds + 2 * WBUF + 16896); LAS unsigned* baseL = histL + 32;
    const int tid = F.tid, lane = F.lane, w = F.wave, fr = lane & 15, quad = lane >> 4;
    const int token = unit * 128 + 16 * w + fr;
    __syncthreads();
    if (tid < 32) histL[tid] = 0u;
    const bf16* xrow = F.X2B + (size_t)token * DM + 32 * quad;
    unsigned char* trow = F.H8 + (size_t)token * DM + 16 * quad;
    f32x4 acc[2]; acc[0] = (f32x4){0.f, 0.f, 0.f, 0.f}; acc[1] = acc[0];
    float rstd;
    { const f32x4 p0 = *(const f32x4*)(F.SSX + (size_t)token * 32 + 8 * quad), p1 = *(const f32x4*)(F.SSX + (size_t)token * 32 + 8 * quad + 4);
      float ss = ((p0.x + p0.y) + (p0.z + p0.w)) + ((p1.x + p1.y) + (p1.z + p1.w)); ss += __shfl_xor(ss, 16); ss += __shfl_xor(ss, 32); rstd = 1.0f / sqrtf(ss * (1.0f / DM) + EPS); }
    u32x4 wst[4];
#define RT_WLOAD(c) do { _Pragma("unroll") for (int j = 0; j < 4; ++j) { const int id = j * 512 + tid, row = id >> 5, cc = id & 31; \
        wst[j] = *(const u32x4*)((row < 32 ? F.WRH + (size_t)row * DM : F.WRL + (size_t)(row - 32) * DM) + 256 * (c) + 8 * cc); } } while (0)
#define RT_WSTORE(b) do { _Pragma("unroll") for (int j = 0; j < 4; ++j) { const int id = j * 512 + tid, row = id >> 5, cc = id & 31; *(LAS u32x4*)(wimg + (b) * WBUF + row * WROW + (((cc >> 2) & 3) + 4 * (cc & 3) + 16 * (cc >> 4)) * 16) = wst[j]; } } while (0)
    RT_WLOAD(0); RT_WSTORE(0);
    __syncthreads();
    for (int c = 0; c < 8; ++c) {
        if (c < 7) RT_WLOAD(c + 1);
        const LAS unsigned char* wb = wimg + (c & 1) * WBUF + fr * WROW + quad * 16;
        for (int s2 = 0; s2 < 2; ++s2) { const int ss = 2 * c + s2;
            v16f va, vb;
#pragma unroll
            for (int j4 = 0; j4 < 4; ++j4) { const int kl = 4 * s2 + j4;
                const u32x4 xr = *(const u32x4*)(xrow + 128 * ss + 8 * j4); const f32x4 xa = {bflo(xr.x), bfhi(xr.x), bflo(xr.y), bfhi(xr.y)}, xb = {bflo(xr.z), bfhi(xr.z), bflo(xr.w), bfhi(xr.w)};
                const f32x4 ga = *(const f32x4*)(F.g2 + 128 * ss + 32 * quad + 8 * j4), gb = *(const f32x4*)(F.g2 + 128 * ss + 32 * quad + 8 * j4 + 4);
                const f32x4 ya = xa * ga * rstd, yb = xb * gb * rstd;
                u32x4 h; h.x = cvt_pk_bf16(ya.x, ya.y); h.y = cvt_pk_bf16(ya.z, ya.w); h.z = cvt_pk_bf16(yb.x, yb.y); h.w = cvt_pk_bf16(yb.z, yb.w);
                u32x4 l; l.x = cvt_pk_bf16(ya.x - bflo(h.x), ya.y - bfhi(h.x)); l.y = cvt_pk_bf16(ya.z - bflo(h.y), ya.w - bfhi(h.y)); l.z = cvt_pk_bf16(yb.x - bflo(h.z), yb.y - bfhi(h.z)); l.w = cvt_pk_bf16(yb.z - bflo(h.w), yb.w - bfhi(h.w));
                if (j4 < 2) { va[8 * j4 + 0] = ya.x; va[8 * j4 + 1] = ya.y; va[8 * j4 + 2] = ya.z; va[8 * j4 + 3] = ya.w; va[8 * j4 + 4] = yb.x; va[8 * j4 + 5] = yb.y; va[8 * j4 + 6] = yb.z; va[8 * j4 + 7] = yb.w; }
                else { vb[8 * j4 - 16] = ya.x; vb[8 * j4 - 15] = ya.y; vb[8 * j4 - 14] = ya.z; vb[8 * j4 - 13] = ya.w; vb[8 * j4 - 12] = yb.x; vb[8 * j4 - 11] = yb.y; vb[8 * j4 - 10] = yb.z; vb[8 * j4 - 9] = yb.w; }
                const bf16x8 yh = __builtin_bit_cast(bf16x8, h), yl = __builtin_bit_cast(bf16x8, l);
#pragma unroll
                for (int et = 0; et < 2; ++et) {
                    const bf16x8 wh = *(const LAS bf16x8*)(wb + (16 * et) * WROW + kl * 64), wl = *(const LAS bf16x8*)(wb + (32 + 16 * et) * WROW + kl * 64);
                    acc[et] = __builtin_amdgcn_mfma_f32_16x16x32_bf16(wh, yh, acc[et], 0, 0, 0);
                    acc[et] = __builtin_amdgcn_mfma_f32_16x16x32_bf16(wh, yl, acc[et], 0, 0, 0);
                    acc[et] = __builtin_amdgcn_mfma_f32_16x16x32_bf16(wl, yh, acc[et], 0, 0, 0); } }
            u32x4 w0, w1; mx6_pack(va, vb, w0, w1);
            *(u32x4*)(trow + 128 * ss) = w0; *(u32x4*)(trow + 128 * ss + 64) = w1;
        }
        if (c < 7) RT_WSTORE((c + 1) & 1);
        __syncthreads();
    }
#undef RT_WLOAD
#undef RT_WSTORE
#pragma unroll
    for (int et = 0; et < 2; ++et)
#pragma unroll
        for (int i = 0; i < 4; ++i) { const int e = 16 * et + 4 * quad + i; lgL[(w * 16 + fr) * 33 + e] = acc[et][i] + F.b_r[e]; }
    __syncthreads();
    int ev[4]; float gv[4]; unsigned lp[4];
    const int mytok = unit * 128 + 16 * w + lane;
    if (lane < 16) {
        const LAS float* lg = lgL + (w * 16 + lane) * 33; unsigned mask = 0u; float vv[4];
#pragma unroll
        for (int k = 0; k < 4; ++k) { float best = -INFINITY; int bi = 0;
            for (int e = 0; e < 32; ++e) { const float v = lg[e]; if (!((mask >> e) & 1u) && v > best) { best = v; bi = e; } }
            mask |= 1u << bi; ev[k] = bi; vv[k] = best; }
        const float e1 = __expf(vv[1] - vv[0]), e2 = __expf(vv[2] - vv[0]), e3 = __expf(vv[3] - vv[0]); const float inv = 1.0f / (1.0f + e1 + e2 + e3);
        gv[0] = inv; gv[1] = e1 * inv; gv[2] = e2 * inv; gv[3] = e3 * inv;
#pragma unroll
        for (int k = 0; k < 4; ++k) lp[k] = __hip_atomic_fetch_add(histL + ev[k], 1u, __ATOMIC_RELAXED, __HIP_MEMORY_SCOPE_WORKGROUP);
    }
    __syncthreads();
    if (tid < 32) baseL[tid] = __hip_atomic_fetch_add((unsigned*)(F.ctl + CW_CNT + 64 * tid), histL[tid], RLX_AGENT);
    __syncthreads();
    if (lane < 16) {
#pragma unroll
        for (int k = 0; k < 4; ++k) { const unsigned pos = baseL[ev[k]] + lp[k];
            F.LIST[(size_t)ev[k] * CAP + pos] = mytok * 4 + k; F.GATE[(size_t)mytok * 4 + k] = gv[k]; }
    }
}

__device__ __forceinline__ int moe_tables(Frame& F) {
    LAS int* cntL = (LAS int*)(F.lds + XT_CNT); LAS int* tstartL = (LAS int*)(F.lds + XT_TSTART); LAS unsigned char* tileE = F.lds + XT_TILEE;
    __syncthreads();
    if (F.tid < 32) cntL[F.tid] = (int)__hip_atomic_load((unsigned*)(F.ctl + CW_CNT + 64 * F.tid), RLX_AGENT);
    __syncthreads();
    if (F.tid == 0) { int s = 0; for (int e = 0; e < 32; ++e) { tstartL[e] = s; s += (cntL[e] + 255) >> 8; } tstartL[32] = s; }
    __syncthreads();
    const int total = tstartL[32];
    for (int mt = F.tid; mt < total; mt += 512) { int e = 0; for (int k = 1; k < 32; ++k) e += (tstartL[k] <= mt) ? 1 : 0; tileE[mt] = (unsigned char)e; }
    __syncthreads();
    return __builtin_amdgcn_readfirstlane(total);
}

struct Args { const float* in[19]; float* out; unsigned char* ws; int ph_lo, ph_hi; };
__global__ void __launch_bounds__(NWAVES * 64, 2) mk_fwd(Args args) {
    extern __shared__ __attribute__((aligned(16))) unsigned char lds[];
    Frame F;
    F.lds = (LAS unsigned char*)lds;
    F.MISC = (volatile LAS unsigned*)(F.lds + MISC_OFF);
    F.tid = threadIdx.x; F.lane = F.tid & 63; F.wave = __builtin_amdgcn_readfirstlane(F.tid >> 6);
    F.G = gridDim.x; { const int bx = blockIdx.x; F.vcu = (F.G % 8 == 0) ? (bx % 8) * (F.G / 8) + bx / 8 : bx; }
    unsigned char* ws = args.ws;
    F.ctl = (gu32*)(ws + WS_CTL);
    F.x = args.in[0]; F.g1 = args.in[1]; F.w_in = args.in[2]; F.gq = args.in[3]; F.gk = args.in[4]; F.rpb = args.in[5]; F.gsg = args.in[6]; F.w_sp = args.in[7]; F.b_sp = args.in[8];
    F.ga = args.in[9]; F.gs = args.in[10]; F.w_out = args.in[11]; F.g2 = args.in[12]; F.w_r = args.in[13]; F.b_r = args.in[14]; F.w_gu = args.in[15]; F.b_gu = args.in[16]; F.w_dn = args.in[17]; F.b_dn = args.in[18];
    F.out = args.out;
    F.WIN = (bf16*)(ws + WS_WIN); F.WOUT = (bf16*)(ws + WS_WOUT); F.WSP = (bf16*)(ws + WS_WSP); F.WRH = (bf16*)(ws + WS_WRH); F.WRL = (bf16*)(ws + WS_WRL);
    F.WGU = ws + WS_WGU; F.WDN = ws + WS_WDN; F.H = (bf16*)(ws + WS_H); F.H8 = ws + WS_H; F.PROJ = (bf16*)(ws + WS_PROJ); F.X2B = (bf16*)(ws + WS_PROJ);     F.MIX = (bf16*)(ws + WS_MIX);
    F.ACT = ws + WS_ACT; F.Y = ws + WS_Y; F.RMS1 = (float*)(ws + WS_RMS1); F.IG1 = (float*)(ws + WS_IG1); F.SSX = (float*)(ws + WS_SSX); F.RA = (float*)(ws + WS_RA); F.RB = (float*)(ws + WS_RB); F.SSQA = (float*)(ws + WS_SSQA); F.SSG = (float*)(ws + WS_SSG); F.RSTD2 = (float*)(ws + WS_RSTD2); F.GATE = (float*)(ws + WS_GATE); F.SLOT = (unsigned*)(ws + WS_SLOT); F.LIST = (int*)(ws + WS_LIST);
    for (int u = F.tid; u < (LDS_BYTES - LDSCTL_OFF) / 4; u += NWAVES * 64) ((LAS unsigned*)(F.lds + LDSCTL_OFF))[u] = 0u;
    __syncthreads();
    XcdBarrier bar; bar.bar = (unsigned*)(F.ctl + CW_BAR); bar.x = 0; bar.st = nullptr;
    if (N_LAUNCHES == 1) bar = xcd_barrier_post((unsigned*)(F.ctl + CW_BAR), F.MISC + 8);
#define GRID_BAR() do { if (N_LAUNCHES == 1) xcd_barrier(bar); } while (0)
    const int lo = args.ph_lo, hi = args.ph_hi;
#define IN(k) (lo <= (k) && (k) < hi)
#define BOTH(k) (IN(k) && IN((k) + 1))

    if (IN(0)) { p0_prologue(F); if (BOTH(0)) GRID_BAR(); }

    if (IN(1)) {
        TileOrder S; S.init(NTOK / BM, NPROJ / BM, F.G, (int)blockIdx.x, nullptr);
        EpiProjX E{F.PROJ, F.gq, F.gk, F.SSG};
        const int grp = F.vcu & 1, nconv = (NE * (16 * 16 + 16 * 8) - F.vcu + F.G - 1) / F.G, hconv = nconv / 2;
        moe_convert(F, 0, grp == 0 ? hconv : 0);
        S.ib = 0; S.ie = 5;
        gemm_phase<EpiProjX, false, true, false>(F.lds, (const char*)F.H, (const char*)F.WIN, 0, DM * 2, S, E, nullptr);
        moe_convert(F, grp == 0 ? hconv : 0, grp == 0 ? nconv : hconv);
        S.ib = 5; S.ie = 0x7fffffff;
        gemm_phase<EpiProjX, false, true, false>(F.lds, (const char*)F.H, (const char*)F.WIN, 0, DM * 2, S, E, nullptr);
        moe_convert(F, grp == 0 ? nconv : hconv, nconv);
        if (BOTH(1)) GRID_BAR();
    }

    if (IN(2)) {
        for (int u = F.vcu; u < NBATCH * 16 * 8; u += F.G) attn_unit(F, u >> 7, (u >> 3) & 15, u & 7);
        if (BOTH(2)) GRID_BAR();
    }

    if (IN(3)) {
        for (int u = F.vcu; u < NTOK / 128; u += F.G) sgu_unit(F, u);
        if (BOTH(3)) GRID_BAR();
    }

    if (IN(4)) {
        TileOrder S; S.init(NTOK / BM, DM / BM, F.G, (int)blockIdx.x, nullptr);
        EpiResid E{F.H, F.RMS1, F.IG1, F.X2B, DM, F.RA, F.RB, F.SSX};
        gemm_phase<EpiResid, false, true, false>(F.lds, (const char*)F.MIX, (const char*)F.WOUT, 0, DM * 2, S, E, nullptr);
        if (BOTH(4)) GRID_BAR();
    }

    if (IN(5)) {
        for (int u = F.vcu; u < NTOK / 128; u += F.G) router_unit(F, u);
        if (BOTH(5)) GRID_BAR();
    }

    if (IN(6)) {
        const int total = moe_tables(F);
        LAS unsigned short* tokL = (LAS unsigned short*)(F.lds + XT_TOKL); const LAS int* cntL = (const LAS int*)(F.lds + XT_CNT); const LAS int* tstartL = (const LAS int*)(F.lds + XT_TSTART);
        TileOrder S; S.init(total, 16, F.G, (int)blockIdx.x, F.lds + XT_TILEE);
        { Unit u; for (int i = 0; i < 36 && S.next(i, u); ++i) { if (F.tid < 256) { const int lp = (u.pm - tstartL[u.e]) * 256 + F.tid; tokL[i * 256 + F.tid] = (unsigned short)(lp < cntL[u.e] ? (F.LIST[(size_t)u.e * CAP + lp] >> 2) : 0); } } }
        __syncthreads();
        EpiSwiglu E{F.ACT, F.b_gu, (const LAS float*)(F.lds + XT_BIAS), (unsigned)(size_t)(F.lds + XT_BIAS)};
        gemm_phase<EpiSwiglu, true, true, true>(F.lds, (const char*)F.H8, (const char*)F.WGU, (size_t)4096 * DM, DM, S, E, tokL);
        if (BOTH(6)) GRID_BAR();
    }

    if (IN(7)) {
        const int total = moe_tables(F);
        LAS unsigned* dstL = (LAS unsigned*)(F.lds + XT_TOKL); const LAS int* cntL = (const LAS int*)(F.lds + XT_CNT); const LAS int* tstartL = (const LAS int*)(F.lds + XT_TSTART);
        TileOrder S; S.init(total, 8, F.G, (int)blockIdx.x, F.lds + XT_TILEE);
        { Unit u; for (int i = 0; i < 18 && S.next(i, u); ++i) { if (F.tid < 256) { const int lp = (u.pm - tstartL[u.e]) * 256 + F.tid; dstL[i * 256 + F.tid] = lp < cntL[u.e] ? (unsigned)F.LIST[(size_t)u.e * CAP + lp] : (unsigned)(NTOK * TOPK); } } }
        __syncthreads();
        EpiDown E{F.Y, F.b_dn, dstL, (const LAS float*)(F.lds + XT_BIAS), (unsigned)(size_t)(F.lds + XT_BIAS)};
        gemm_phase<EpiDown, false, true, true>(F.lds, (const char*)F.ACT, (const char*)F.WDN, (size_t)DM * DM, DM, S, E, nullptr);
        if (BOTH(7)) GRID_BAR();
    }

    if (IN(8)) {
        const int gw = F.vcu * NWAVES + F.wave, NGW = F.G * NWAVES, lane = F.lane;
        for (int t = gw; t < NTOK; t += NGW) {
            const f32x4 gt = *(const f32x4*)(F.GATE + (size_t)t * 4);
            float* orow = F.out + (size_t)t * DM + 16 * lane; const unsigned char* yrow = F.Y + (size_t)t * 4 * DM + 16 * lane; const bf16* xrow = F.X2B + (size_t)t * DM + 16 * lane;
#pragma unroll
            for (int j = 0; j < 2; ++j) { f32x4 o[4];
                const u32x4 xlo = *(const u32x4*)(xrow + 1024 * j), xhi = *(const u32x4*)(xrow + 1024 * j + 8);
                o[0] = (f32x4){bflo(xlo.x), bfhi(xlo.x), bflo(xlo.y), bfhi(xlo.y)}; o[1] = (f32x4){bflo(xlo.z), bfhi(xlo.z), bflo(xlo.w), bfhi(xlo.w)};
                o[2] = (f32x4){bflo(xhi.x), bfhi(xhi.x), bflo(xhi.y), bfhi(xhi.y)}; o[3] = (f32x4){bflo(xhi.z), bfhi(xhi.z), bflo(xhi.w), bfhi(xhi.w)};
#pragma unroll
                for (int k = 0; k < 4; ++k) { const u32x4 y = *(const u32x4*)(yrow + (size_t)k * DM + 1024 * j); const float g = gt[k];
#pragma unroll
                    for (int q = 0; q < 4; ++q) { const f32x2 lo = __builtin_amdgcn_cvt_pk_f32_fp8((int)y[q], false), hi = __builtin_amdgcn_cvt_pk_f32_fp8((int)y[q], true);
                        o[q].x += g * lo.x; o[q].y += g * lo.y; o[q].z += g * hi.x; o[q].w += g * hi.y; } }
#pragma unroll
                for (int q = 0; q < 4; ++q) *(f32x4*)(orow + 1024 * j + 4 * q) = o[q]; }
        }
    }
#undef IN
#undef BOTH
}

extern "C" void kernel_launch(void* const* d_in, const int* in_sizes, int n_in, void* d_out, int out_size, void* d_ws, size_t ws_size, hipStream_t stream) {
    static int grid = 0;
    if (grid == 0) {
        if (n_in != 19 || out_size != NTOK * DM || ws_size < WS_END) { fprintf(stderr, "kernel_launch: unexpected problem (n_in %d, out %d, ws %zu)\n", n_in, out_size, ws_size); grid = -1; return; }
        int dev = 0, cus = 0, per_cu = 0;
        if (hipGetDevice(&dev) != hipSuccess || hipDeviceGetAttribute(&cus, hipDeviceAttributeMultiprocessorCount, dev) != hipSuccess) { grid = -1; return; }
        if (hipFuncSetAttribute((const void*)mk_fwd, hipFuncAttributeMaxDynamicSharedMemorySize, LDS_BYTES) != hipSuccess) { fprintf(stderr, "kernel_launch: hipFuncSetAttribute failed\n"); grid = -1; return; }
        if (hipOccupancyMaxActiveBlocksPerMultiprocessor(&per_cu, (const void*)mk_fwd, NWAVES * 64, LDS_BYTES) != hipSuccess || per_cu < 1) { fprintf(stderr, "kernel_launch: occupancy query says %d\n", per_cu); }
        (void)hipGetLastError();
        grid = cus;
    }
    if (grid < 0) return;
    if (hipMemsetAsync((char*)d_ws + WS_CTL, 0, CTL_ZERO_BYTES, stream) != hipSuccess) return;
    Args a{};
    for (int i = 0; i < 19; ++i) a.in[i] = (const float*)d_in[i];
    a.out = (float*)d_out; a.ws = (unsigned char*)d_ws;
    for (int li = 0; li < N_LAUNCHES; ++li) {
        a.ph_lo = (N_LAUNCHES == 1) ? 0 : li; a.ph_hi = (N_LAUNCHES == 1) ? N_PHASES : li + 1;
        hipLaunchKernelGGL(mk_fwd, dim3(grid), dim3(NWAVES * 64), LDS_BYTES, stream, a);
    }
}
```

```cpp
#include <hip/hip_runtime.h>
#include <cstdio>
#include <cstdint>

#ifndef MK_N_LAUNCHES
#define MK_N_LAUNCHES 1
#endif
constexpr int N_LAUNCHES = MK_N_LAUNCHES;
constexpr int N_PHASES = 9;

#define LAS __attribute__((address_space(3)))
#define GAS __attribute__((address_space(1)))
typedef unsigned short bf16;
typedef short bf16x8 __attribute__((ext_vector_type(8)));
typedef short s16x4 __attribute__((ext_vector_type(4)));
typedef float f32x4 __attribute__((ext_vector_type(4)));
typedef float f32x2 __attribute__((ext_vector_type(2)));
typedef unsigned u32x4 __attribute__((ext_vector_type(4)));
typedef unsigned u32x2 __attribute__((ext_vector_type(2)));
typedef GAS unsigned gu32;
typedef int v8i __attribute__((ext_vector_type(8)));
typedef int v4i __attribute__((ext_vector_type(4)));
typedef int v6i __attribute__((ext_vector_type(6)));
typedef float v16f __attribute__((ext_vector_type(16)));

constexpr int NTOK = 32768, DM = 2048, NPROJ = 5120, SEQ = 8192, NBATCH = 4;
constexpr int NE = 32, TOPK = 4, CAP = 32768;
constexpr int MAXROWS = NTOK * TOPK + NE * 256;
constexpr float EPS = 1e-6f;
constexpr int NWAVES = 8;

constexpr size_t MiB = 1u << 20;
constexpr size_t WS_CTL = 0, CTL_ZERO_BYTES = 1 * MiB;
constexpr size_t WS_WIN = 2 * MiB;
constexpr size_t WS_WOUT = 22 * MiB;
constexpr size_t WS_WSP = 30 * MiB;
constexpr size_t WS_WRH = 31 * MiB;
constexpr size_t WS_WRL = 31 * MiB + 128 * 1024;
constexpr size_t WS_RSTD2 = 31 * MiB + 512 * 1024;
constexpr size_t WS_SLOT = 32 * MiB;
constexpr size_t WS_GATE = 32 * MiB + 512 * 1024;
constexpr size_t WS_LIST = 33 * MiB;
constexpr size_t WS_WGU = 40 * MiB;
constexpr size_t WS_SSQA = 300 * MiB;
constexpr size_t WS_SSG = 304 * MiB;
constexpr size_t WS_RA = 308 * MiB;
constexpr size_t WS_RB = 309 * MiB;
constexpr size_t WS_SSX = 312 * MiB;
constexpr size_t WS_RMS1 = 310 * MiB;
constexpr size_t WS_IG1 = 311 * MiB;
constexpr size_t WS_WDN = 552 * MiB;
constexpr size_t WS_H = 808 * MiB;
constexpr size_t WS_PROJ = 936 * MiB;
constexpr size_t WS_MIX = 1256 * MiB;
constexpr size_t WS_ACT = 1384 * MiB;
constexpr size_t WS_Y = 1928 * MiB;
constexpr size_t WS_END = 2472 * MiB;

constexpr int CW_TMO = 0, CW_CODE = 1;
constexpr int CW_BAR = 4096;
constexpr int CW_CNT = 8192;

constexpr int RING_BYTES = 131072;
constexpr int XT_OFF = RING_BYTES;
constexpr int XT_TOKL = XT_OFF;
constexpr int XT_TILEE = XT_OFF + 18432;
constexpr int XT_TSTART = XT_TILEE + 576;
constexpr int XT_CNT = XT_TSTART + 160;
constexpr int XT_BIAS = XT_OFF + 19456;
constexpr int XT_GAINS = XT_BIAS + 2048;
constexpr int XT_MISC2 = XT_GAINS + 512;
constexpr int AT_RPB = 147456;
constexpr int AT_MRG = AT_RPB + 2048;
constexpr int LDSCTL_OFF = AT_MRG + 10240;
constexpr int MISC_OFF = LDSCTL_OFF + 320;
constexpr int LDS_BYTES = LDSCTL_OFF + 1024;
static_assert(XT_CNT + 128 <= XT_BIAS && XT_MISC2 <= LDSCTL_OFF && LDS_BYTES <= 160 * 1024, "LDS map");
constexpr int N_PH = 9;

#define RLX_AGENT __ATOMIC_RELAXED, __HIP_MEMORY_SCOPE_AGENT
#define LDS_WAIT() asm volatile("s_waitcnt lgkmcnt(0)" ::: "memory")
#define VM_WAIT() asm volatile("s_waitcnt vmcnt(0)" ::: "memory")

__device__ __forceinline__ unsigned cvt_pk_bf16(float lo, float hi) { unsigned r; asm volatile("v_cvt_pk_bf16_f32 %0, %1, %2" : "=v"(r) : "v"(lo), "v"(hi)); return r; }
__device__ __forceinline__ unsigned pk4_fp8(float a, float b, float c, float d) { int w = 0; w = __builtin_amdgcn_cvt_pk_fp8_f32(a, b, w, false); w = __builtin_amdgcn_cvt_pk_fp8_f32(c, d, w, true); return (unsigned)w; }
__device__ __forceinline__ v8i cat8(bf16x8 a, bf16x8 b) { const v4i x = __builtin_bit_cast(v4i, a), y = __builtin_bit_cast(v4i, b); return __builtin_shufflevector(x, y, 0, 1, 2, 3, 4, 5, 6, 7); }
__device__ __forceinline__ bf16x8 lo8(v8i a) { return __builtin_bit_cast(bf16x8, (v4i)__builtin_shufflevector(a, a, 0, 1, 2, 3)); }
__device__ __forceinline__ bf16x8 hi8(v8i a) { return __builtin_bit_cast(bf16x8, (v4i)__builtin_shufflevector(a, a, 4, 5, 6, 7)); }
__device__ __forceinline__ void glds16(const void* gsrc, unsigned lds_dst) { unsigned keep;
    asm volatile("s_mov_b32 %0, m0\n\ts_mov_b32 m0, %2\n\ts_nop 0\n\tglobal_load_lds_dwordx4 %1, off\n\ts_mov_b32 m0, %0" : "=&s"(keep) : "v"(gsrc), "s"(lds_dst) : "memory"); }
__device__ __forceinline__ u32x4 pair16(u32x2 a, u32x2 b) { const auto s0 = __builtin_amdgcn_permlane16_swap(a.x, b.x, false, false), s1 = __builtin_amdgcn_permlane16_swap(a.y, b.y, false, false);
    u32x4 w; w.x = s0[0]; w.y = s1[0]; w.z = s0[1]; w.w = s1[1]; return w; }
__device__ __forceinline__ void mx6_pack(v16f a, v16f b, u32x4& w0, u32x4& w1) {
    float m0 = 0.f, m1 = 0.f;
#pragma unroll
    for (int i = 0; i < 16; ++i) { m0 = fmaxf(m0, fabsf(a[i])); m1 = fmaxf(m1, fabsf(b[i])); }
    const float mx = fmaxf(m0, m1);
    int sb = (int)(((__float_as_uint(mx) + 0x00100000u) >> 23) & 0xffu) - 2;
    sb = sb < 2 ? 2 : (sb > 250 ? 250 : sb);
    const float inv = __uint_as_float((unsigned)(254 - sb) << 23);
    a = a * inv; b = b * inv;
    v6i r; asm volatile("v_cvt_scalef32_2xpk16_fp6_f32 %0, %1, %2, 1.0" : "=&v"(r) : "v"(a), "v"(b));
    w0.x = (unsigned)r[0]; w0.y = (unsigned)r[1]; w0.z = (unsigned)r[2]; w0.w = (unsigned)r[3];
    w1.x = (unsigned)r[4]; w1.y = (unsigned)r[5]; w1.z = (unsigned)sb; w1.w = 0u;
}
__device__ __forceinline__ float bflo(unsigned u) { return __uint_as_float(u << 16); }
__device__ __forceinline__ float bfhi(unsigned u) { return __uint_as_float(u & 0xffff0000u); }
__device__ __forceinline__ float wave_sum(float v) {
#pragma unroll
    for (int o = 1; o < 64; o <<= 1) v += __shfl_xor(v, o);
    return v;
}
__device__ __forceinline__ f32x2 gelu_pk(f32x2 v) {
    const f32x2 av = __builtin_elementwise_abs(v), d = av * 0.2316418882f + 1.0f;
    f32x2 t; t.x = __builtin_amdgcn_rcpf(d.x); t.y = __builtin_amdgcn_rcpf(d.y);
    f32x2 q = t * 0.5307027145f + (-0.7265760135f); q = q * t + 0.7107068705f; q = q * t + (-0.142248368f); q = q * t + 0.127414796f; q = q * t;
    const f32x2 s = (v * v) * (-0.72134752044f);
    f32x2 e; e.x = __builtin_amdgcn_exp2f(s.x); e.y = __builtin_amdgcn_exp2f(s.y);
    const f32x2 m = v * (q * e), r = v - m;
    f32x2 o; o.x = v.x < 0.f ? m.x : r.x; o.y = v.y < 0.f ? m.y : r.y; return o;
}
__device__ __forceinline__ float gelu1(float x) { f32x2 r = gelu_pk((f32x2){x, x}); return r.x; }

#define XB_TMO      128
#define XB_XCNT(j)  (256  + 64 * (j))
#define XB_XSUB(j)  (1280 + 64 * (j))
#define XB_XGEN(j)  (2304 + 64 * (j))
#define XB_TOP      3328
#define XB_TOPGEN   3392
#define XCD_BAR_WORDS 3456
#define XB_SPIN_CAP (1u << 18)
__device__ __forceinline__ unsigned xb_ld(unsigned* p)              { return __hip_atomic_load(p, __ATOMIC_RELAXED, __HIP_MEMORY_SCOPE_AGENT); }
__device__ __forceinline__ unsigned xb_add(unsigned* p, unsigned v) { return __hip_atomic_fetch_add(p, v, __ATOMIC_RELAXED, __HIP_MEMORY_SCOPE_AGENT); }
__device__ __forceinline__ unsigned xb_xcc_id() { return (unsigned)__builtin_amdgcn_s_getreg((3 << 11) | 20) & 0xFu; }
#define XB_SPIN(cond, bar) do { unsigned _sp = 0; while (cond) { __builtin_amdgcn_s_sleep(1); \
    if ((++_sp & 255u) == 0u) { if (xb_ld(&(bar)[XB_TMO])) break; if (_sp > XB_SPIN_CAP) { atomicAdd(&(bar)[XB_TMO], 1u); break; } } } } while (0)
struct XcdBarrier { unsigned* bar; unsigned x; volatile LAS unsigned* st; };
__device__ __forceinline__ XcdBarrier xcd_barrier_post(unsigned* bar, volatile LAS unsigned* st) {
    XcdBarrier b; b.bar = bar; b.x = xb_xcc_id(); b.st = st;
    if (threadIdx.x == 0) (void)xb_add(&bar[XB_XCNT(b.x)], 1u);
    return b;
}
__device__ __forceinline__ void xcd_barrier_complete(unsigned* bar, unsigned x, unsigned& nloc, unsigned& nx) {
    const unsigned G = gridDim.x * gridDim.y * gridDim.z;
    unsigned sum, cnt, mine, sp = 0u;
    for (;;) {
        sum = 0u; cnt = 0u; mine = 0u;
#pragma unroll
        for (unsigned j = 0; j < 16; ++j) { const unsigned c = xb_ld(&bar[XB_XCNT(j)]); sum += c; cnt += (c > 0u) ? 1u : 0u; mine = (j == x) ? c : mine; }
        if (sum == G) break;
        __builtin_amdgcn_s_sleep(1);
        if ((++sp & 255u) == 0u) { if (xb_ld(&bar[XB_TMO])) break; if (sp > XB_SPIN_CAP) { atomicAdd(&bar[XB_TMO], 1u); break; } }
    }
    nloc = mine > 0u ? mine : 1u; nx = cnt > 0u ? cnt : 1u;
}
__device__ __forceinline__ void xcd_barrier(const XcdBarrier& b) {
    asm volatile("s_waitcnt vmcnt(0)" ::: "memory");
    __syncthreads();
    if (threadIdx.x == 0) {
        unsigned* bar = b.bar;
        __builtin_amdgcn_s_waitcnt(0);
        unsigned nloc = b.st[0], nx = b.st[1];
        if (nloc == 0u) { xcd_barrier_complete(bar, b.x, nloc, nx); b.st[0] = nloc; b.st[1] = nx; }
        const unsigned old = xb_add(&bar[XB_XSUB(b.x)], 1u);
        const unsigned gen = old / nloc;
        if (old + 1u == (gen + 1u) * nloc) {
            __builtin_amdgcn_fence(__ATOMIC_RELEASE, "agent");
            asm volatile("s_waitcnt vmcnt(0)" ::: "memory");
            const unsigned og = xb_add(&bar[XB_TOP], 1u);
            const unsigned tg = og / nx;
            if (og + 1u == (tg + 1u) * nx) xb_add(&bar[XB_TOPGEN], 1u);
            else XB_SPIN(xb_ld(&bar[XB_TOPGEN]) == tg, bar);
            __builtin_amdgcn_fence(__ATOMIC_ACQUIRE, "agent");
            xb_add(&bar[XB_XGEN(b.x)], 1u);
            asm volatile("s_waitcnt vmcnt(0)" ::: "memory");
        } else {
            XB_SPIN(xb_ld(&bar[XB_XGEN(b.x)]) == gen, bar);
            __builtin_amdgcn_fence(__ATOMIC_ACQUIRE, "agent");
            asm volatile("s_waitcnt vmcnt(0)" ::: "memory");
        }
    }
    __syncthreads();
}

constexpr int BM = 256, BK = 64, HALF = 128, HTB = HALF * BK * 2, NXCD = 8, WGM = 8;
__host__ __device__ __forceinline__ int lds_byte(int r, int c) { const int st = (r >> 4) * 2 + (c >> 5), rr = r & 15, cc = c & 31, ob = rr * 64 + cc * 2; return st * 1024 + (ob ^ (((ob >> 9) & 1) << 5)); }
__host__ __device__ __forceinline__ void stage_rc(int b, int& R, int& C) { const int st = b / 1024, sb = b % 1024, swz = sb ^ (((sb >> 9) & 1) << 5); R = (st >> 1) * 16 + swz / 64; C = (st & 1) * 32 + (swz % 64) / 2; }
__host__ __device__ __forceinline__ int perm32(int rho) { const int n = rho >> 4, i = rho & 15; return 8 * (i >> 2) + 4 * n + (i & 3); }

struct Unit { int pm, pn, e, ui; };
struct TileOrder {
    int nM, nN, nwg, G, c, ib, ie; const LAS unsigned char* tileE;
    __device__ __forceinline__ void init(int nM_, int nN_, int G_, int c_, const LAS unsigned char* te) { nM = nM_; nN = nN_; nwg = nM * nN; G = G_; c = c_; tileE = te; ib = 0; ie = 0x7fffffff; }
    __device__ __forceinline__ bool next(int i_, Unit& u) const {
        const int i = ib + i_; if (i >= ie) return false;
        const long L = (long)i * G + c; if (L >= nwg) return false;
        int wgid = (int)L; { const int q = nwg / NXCD, r = nwg % NXCD, xcd = wgid % NXCD, off = wgid / NXCD; wgid = (xcd < r ? xcd * (q + 1) : r * (q + 1) + (xcd - r) * q) + off; }
        const int nig = WGM * nN, gid = wgid / nig, fm = gid * WGM, gsz = (nM - fm) < WGM ? (nM - fm) : WGM;
        u.pm = fm + ((wgid % nig) % gsz); u.pn = (wgid % nig) / gsz; u.ui = i;
        u.e = tileE ? __builtin_amdgcn_readfirstlane((int)tileE[u.pm]) : 0;
        return true;
    }
};

struct EpiProjX {
    static constexpr bool MIDK = false, BIASL = false;
    static constexpr bool PERM = true;
    bf16* O; const float* gq; const float* gk; float* SSG;
    __device__ __forceinline__ void operator()(const f32x4 (&acc)[2][2][4][2], const Unit& u, int wr, int wc, int fr, int fq) const {
        const int row0 = u.pm * BM + wr * 64 + fr, col0 = u.pn * BM + wc * 64 + 8 * fq, kind = u.pn >> 2;
        if (kind <= 1) {
            const float* gp = (kind == 0 ? gq : gk) + 8 * fq; const float qs = kind == 0 ? 0.125f * 1.4426950408889634f : 1.0f;
            const f32x4 g00 = *(const f32x4*)(gp), g01 = *(const f32x4*)(gp + 4), g10 = *(const f32x4*)(gp + 32), g11 = *(const f32x4*)(gp + 36);
#pragma unroll
            for (int ai = 0; ai < 2; ++ai)
#pragma unroll
                for (int m = 0; m < 4; ++m) { const f32x4 a = acc[ai][0][m][0], b = acc[ai][0][m][1], c = acc[ai][1][m][0], d = acc[ai][1][m][1];
                    float ss = (a.x * a.x + a.y * a.y) + (a.z * a.z + a.w * a.w) + (b.x * b.x + b.y * b.y) + (b.z * b.z + b.w * b.w) + (c.x * c.x + c.y * c.y) + (c.z * c.z + c.w * c.w) + (d.x * d.x + d.y * d.y) + (d.z * d.z + d.w * d.w);
                    ss += __shfl_xor(ss, 16); ss += __shfl_xor(ss, 32);
                    const float r = qs / sqrtf(ss * (1.0f / 64.0f) + EPS);
                    const f32x4 oa = a * r * g00, ob = b * r * g01, oc = c * r * g10, od = d * r * g11;
                    bf16* rowp = O + (size_t)(row0 + ai * HALF + m * 16) * NPROJ + col0;
                    u32x4 w0, w1; w0.x = cvt_pk_bf16(oa.x, oa.y); w0.y = cvt_pk_bf16(oa.z, oa.w); w0.z = cvt_pk_bf16(ob.x, ob.y); w0.w = cvt_pk_bf16(ob.z, ob.w);
                    w1.x = cvt_pk_bf16(oc.x, oc.y); w1.y = cvt_pk_bf16(oc.z, oc.w); w1.z = cvt_pk_bf16(od.x, od.y); w1.w = cvt_pk_bf16(od.z, od.w);
                    *(u32x4*)(rowp) = w0; *(u32x4*)(rowp + 32) = w1; }
        } else if (kind == 2) {
#pragma unroll
            for (int ai = 0; ai < 2; ++ai)
#pragma unroll
                for (int m = 0; m < 4; ++m) { bf16* rowp = O + (size_t)(row0 + ai * HALF + m * 16) * NPROJ + col0;
#pragma unroll
                    for (int bj = 0; bj < 2; ++bj) { const f32x4 v0 = acc[ai][bj][m][0], v1 = acc[ai][bj][m][1];
                        u32x4 w; w.x = cvt_pk_bf16(v0[0], v0[1]); w.y = cvt_pk_bf16(v0[2], v0[3]); w.z = cvt_pk_bf16(v1[0], v1[1]); w.w = cvt_pk_bf16(v1[2], v1[3]);
                        *(u32x4*)(rowp + bj * 32) = w; } }
        } else {
#pragma unroll
            for (int ai = 0; ai < 2; ++ai)
#pragma unroll
                for (int m = 0; m < 4; ++m) { const int row = row0 + ai * HALF + m * 16; bf16* rowp = O + (size_t)row * NPROJ + col0; float ss = 0.f;
#pragma unroll
                    for (int bj = 0; bj < 2; ++bj) { const f32x4 v0 = acc[ai][bj][m][0], v1 = acc[ai][bj][m][1];
                        const f32x2 a = gelu_pk((f32x2){v0[0], v0[1]}), b = gelu_pk((f32x2){v0[2], v0[3]}), c = gelu_pk((f32x2){v1[0], v1[1]}), d = gelu_pk((f32x2){v1[2], v1[3]});
                        ss += (a.x * a.x + a.y * a.y) + (b.x * b.x + b.y * b.y) + (c.x * c.x + c.y * c.y) + (d.x * d.x + d.y * d.y);
                        u32x4 w; w.x = cvt_pk_bf16(a.x, a.y); w.y = cvt_pk_bf16(b.x, b.y); w.z = cvt_pk_bf16(c.x, c.y); w.w = cvt_pk_bf16(d.x, d.y);
                        *(u32x4*)(rowp + bj * 32) = w; }
                    if (kind == 4) { ss += __shfl_xor(ss, 16); ss += __shfl_xor(ss, 32); if (fq == 0) SSG[(size_t)row * 16 + (u.pn - 16) * 4 + wc] = ss; } }
        }
    }
};
struct EpiResid {
    static constexpr bool PERM = true, MIDK = true, BIASL = false;
    const bf16* hb; const float* rms1; const float* ig1; bf16* x2b; int ldc; const float* RA; const float* RB; float* SSX;
    __device__ __forceinline__ void mid(f32x4 (&acc)[2][2][4][2], const Unit& u, int wr, int fr) const {
        const int row0 = u.pm * BM + wr * 64 + fr;
#pragma unroll
        for (int ai = 0; ai < 2; ++ai)
#pragma unroll
            for (int m = 0; m < 4; ++m) { int row = row0 + ai * HALF + m * 16; asm volatile("" : "+v"(row));
                const float f = RA[row] / RB[row];
#pragma unroll
                for (int bj = 0; bj < 2; ++bj)
#pragma unroll
                    for (int n = 0; n < 2; ++n) acc[ai][bj][m][n] = acc[ai][bj][m][n] * f; }
    }
    __device__ __forceinline__ void operator()(const f32x4 (&acc)[2][2][4][2], const Unit& u, int wr, int wc, int fr, int fq) const {
        const int row0 = u.pm * BM + wr * 64 + fr, col0 = u.pn * BM + wc * 32 + 8 * fq;
        f32x4 ig[2][2];
#pragma unroll
        for (int bj = 0; bj < 2; ++bj)
#pragma unroll
            for (int n = 0; n < 2; ++n) ig[bj][n] = *(const f32x4*)(ig1 + col0 + bj * HALF + 4 * n);
#pragma unroll
        for (int ai = 0; ai < 2; ++ai) {
            u32x4 hv[4][2]; float rb[4], rm[4];
#pragma unroll
            for (int m = 0; m < 4; ++m) { const int row = row0 + ai * HALF + m * 16; const size_t off = (size_t)row * ldc + col0; rb[m] = RB[row]; rm[m] = rms1[row];
#pragma unroll
                for (int bj = 0; bj < 2; ++bj) hv[m][bj] = *(const u32x4*)(hb + off + bj * HALF); }
#pragma unroll
            for (int m = 0; m < 4; ++m) { const int row = row0 + ai * HALF + m * 16; const size_t off = (size_t)row * ldc + col0;
                float ss = 0.f;
#pragma unroll
                for (int bj = 0; bj < 2; ++bj) { const u32x4 h = hv[m][bj];
                    const f32x4 x0 = (f32x4){bflo(h.x), bfhi(h.x), bflo(h.y), bfhi(h.y)} * ig[bj][0] * rm[m], x1 = (f32x4){bflo(h.z), bfhi(h.z), bflo(h.w), bfhi(h.w)} * ig[bj][1] * rm[m];
                    const f32x4 o0 = x0 + acc[ai][bj][m][0] * rb[m], o1 = x1 + acc[ai][bj][m][1] * rb[m];
                    ss += (o0.x * o0.x + o0.y * o0.y) + (o0.z * o0.z + o0.w * o0.w) + (o1.x * o1.x + o1.y * o1.y) + (o1.z * o1.z + o1.w * o1.w);
                    u32x4 w; w.x = cvt_pk_bf16(o0.x, o0.y); w.y = cvt_pk_bf16(o0.z, o0.w); w.z = cvt_pk_bf16(o1.x, o1.y); w.w = cvt_pk_bf16(o1.z, o1.w);
                    *(u32x4*)(x2b + off + bj * HALF) = w; }
                ss += __shfl_xor(ss, 16); ss += __shfl_xor(ss, 32);
                SSX[(size_t)row * 32 + u.pn * 4 + wc] = ss; }
        }
    }
};
struct EpiSwiglu {
    static constexpr bool MIDK = false, BIASL = true;
    static constexpr bool PERM = true;
    unsigned char* act; const float* bgu; const LAS float* biasL; unsigned biasA;
    __device__ __forceinline__ void prefetch(const Unit& u, int wid, int lane) const {
        if (wid == 0) glds16(bgu + (size_t)u.e * 4096 + u.pn * 128 + (lane & 31) * 4 + (lane >> 5) * 2048, biasA + (unsigned)(u.ui & 1) * 1024u); }
    __device__ __forceinline__ void operator()(const f32x4 (&acc)[2][2][4][2], const Unit& u, int wr, int wc, int fr, int fq) const {
        const int jl = wc * 32 + 8 * fq;
        const LAS float* bp = biasL + (u.ui & 1) * 256 + jl;
        const f32x4 bg0 = *(const LAS f32x4*)(bp), bg1 = *(const LAS f32x4*)(bp + 4), bl0 = *(const LAS f32x4*)(bp + 128) + 1.0f, bl1 = *(const LAS f32x4*)(bp + 132) + 1.0f;
        unsigned char* obase = act + (size_t)(u.pm * BM + wr * 64 + 16 * (2 * (fq & 1) + (fq >> 1)) + fr) * 2048 + u.pn * 128 + wc * 16;
#pragma unroll
        for (int ai = 0; ai < 2; ++ai) {
            float o[4][8];
#pragma unroll
            for (int m = 0; m < 4; ++m)
#pragma unroll
                for (int n = 0; n < 2; ++n) { const f32x4 ag = acc[ai][0][m][n], al = acc[ai][1][m][n], bg = n ? bg1 : bg0, bl = n ? bl1 : bl0;
#pragma unroll
                    for (int hq = 0; hq < 2; ++hq) {
                        f32x2 g = (f32x2){ag[2 * hq], ag[2 * hq + 1]} + (f32x2){bg[2 * hq], bg[2 * hq + 1]};
                        f32x2 l = (f32x2){al[2 * hq], al[2 * hq + 1]} + (f32x2){bl[2 * hq], bl[2 * hq + 1]};
                        g.x = fminf(g.x, 7.0f); g.y = fminf(g.y, 7.0f);
                        l.x = __builtin_amdgcn_fmed3f(l.x, -6.0f, 8.0f); l.y = __builtin_amdgcn_fmed3f(l.y, -6.0f, 8.0f);
                        const f32x2 z = g * (-1.702f * 1.4426950408889634f);
                        f32x2 e; e.x = __builtin_amdgcn_exp2f(z.x); e.y = __builtin_amdgcn_exp2f(z.y);
                        const f32x2 d = e + 1.0f; f32x2 r; r.x = __builtin_amdgcn_rcpf(d.x); r.y = __builtin_amdgcn_rcpf(d.y);
                        const f32x2 oo = (g * r) * l; o[m][4 * n + 2 * hq] = oo.x; o[m][4 * n + 2 * hq + 1] = oo.y; } }
            v16f va, vb;
#pragma unroll
            for (int j = 0; j < 8; ++j) {
                const auto x0 = __builtin_amdgcn_permlane32_swap(__float_as_uint(o[0][j]), __float_as_uint(o[1][j]), false, false);
                const auto x1 = __builtin_amdgcn_permlane32_swap(__float_as_uint(o[2][j]), __float_as_uint(o[3][j]), false, false);
                const auto px = __builtin_amdgcn_permlane16_swap(x0[0], x1[0], false, false), py = __builtin_amdgcn_permlane16_swap(x0[1], x1[1], false, false);
                va[j] = __uint_as_float(px[0]); va[8 + j] = __uint_as_float(px[1]); vb[j] = __uint_as_float(py[0]); vb[8 + j] = __uint_as_float(py[1]); }
            u32x4 w0, w1; mx6_pack(va, vb, w0, w1);
            *(u32x4*)(obase + (size_t)(ai * HALF) * 2048) = w0; *(u32x4*)(obase + (size_t)(ai * HALF) * 2048 + 64) = w1; }
    }
};
struct EpiDown {
    static constexpr bool MIDK = false, BIASL = true;
    static constexpr bool PERM = true;
    unsigned char* Y; const float* bdn; const LAS unsigned* dstL; const LAS float* biasL; unsigned biasA;
    __device__ __forceinline__ void prefetch(const Unit& u, int wid, int lane) const {
        if (wid == 0) glds16(bdn + (size_t)u.e * 2048 + u.pn * 256 + lane * 4, biasA + (unsigned)(u.ui & 1) * 1024u); }
    __device__ __forceinline__ void operator()(const f32x4 (&acc)[2][2][4][2], const Unit& u, int wr, int wc, int fr, int fq) const {
        const int col0 = u.pn * BM + wc * 64 + 16 * fq;
        const LAS float* bp = biasL + (u.ui & 1) * 256 + wc * 64 + 16 * fq;
        f32x4 bv[2][2];
#pragma unroll
        for (int bj = 0; bj < 2; ++bj)
#pragma unroll
            for (int n = 0; n < 2; ++n) bv[bj][n] = *(const LAS f32x4*)(bp + 8 * bj + 4 * n);
#pragma unroll
        for (int ai = 0; ai < 2; ++ai)
#pragma unroll
            for (int m = 0; m < 4; ++m) { const unsigned dst = dstL[u.ui * 256 + ai * HALF + wr * 64 + m * 16 + fr];
                const f32x4 v00 = acc[ai][0][m][0] + bv[0][0], v01 = acc[ai][0][m][1] + bv[0][1], v10 = acc[ai][1][m][0] + bv[1][0], v11 = acc[ai][1][m][1] + bv[1][1];
                u32x4 w; w.x = pk4_fp8(v00[0], v00[1], v00[2], v00[3]); w.y = pk4_fp8(v01[0], v01[1], v01[2], v01[3]); w.z = pk4_fp8(v10[0], v10[1], v10[2], v10[3]); w.w = pk4_fp8(v11[0], v11[1], v11[2], v11[3]);
                *(u32x4*)(Y + (size_t)dst * 2048 + col0) = w; }
    }
};

template <class Epi, bool GATHER, bool ALIGN_EPI, bool FP8>
__device__ __forceinline__ void gemm_phase(LAS unsigned char* lds, const char* Abase, const char* Bbase, size_t estrideB, int KB, const TileOrder& S, const Epi& E, const LAS unsigned short* tokL) {
    const int tid = threadIdx.x, wid = __builtin_amdgcn_readfirstlane(tid >> 6), lane = tid & 63, wr = wid >> 2, wc = wid & 3, fr = lane & 15, fq = lane >> 4;
    const int nt = KB / 128;
    int Rr[2], Cc[2]; unsigned voffB[2], vA[2][2];
#pragma unroll
    for (int i = 0; i < 2; ++i) { int R, C; stage_rc(tid * 16 + i * 8192, R, C); const int Rb = Epi::PERM ? ((R & ~31) + perm32(R & 31)) : R;
        Rr[i] = R; Cc[i] = C; voffB[i] = (unsigned)(Rb * KB + C * 2); }
    const size_t kstep = (size_t)128;
    const size_t hstep = (size_t)HALF * KB;
    const size_t tstep = 2 * hstep;
    const unsigned ldsw = (unsigned)wid * 1024u;
    const int aoff = lds_byte(wr * 64 + fr, fq * 8), boff = lds_byte(wc * 32 + fr, fq * 8);
#define PG8_SA(b, h) (((b) * 2 + (h)) * HTB)
#define PG8_SB(b, h) ((4 + (b) * 2 + (h)) * HTB)
#define PG8_STAGE(bufoff, gbase, voff) do { _Pragma("unroll") for (int _i = 0; _i < 2; ++_i) \
        __builtin_amdgcn_global_load_lds((const GAS unsigned*)((const char*)(gbase) + (voff)[_i]), (LAS unsigned*)(lds + (bufoff) + ldsw + _i * 8192), 16, 0, 0); } while (0)
#define PG8_LDA(dst, b, h) do { _Pragma("unroll") for (int m = 0; m < 4; ++m) dst[m] = __builtin_shufflevector(*(const LAS v4i*)(lds + PG8_SA(b, h) + aoff + m * 2048), *(const LAS v4i*)(lds + PG8_SA(b, h) + aoff + m * 2048 + 1024), 0, 1, 2, 3, 4, 5, 6, 7); } while (0)
#define PG8_LDB(dst, b, h) do { _Pragma("unroll") for (int n = 0; n < 2; ++n) dst[n] = __builtin_shufflevector(*(const LAS v4i*)(lds + PG8_SB(b, h) + boff + n * 2048), *(const LAS v4i*)(lds + PG8_SB(b, h) + boff + n * 2048 + 1024), 0, 1, 2, 3, 4, 5, 6, 7); } while (0)
#define PG8_MMA(ai, bj, At, Bt) do { __builtin_amdgcn_s_setprio(1); _Pragma("unroll") for (int m = 0; m < 4; ++m) _Pragma("unroll") for (int n = 0; n < 2; ++n) { \
        if constexpr (FP8) acc[ai][bj][m][n] = __builtin_amdgcn_mfma_scale_f32_16x16x128_f8f6f4(Bt[n], At[m], acc[ai][bj][m][n], 2, 2, 0, Bt[n][6], 0, At[m][6])    ; \
        else { acc[ai][bj][m][n] = __builtin_amdgcn_mfma_f32_16x16x32_bf16(lo8(Bt[n]), lo8(At[m]), acc[ai][bj][m][n], 0, 0, 0); acc[ai][bj][m][n] = __builtin_amdgcn_mfma_f32_16x16x32_bf16(hi8(Bt[n]), hi8(At[m]), acc[ai][bj][m][n], 0, 0, 0); } } __builtin_amdgcn_s_setprio(0); } while (0)
#define PG8_WAIT_V(n) asm volatile("s_waitcnt vmcnt(" #n ")" ::: "memory")
#define PG8_WAIT_L(n) asm volatile("s_waitcnt lgkmcnt(" #n ")" ::: "memory")
#define PG8_BAR __builtin_amdgcn_s_barrier()
#define PG8_SCHED __builtin_amdgcn_sched_barrier(0)
#define PG8_SETVA(u) do { _Pragma("unroll") for (int _h = 0; _h < 2; ++_h) _Pragma("unroll") for (int _i = 0; _i < 2; ++_i) { \
        const int _row = GATHER ? (int)tokL[(u).ui * 256 + _h * HALF + Rr[_i]] : (_h * HALF + Rr[_i]); vA[_h][_i] = (unsigned)(_row * KB + Cc[_i] * 2); asm volatile("" : "+v"(vA[_h][_i])); } } while (0)
    Unit cur, nxt; int ui = 0;
    if (!S.next(0, cur)) return;
    f32x4 acc[2][2][4][2];
#pragma unroll
    for (int a = 0; a < 2; ++a)
#pragma unroll
        for (int b = 0; b < 2; ++b)
#pragma unroll
            for (int m = 0; m < 4; ++m)
#pragma unroll
                for (int n = 0; n < 2; ++n) acc[a][b][m][n] = (f32x4){0.f, 0.f, 0.f, 0.f};
    v8i At[4], B0[2], B1[2];
    const char* cA = GATHER ? Abase : Abase + (size_t)cur.pm * tstep;
    const char* cB = Bbase + (size_t)cur.e * estrideB + (size_t)cur.pn * tstep;
    PG8_SETVA(cur);
    if constexpr (Epi::BIASL) E.prefetch(cur, wid, lane);
    PG8_STAGE(PG8_SB(0, 0), cB, voffB); PG8_STAGE(PG8_SB(0, 1), cB + hstep, voffB); PG8_STAGE(PG8_SA(0, 0), cA, vA[0]); PG8_STAGE(PG8_SA(0, 1), cA, vA[1]);
    if (wr == 1) PG8_BAR;
    PG8_WAIT_V(2); PG8_BAR;
    PG8_STAGE(PG8_SB(1, 0), cB + kstep, voffB); PG8_STAGE(PG8_SA(1, 0), cA + kstep, vA[0]); PG8_STAGE(PG8_SB(1, 1), cB + hstep + kstep, voffB);
    PG8_WAIT_V(6); PG8_BAR;
    for (;;) {
        const bool has_next = S.next(ui + 1, nxt);
        const char* nA = has_next ? (GATHER ? Abase : Abase + (size_t)nxt.pm * tstep) : cA;
        const char* nB = has_next ? Bbase + (size_t)nxt.e * estrideB + (size_t)nxt.pn * tstep : cB;
        for (int t = 0; t < nt; t += 2) {
            if constexpr (Epi::MIDK) { if (t == nt / 2) E.mid(acc, cur, wr, fr); }
            const bool last = (t == nt - 2);
            const char* a1 = cA + (size_t)(t + 1) * kstep;
            const char* a2 = last ? nA : cA + (size_t)(t + 2) * kstep; const char* b2 = last ? nB : cB + (size_t)(t + 2) * kstep;
            const char* a3 = a2 + kstep; const char* b3 = b2 + kstep;
            PG8_LDB(B0, 0, 0); PG8_LDB(B1, 0, 1); PG8_SCHED; PG8_LDA(At, 0, 0); PG8_STAGE(PG8_SA(1, 1), a1, vA[1]);
            if (last && has_next) PG8_SETVA(nxt);
            PG8_WAIT_V(8); PG8_WAIT_L(0); PG8_BAR; PG8_MMA(0, 0, At, B0); PG8_MMA(0, 1, At, B1); PG8_BAR; PG8_SCHED;
            PG8_LDA(At, 0, 1); PG8_STAGE(PG8_SB(0, 0), b2, voffB); PG8_STAGE(PG8_SB(0, 1), b2 + hstep, voffB); PG8_STAGE(PG8_SA(0, 0), a2, vA[0]);
            PG8_WAIT_V(8); PG8_WAIT_L(0); PG8_BAR; PG8_MMA(1, 0, At, B0); PG8_MMA(1, 1, At, B1); PG8_BAR; PG8_SCHED;
            PG8_LDB(B0, 1, 0); PG8_LDB(B1, 1, 1); PG8_SCHED; PG8_LDA(At, 1, 0); PG8_STAGE(PG8_SA(0, 1), a2, vA[1]);
            PG8_WAIT_V(8); PG8_WAIT_L(0); PG8_BAR; PG8_MMA(0, 0, At, B0); PG8_MMA(0, 1, At, B1); PG8_BAR; PG8_SCHED;
            PG8_LDA(At, 1, 1); PG8_STAGE(PG8_SB(1, 0), b3, voffB); PG8_STAGE(PG8_SB(1, 1), b3 + hstep, voffB); PG8_STAGE(PG8_SA(1, 0), a3, vA[0]);
            PG8_WAIT_V(8); PG8_WAIT_L(0); PG8_BAR; PG8_MMA(1, 0, At, B0); PG8_MMA(1, 1, At, B1); PG8_BAR; PG8_SCHED;
        }
        if constexpr (ALIGN_EPI) { if (wr == 0) PG8_BAR; }
        E(acc, cur, wr, wc, fr, fq);
        if (!has_next) break;
#pragma unroll
        for (int a = 0; a < 2; ++a)
#pragma unroll
            for (int b = 0; b < 2; ++b)
#pragma unroll
                for (int m = 0; m < 4; ++m)
#pragma unroll
                    for (int n = 0; n < 2; ++n) acc[a][b][m][n] = (f32x4){0.f, 0.f, 0.f, 0.f};
        cur = nxt; cA = nA; cB = nB; ++ui;
        if constexpr (Epi::BIASL) E.prefetch(cur, wid, lane);
        if constexpr (ALIGN_EPI) { if (wr == 1) PG8_BAR; }
    }
    PG8_WAIT_V(0);
    if constexpr (!ALIGN_EPI) { if (wr == 0) PG8_BAR; }
    PG8_BAR;
#undef PG8_SA
#undef PG8_SB
#undef PG8_STAGE
#undef PG8_LDA
#undef PG8_LDB
#undef PG8_MMA
#undef PG8_WAIT_V
#undef PG8_WAIT_L
#undef PG8_BAR
#undef PG8_SCHED
#undef PG8_SETVA
}

struct Frame {
    LAS unsigned char* lds;
    volatile LAS unsigned* MISC;
    gu32* ctl;
    int tid, lane, wave, vcu, G;
    const float *x, *g1, *w_in, *gq, *gk, *rpb, *gsg, *w_sp, *b_sp, *ga, *gs, *w_out, *g2, *w_r, *b_r, *w_gu, *b_gu, *w_dn, *b_dn;
    float* out;
    bf16 *WIN, *WOUT, *WSP, *WRH, *WRL, *H, *PROJ, *MIX, *X2B; unsigned char *WGU, *WDN, *ACT, *H8, *Y;
    float *RSTD2, *GATE, *SSQA, *SSG, *RA, *RB, *SSX, *RMS1, *IG1; unsigned* SLOT; int* LIST;
};

__device__ __forceinline__ void p0_transpose_item(const float* W, int N, int K, bf16* WT, int k0, int n0, int out_row0, int hi_off, const float* kgain, LAS float* scr, int lane) {
    const int l16 = lane & 15, lq = lane >> 4;
#pragma unroll 4
    for (int i = 0; i < 16; ++i) { const int kk = 4 * i + lq; f32x4 v = *(const f32x4*)(W + (size_t)(k0 + kk) * N + n0 + 4 * l16); if (kgain) v = v * kgain[k0 + kk];
        LAS float* d = scr + kk * 65 + 4 * l16; d[0] = v.x; d[1] = v.y; d[2] = v.z; d[3] = v.w; }
    LDS_WAIT(); asm volatile("" ::: "memory");
    const int c = lane >> 3, nn = lane & 7;
#pragma unroll
    for (int j = 0; j < 8; ++j) { const int n = nn + 8 * j; const LAS float* s = scr + (8 * c) * 65 + n;
        u32x4 o; o.x = cvt_pk_bf16(s[0], s[65]); o.y = cvt_pk_bf16(s[2 * 65], s[3 * 65]); o.z = cvt_pk_bf16(s[4 * 65], s[5 * 65]); o.w = cvt_pk_bf16(s[6 * 65], s[7 * 65]);
        *(u32x4*)(WT + (size_t)(out_row0 + n + (n >= 32 ? hi_off : 0)) * K + k0 + 8 * c) = o; }
    LDS_WAIT(); asm volatile("" ::: "memory");
}
__device__ __forceinline__ void p0_transpose_item_fp8(const float* W, int N, int K, unsigned char* WT, int k0, int n0, int out_row0, LAS float* scr, int lane) {
    const int l8 = lane & 7, lr = lane >> 3;
#pragma unroll 4
    for (int i = 0; i < 16; ++i) { const int kk = 8 * i + lr; const f32x4 v = *(const f32x4*)(W + (size_t)(k0 + kk) * N + n0 + 4 * l8);
        LAS float* d = scr + kk * 33 + 4 * l8; d[0] = v.x; d[1] = v.y; d[2] = v.z; d[3] = v.w; }
    LDS_WAIT(); asm volatile("" ::: "memory");
    const int n = lane & 31, kh = lane >> 5; const LAS float* s = scr + (64 * kh) * 33 + n;
#pragma unroll
    for (int c4 = 0; c4 < 4; ++c4) { u32x4 o;
        o.x = pk4_fp8(s[(16 * c4 + 0) * 33] * 64.f, s[(16 * c4 + 1) * 33] * 64.f, s[(16 * c4 + 2) * 33] * 64.f, s[(16 * c4 + 3) * 33] * 64.f);
        o.y = pk4_fp8(s[(16 * c4 + 4) * 33] * 64.f, s[(16 * c4 + 5) * 33] * 64.f, s[(16 * c4 + 6) * 33] * 64.f, s[(16 * c4 + 7) * 33] * 64.f);
        o.z = pk4_fp8(s[(16 * c4 + 8) * 33] * 64.f, s[(16 * c4 + 9) * 33] * 64.f, s[(16 * c4 + 10) * 33] * 64.f, s[(16 * c4 + 11) * 33] * 64.f);
        o.w = pk4_fp8(s[(16 * c4 + 12) * 33] * 64.f, s[(16 * c4 + 13) * 33] * 64.f, s[(16 * c4 + 14) * 33] * 64.f, s[(16 * c4 + 15) * 33] * 64.f);
        *(u32x4*)(WT + (size_t)(out_row0 + n) * K + k0 + 64 * kh + 16 * c4) = o; }
    LDS_WAIT(); asm volatile("" ::: "memory");
}
__device__ __forceinline__ void moe_convert(Frame& F, int j0, int j1) {
    LAS float* img = (LAS float*)F.lds;
    constexpr int T_GU = 16 * 16, T_DN = 16 * 8, NT = NE * (T_GU + T_DN);
    const int w = F.wave, lane = F.lane;
    f32x4 v0[16], v1[16];
#define P0_DECODE(t, W_, N_, WT_, k0_, n0_, isgu_) do { int r_ = (t); if (r_ < NE * T_GU) { const int e_ = r_ / T_GU, q_ = r_ % T_GU; W_ = F.w_gu + (size_t)e_ * DM * 4096; N_ = 4096; WT_ = F.WGU + (size_t)e_ * 4096 * DM; k0_ = 128 * (q_ / 16); n0_ = 256 * (q_ % 16); isgu_ = 1; } \
        else { r_ -= NE * T_GU; const int e_ = r_ / T_DN, q_ = r_ % T_DN; W_ = F.w_dn + (size_t)e_ * DM * DM; N_ = DM; WT_ = F.WDN + (size_t)e_ * DM * DM; k0_ = 128 * (q_ / 8); n0_ = 256 * (q_ % 8); isgu_ = 0; } } while (0)
#define P0_VALID(jj) ((jj) < j1 && F.vcu + (jj) * F.G < NT)
#define P0_LOAD(v_, jj) do { const float* W_ = nullptr; unsigned char* WT_ = nullptr; int N_ = 0, k0_ = 0, n0_ = 0, ig_ = 0; P0_DECODE(F.vcu + (jj) * F.G, W_, N_, WT_, k0_, n0_, ig_); (void)WT_; (void)ig_; \
        _Pragma("unroll") for (int i = 0; i < 16; ++i) v_[i] = __builtin_nontemporal_load((const f32x4*)(W_ + (size_t)(k0_ + 16 * w + i) * N_ + n0_ + 4 * lane)); } while (0)
#define P0_IMG(v_) do { _Pragma("unroll") for (int i = 0; i < 16; ++i) *(LAS f32x4*)(img + (16 * w + i) * 256 + ((4 * lane + 8 * (w >> 1)) & 255)) = v_[i]; } while (0)
#define P0_CONVERT(jj) do { const float* W_ = nullptr; unsigned char* WT = nullptr; int N_ = 0, k0 = 0, n0 = 0, isgu = 0; P0_DECODE(F.vcu + (jj) * F.G, W_, N_, WT, k0, n0, isgu); (void)W_; (void)N_; \
          const int q = lane & 3; \
          _Pragma("unroll") for (int h = 0; h < 2; ++h) { const int n = 32 * w + (lane >> 2) + 16 * h;     \
              const int nn = n0 + n; const int ll = nn & 255;            \
              const int jl = nn & 127;                                   \
              const int orow = isgu ? (((nn & 2047) >> 7) * 256 + (nn >> 11) * 128 + jl) : ((nn & ~255) + 128 * ((ll >> 3) & 1) + 32 * (ll >> 6) + 8 * ((ll >> 4) & 3) + (ll & 7)); \
              unsigned char* dst = WT + (size_t)orow * DM + k0 + 16 * q;     \
              const LAS float* sp = img + (32 * q) * 256 + ((n + 8 * q) & 255); v16f va, vb; \
              _Pragma("unroll") for (int p = 0; p < 16; ++p) { va[p] = sp[p * 256]; vb[p] = sp[(16 + p) * 256]; } \
              u32x4 w0, w1; mx6_pack(va, vb, w0, w1); \
              __builtin_nontemporal_store(w0, (u32x4*)(dst)); __builtin_nontemporal_store(w1, (u32x4*)(dst + 64)); } } while (0)
    if (P0_VALID(j0)) P0_LOAD(v0, j0);
    if (P0_VALID(j0 + 1)) P0_LOAD(v1, j0 + 1);
    for (int j = j0; P0_VALID(j); j += 2) {
        P0_IMG(v0); __syncthreads();
        if (P0_VALID(j + 2)) P0_LOAD(v0, j + 2);
        P0_CONVERT(j); __syncthreads();
        if (!P0_VALID(j + 1)) break;
        P0_IMG(v1); __syncthreads();
        if (P0_VALID(j + 3)) P0_LOAD(v1, j + 3);
        P0_CONVERT(j + 1); __syncthreads();
    }
#undef P0_DECODE
#undef P0_VALID
#undef P0_LOAD
#undef P0_IMG
#undef P0_CONVERT
}
__device__ __forceinline__ void p0_prologue(Frame& F) {
    LAS float* scr = (LAS float*)(F.lds + F.wave * 16896);
    const int gw = F.vcu * NWAVES + F.wave, NGW = F.G * NWAVES, lane = F.lane;
    constexpr int I_IN = 32 * 80, I_OUT = 32 * 32;
    constexpr int NITEMS = I_IN + I_OUT;
    for (int it = gw; it < NITEMS; it += NGW) {
        int r = it;
        if (r < I_IN) { const int kb = r / 80, nb = r % 80; p0_transpose_item(F.w_in, NPROJ, DM, F.WIN, 64 * kb, 64 * nb, (nb >> 2) * 256 + (nb & 3) * 32, 96, nullptr, scr, lane); continue; } r -= I_IN;
        { const int kb = r / 32, nb = r % 32; p0_transpose_item(F.w_out, DM, DM, F.WOUT, 64 * kb, 64 * nb, 64 * nb, 0, kb < 16 ? F.ga : F.gs - 1024, scr, lane); }
    }
    {
        f32x4 g1v[8];
#pragma unroll
        for (int j = 0; j < 4; ++j) { g1v[2 * j] = *(const f32x4*)(F.g1 + 8 * lane + 512 * j); g1v[2 * j + 1] = *(const f32x4*)(F.g1 + 8 * lane + 512 * j + 4); }
        for (int m = gw; m < NTOK; m += 2 * NGW) {
            const int m2 = m + NGW; const bool has2 = m2 < NTOK;
            const float* xr = F.x + (size_t)m * DM + 8 * lane; const float* xr2 = F.x + (size_t)(has2 ? m2 : m) * DM + 8 * lane;
            f32x4 v[8], u[8]; float s = 0.f, s2 = 0.f;
#pragma unroll
            for (int j = 0; j < 4; ++j) { v[2 * j] = __builtin_nontemporal_load((const f32x4*)(xr + 512 * j)); v[2 * j + 1] = __builtin_nontemporal_load((const f32x4*)(xr + 512 * j + 4)); u[2 * j] = __builtin_nontemporal_load((const f32x4*)(xr2 + 512 * j)); u[2 * j + 1] = __builtin_nontemporal_load((const f32x4*)(xr2 + 512 * j + 4)); }
#pragma unroll
            for (int j = 0; j < 8; ++j) { s += (v[j].x * v[j].x + v[j].y * v[j].y) + (v[j].z * v[j].z + v[j].w * v[j].w); s2 += (u[j].x * u[j].x + u[j].y * u[j].y) + (u[j].z * u[j].z + u[j].w * u[j].w); }
            const float rm = sqrtf(wave_sum(s) * (1.0f / DM) + EPS), rm2 = sqrtf(wave_sum(s2) * (1.0f / DM) + EPS); const float rs = 1.0f / rm, rs2 = 1.0f / rm2;
            if (lane == 0) { F.RMS1[m] = rm; if (has2) F.RMS1[m2] = rm2; }
#pragma unroll
            for (int j = 0; j < 4; ++j) { const f32x4 a = v[2 * j] * rs * g1v[2 * j], b = v[2 * j + 1] * rs * g1v[2 * j + 1]; u32x4 o; o.x = cvt_pk_bf16(a.x, a.y); o.y = cvt_pk_bf16(a.z, a.w); o.z = cvt_pk_bf16(b.x, b.y); o.w = cvt_pk_bf16(b.z, b.w);
                *(u32x4*)(F.H + (size_t)m * DM + 8 * lane + 512 * j) = o; }
            if (has2) {
#pragma unroll
                for (int j = 0; j < 4; ++j) { const f32x4 a = u[2 * j] * rs2 * g1v[2 * j], b = u[2 * j + 1] * rs2 * g1v[2 * j + 1]; u32x4 o; o.x = cvt_pk_bf16(a.x, a.y); o.y = cvt_pk_bf16(a.z, a.w); o.z = cvt_pk_bf16(b.x, b.y); o.w = cvt_pk_bf16(b.z, b.w);
                    *(u32x4*)(F.H + (size_t)m2 * DM + 8 * lane + 512 * j) = o; } }
        }
    }
    const int gt = F.vcu * 512 + F.tid, NGT = F.G * 512;
    for (int i = gt; i < DM; i += NGT) F.IG1[i] = 1.0f / F.g1[i];
    for (int i = gt; i < 16 * 128 * 128; i += NGT) { const float v = F.w_sp[i]; F.WSP[i] = (bf16)(cvt_pk_bf16(v, 0.f) & 0xffffu); }
    for (int i = gt; i < NE * DM; i += NGT) { const int e = i / DM, d = i % DM; const float v = F.w_r[(size_t)d * NE + e]; const unsigned hi = cvt_pk_bf16(v, 0.f) & 0xffffu; const float lo = v - __uint_as_float(hi << 16);
        F.WRH[i] = (bf16)hi; F.WRL[i] = (bf16)(cvt_pk_bf16(lo, 0.f) & 0xffffu); }
}

typedef short v4i16_t __attribute__((ext_vector_type(4)));
__device__ __forceinline__ s16x4 tr_read(const LAS unsigned char* p) { return __builtin_bit_cast(s16x4, __builtin_amdgcn_ds_read_tr16_b64_v4i16((LAS v4i16_t*)p)); }
__device__ __forceinline__ void attn_unit(Frame& F, int b, int h, int band) {
    constexpr int SLOT = 16384;
    LAS unsigned char* ring = F.lds;
    LAS float* rpbL = (LAS float*)(F.lds + AT_RPB);
    LAS unsigned* mrg = (LAS unsigned*)(F.lds + AT_MRG);
    const int tid = F.tid, lane = F.lane, w = F.wave, fr = lane & 15, quad = lane >> 4;
    const int cg = w & 3, hf8 = w >> 2;
    const int c0 = 16 * cg, w0 = (cg == 0) ? 0 : (cg == 1) ? 8 : (cg == 2) ? 24 : 32;
    const int qc = c0 + fr; const int cs = min(max(qc - 8, 0), 48);
    const int R0 = band * 16;
    __syncthreads();
    for (int i = tid; i < 480; i += 512) { const int ro = i >> 5, co = i & 31; rpbL[i] = co < 31 ? F.rpb[h * 465 + ro * 31 + co] * 1.4426950408889634f : -INFINITY; }
    int cooff[2][4];
#pragma unroll
    for (int hf = 0; hf < 2; ++hf)
#pragma unroll
        for (int i = 0; i < 4; ++i) { const int kc = w0 + 16 * hf + 4 * quad + i; const bool valid = (kc >= cs) && (kc < cs + 16); cooff[hf][i] = 4 * (valid ? kc - qc + 15 : 31); }
    const char* projb = (const char*)F.PROJ + (size_t)b * SEQ * NPROJ * 2; const unsigned ringb = (unsigned)(size_t)ring;
    const unsigned lane_src = (unsigned)((8 * w + (lane >> 3)) * NPROJ + 1024 + h * 64) * 2u + (unsigned)(((lane & 7) ^ (lane >> 3)) * 16);
#define ROW_DMA(rowabs) do { const char* src_ = projb + (size_t)(rowabs) * 64 * NPROJ * 2 + lane_src; const unsigned sb_ = ringb + (unsigned)(((rowabs) % 9) * SLOT + w * 1024); \
        glds16(src_, sb_); glds16(src_ + 2048, sb_ + 8192u); } while (0)
    const int rs0 = min(max(R0 - 4, 0), 120);
    for (int j = 0; j < 8; ++j) ROW_DMA(rs0 + j);
    int loaded_hi = rs0 + 7;
    const bf16* qbase = F.PROJ + ((size_t)b * SEQ + qc) * NPROJ + h * 64 + 8 * quad;
    bf16x8 qa = *(const bf16x8*)(qbase + (size_t)R0 * 64 * NPROJ), qb = *(const bf16x8*)(qbase + (size_t)R0 * 64 * NPROJ + 32);
    VM_WAIT(); __syncthreads();
    for (int step = 0; step < 16; ++step) {
        const int r = R0 + step, rs = min(max(r - 4, 0), 120);
        bf16x8 qf0 = qa, qf1 = qb;
        if (step < 15) { const int nh = min(max(r - 3, 0), 120) + 7; if (nh > loaded_hi) { ROW_DMA(nh); loaded_hi = nh; }
            qa = *(const bf16x8*)(qbase + (size_t)(r + 1) * 64 * NPROJ); qb = *(const bf16x8*)(qbase + (size_t)(r + 1) * 64 * NPROJ + 32); }
        f32x4 s[4][2];
#pragma unroll
        for (int kr = 0; kr < 4; ++kr) { const int sb = ((rs + 4 * hf8 + kr) % 9) * SLOT;
#pragma unroll
            for (int hf = 0; hf < 2; ++hf) { const int key = w0 + 16 * hf + fr;
                const bf16x8 a0 = *(const LAS bf16x8*)(ring + sb + key * 128 + ((quad ^ (key & 7)) << 4));
                const bf16x8 a1 = *(const LAS bf16x8*)(ring + sb + key * 128 + (((quad + 4) ^ (key & 7)) << 4));
                f32x4 z = {0.f, 0.f, 0.f, 0.f};
                z = __builtin_amdgcn_mfma_f32_16x16x32_bf16(a0, qf0, z, 0, 0, 0);
                z = __builtin_amdgcn_mfma_f32_16x16x32_bf16(a1, qf1, z, 0, 0, 0);
                s[kr][hf] = z; } }
        float mx = -INFINITY;
        { const LAS unsigned char* bb = (const LAS unsigned char*)rpbL + (rs + 4 * hf8 - r + 7) * 128;
#pragma unroll
            for (int kr = 0; kr < 4; ++kr)
#pragma unroll
                for (int hf = 0; hf < 2; ++hf)
#pragma unroll
                    for (int i = 0; i < 4; ++i) { const float v = s[kr][hf][i] + *(const LAS float*)(bb + kr * 128 + cooff[hf][i]); s[kr][hf][i] = v; mx = fmaxf(mx, v); } }
        mx = fmaxf(mx, __shfl_xor(mx, 16)); mx = fmaxf(mx, __shfl_xor(mx, 32));
        float lsum = 0.f; bf16x8 pf[4];
#pragma unroll
        for (int kr = 0; kr < 4; ++kr) { float p[8];
#pragma unroll
            for (int i = 0; i < 8; ++i) { p[i] = __builtin_amdgcn_exp2f(s[kr][i >> 2][i & 3] - mx); lsum += p[i]; }
            u32x4 pk; pk.x = cvt_pk_bf16(p[0], p[1]); pk.y = cvt_pk_bf16(p[2], p[3]); pk.z = cvt_pk_bf16(p[4], p[5]); pk.w = cvt_pk_bf16(p[6], p[7]); pf[kr] = __builtin_bit_cast(bf16x8, pk); }
        lsum += __shfl_xor(lsum, 16); lsum += __shfl_xor(lsum, 32);
        f32x4 o[4];
#pragma unroll
        for (int dt = 0; dt < 4; ++dt) o[dt] = (f32x4){0.f, 0.f, 0.f, 0.f};
#pragma unroll
        for (int kr = 0; kr < 4; ++kr) { const int sb = ((rs + 4 * hf8 + kr) % 9) * SLOT + 8192; const int key = w0 + 4 * quad + (fr >> 2), pp = fr & 3;
#pragma unroll
            for (int dt = 0; dt < 4; ++dt) { const int c = 2 * dt + (pp >> 1); const int ad = sb + key * 128 + ((c ^ (key & 7)) << 4) + 8 * (pp & 1);
                const s16x4 lo = tr_read(ring + ad), hi = tr_read(ring + ad + 16 * 128);
                const bf16x8 vf = __builtin_shufflevector(lo, hi, 0, 1, 2, 3, 4, 5, 6, 7);
                o[dt] = __builtin_amdgcn_mfma_f32_16x16x32_bf16(vf, pf[kr], o[dt], 0, 0, 0); } }
        if (w >= 4) { LAS unsigned* m = mrg + (w - 4) * 640 + lane; m[0] = __float_as_uint(mx); m[64] = __float_as_uint(lsum);
#pragma unroll
            for (int dt = 0; dt < 4; ++dt) { m[(2 + 2 * dt) * 64] = cvt_pk_bf16(o[dt][0], o[dt][1]); m[(3 + 2 * dt) * 64] = cvt_pk_bf16(o[dt][2], o[dt][3]); } }
        __syncthreads();
        if (w < 4) { const LAS unsigned* m = mrg + w * 640 + lane; const float mx2 = __uint_as_float(m[0]), l2 = __uint_as_float(m[64]);
            const float mm = fmaxf(mx, mx2), a1 = __builtin_amdgcn_exp2f(mx - mm), a2 = __builtin_amdgcn_exp2f(mx2 - mm); const float inv = 1.0f / (lsum * a1 + l2 * a2);
            const float f1 = a1 * inv, f2 = a2 * inv; float ssq = 0.f;
            bf16* op = F.MIX + ((size_t)b * SEQ + (size_t)r * 64 + qc) * DM + h * 64 + 4 * quad;
            u32x2 pk[4];
#pragma unroll
            for (int dt = 0; dt < 4; ++dt) { const unsigned u0 = m[(2 + 2 * dt) * 64], u1 = m[(3 + 2 * dt) * 64];
                const float v0 = o[dt][0] * f1 + bflo(u0) * f2, v1 = o[dt][1] * f1 + bfhi(u0) * f2, v2 = o[dt][2] * f1 + bflo(u1) * f2, v3 = o[dt][3] * f1 + bfhi(u1) * f2;
                ssq += (v0 * v0 + v1 * v1) + (v2 * v2 + v3 * v3);
                pk[dt].x = cvt_pk_bf16(v0, v1); pk[dt].y = cvt_pk_bf16(v2, v3); }
            ssq += __shfl_xor(ssq, 16); ssq += __shfl_xor(ssq, 32);
            VM_WAIT();
#pragma unroll
            for (int dp = 0; dp < 2; ++dp) *(u32x4*)(op + 32 * dp + ((quad & 1) ? 12 : 0)) = pair16(pk[2 * dp], pk[2 * dp + 1]);
            if (quad == 0) F.SSQA[((size_t)b * SEQ + (size_t)r * 64 + qc) * 16 + h] = ssq; }
        else VM_WAIT();
        __syncthreads();
    }
#undef ROW_DMA
}

__device__ __forceinline__ void sgu_unit(Frame& F, int unit) {
    LAS unsigned char* Gn = F.lds;
    LAS float* rsG = (LAS float*)(F.lds + 16384);
    const int tid = F.tid, lane = F.lane, w = F.wave, fr = lane & 15, quad = lane >> 4;
    const size_t tk0 = (size_t)unit * 128;
    __syncthreads();
    if (tid < 128) { const f32x4* sp = (const f32x4*)(F.SSG + (tk0 + tid) * 16); const f32x4 a = sp[0], b2 = sp[1], c = sp[2], d = sp[3];
        const float ss = ((a.x + a.y) + (a.z + a.w)) + ((b2.x + b2.y) + (b2.z + b2.w)) + ((c.x + c.y) + (c.z + c.w)) + ((d.x + d.y) + (d.z + d.w)); rsG[tid] = 1.0f / sqrtf(ss * (1.0f / 1024.0f) + EPS); }
    else if (tid < 256) { const int q = tid - 128; const f32x4* sp = (const f32x4*)(F.SSQA + (tk0 + q) * 16); const f32x4 a = sp[0], b2 = sp[1], c = sp[2], d = sp[3];
        const float ss = ((a.x + a.y) + (a.z + a.w)) + ((b2.x + b2.y) + (b2.z + b2.w)) + ((c.x + c.y) + (c.z + c.w)) + ((d.x + d.y) + (d.z + d.w)); F.RA[tk0 + q] = 1.0f / sqrtf(ss * (1.0f / 1024.0f) + EPS); }
    float ssq = 0.f; const int p = 16 * w + fr;
    const bf16* gsrc0 = F.PROJ + (tk0 + (tid >> 3)) * NPROJ + 4096 + (tid & 7) * 8;
    const bf16* usrc = F.PROJ + (tk0 + p) * NPROJ + 3072 + 4 * quad;
    const bf16* wsrc = F.WSP + (size_t)p * 128 + 8 * quad;
    u32x4 gv0 = *(const u32x4*)(gsrc0), gv1 = *(const u32x4*)(gsrc0 + (size_t)64 * NPROJ);
    u32x2 uv[4]; bf16x8 wv[4];
#pragma unroll
    for (int dt = 0; dt < 4; ++dt) { uv[dt] = *(const u32x2*)(usrc + 16 * dt); wv[dt] = *(const bf16x8*)(wsrc + 32 * dt); }
    for (int gi = 0; gi < 16; ++gi) {
        __syncthreads();
#pragma unroll
        for (int j = 0; j < 2; ++j) { const int q = (tid >> 3) + 64 * j, c = tid & 7; const u32x4 v = j ? gv1 : gv0; const float rr = rsG[q];
            const f32x4 ga = *(const f32x4*)(F.gsg + gi * 64 + c * 8), gb = *(const f32x4*)(F.gsg + gi * 64 + c * 8 + 4);
            u32x4 o; o.x = cvt_pk_bf16(bflo(v.x) * rr * ga.x, bfhi(v.x) * rr * ga.y); o.y = cvt_pk_bf16(bflo(v.y) * rr * ga.z, bfhi(v.y) * rr * ga.w);
            o.z = cvt_pk_bf16(bflo(v.z) * rr * gb.x, bfhi(v.z) * rr * gb.y); o.w = cvt_pk_bf16(bflo(v.w) * rr * gb.z, bfhi(v.w) * rr * gb.w);
            *(LAS u32x4*)(Gn + q * 128 + ((c ^ (q & 7)) << 4)) = o; }
        u32x2 uc[4]; bf16x8 wf[4];
#pragma unroll
        for (int dt = 0; dt < 4; ++dt) { uc[dt] = uv[dt]; wf[dt] = wv[dt]; }
        if (gi < 15) { gv0 = *(const u32x4*)(gsrc0 + (gi + 1) * 64); gv1 = *(const u32x4*)(gsrc0 + (size_t)64 * NPROJ + (gi + 1) * 64);
#pragma unroll
            for (int dt = 0; dt < 4; ++dt) { uv[dt] = *(const u32x2*)(usrc + (gi + 1) * 64 + 16 * dt); wv[dt] = *(const bf16x8*)(wsrc + (size_t)(gi + 1) * 16384 + 32 * dt); } }
        __syncthreads();
        f32x4 acc[4];
#pragma unroll
        for (int dt = 0; dt < 4; ++dt) acc[dt] = (f32x4){0.f, 0.f, 0.f, 0.f};
#pragma unroll
        for (int ks = 0; ks < 4; ++ks) { const int rowA = 32 * ks + 8 * quad + (fr >> 2), rowB = rowA + 4; const int pp = fr & 3;
#pragma unroll
            for (int dt = 0; dt < 4; ++dt) { const int c = 2 * dt + (pp >> 1);
                const s16x4 lo = tr_read(Gn + rowA * 128 + ((c ^ (rowA & 7)) << 4) + 8 * (pp & 1)), hi = tr_read(Gn + rowB * 128 + ((c ^ (rowB & 7)) << 4) + 8 * (pp & 1));
                const bf16x8 af = __builtin_shufflevector(lo, hi, 0, 1, 2, 3, 4, 5, 6, 7);
                acc[dt] = __builtin_amdgcn_mfma_f32_16x16x32_bf16(af, wf[ks], acc[dt], 0, 0, 0); } }
        const float bs = F.b_sp[gi * 128 + p];
        u32x2 pk[4];
#pragma unroll
        for (int dt = 0; dt < 4; ++dt) { const u32x2 uu = uc[dt];
            const float s0 = bflo(uu.x) * (acc[dt][0] + bs), s1 = bfhi(uu.x) * (acc[dt][1] + bs), s2 = bflo(uu.y) * (acc[dt][2] + bs), s3 = bfhi(uu.y) * (acc[dt][3] + bs);
            ssq += (s0 * s0 + s1 * s1) + (s2 * s2 + s3 * s3);
            pk[dt].x = cvt_pk_bf16(s0, s1); pk[dt].y = cvt_pk_bf16(s2, s3); }
#pragma unroll
        for (int dp = 0; dp < 2; ++dp) *(u32x4*)(F.MIX + (tk0 + p) * DM + 1024 + gi * 64 + 32 * dp + 4 * quad + ((quad & 1) ? 12 : 0)) = pair16(pk[2 * dp], pk[2 * dp + 1]);
    }
    ssq += __shfl_xor(ssq, 16); ssq += __shfl_xor(ssq, 32);
    if (quad == 0) F.RB[tk0 + p] = 1.0f / sqrtf(ssq * (1.0f / 1024.0f) + EPS);
}

__device__ __forceinline__ void router_unit(Frame& F, int unit) {
    constexpr int WROW = 544, WBUF = 64 * WROW;
    LAS unsigned char* wimg = F.lds;
    LAS float* lgL = (LAS float*)(F.lds + 2 * WBUF);
    LAS unsigned* histL = (LAS unsigned*)(F.lds + 2 * WBUF + 16896); LAS unsigned* baseL = histL + 32;
    const int tid = F.tid, lane = F.lane, w = F.wave, fr = lane & 15, quad = lane >> 4;
    const int token = unit * 128 + 16 * w + fr;
    __syncthreads();
    if (tid < 32) histL[tid] = 0u;
    const bf16* xrow = F.X2B + (size_t)token * DM + 32 * quad;
    unsigned char* trow = F.H8 + (size_t)token * DM + 16 * quad;
    f32x4 acc[2]; acc[0] = (f32x4){0.f, 0.f, 0.f, 0.f}; acc[1] = acc[0];
    float rstd;
    { const f32x4 p0 = *(const f32x4*)(F.SSX + (size_t)token * 32 + 8 * quad), p1 = *(const f32x4*)(F.SSX + (size_t)token * 32 + 8 * quad + 4);
      float ss = ((p0.x + p0.y) + (p0.z + p0.w)) + ((p1.x + p1.y) + (p1.z + p1.w)); ss += __shfl_xor(ss, 16); ss += __shfl_xor(ss, 32); rstd = 1.0f / sqrtf(ss * (1.0f / DM) + EPS); }
    u32x4 wst[4];
#define RT_WLOAD(c) do { _Pragma("unroll") for (int j = 0; j < 4; ++j) { const int id = j * 512 + tid, row = id >> 5, cc = id & 31; \
        wst[j] = *(const u32x4*)((row < 32 ? F.WRH + (size_t)row * DM : F.WRL + (size_t)(row - 32) * DM) + 256 * (c) + 8 * cc); } } while (0)
#define RT_WSTORE(b) do { _Pragma("unroll") for (int j = 0; j < 4; ++j) { const int id = j * 512 + tid, row = id >> 5, cc = id & 31; *(LAS u32x4*)(wimg + (b) * WBUF + row * WROW + (((cc >> 2) & 3) + 4 * (cc & 3) + 16 * (cc >> 4)) * 16) = wst[j]; } } while (0)
    RT_WLOAD(0); RT_WSTORE(0);
    __syncthreads();
    for (int c = 0; c < 8; ++c) {
        if (c < 7) RT_WLOAD(c + 1);
        const LAS unsigned char* wb = wimg + (c & 1) * WBUF + fr * WROW + quad * 16;
        for (int s2 = 0; s2 < 2; ++s2) { const int ss = 2 * c + s2;
            v16f va, vb;
#pragma unroll
            for (int j4 = 0; j4 < 4; ++j4) { const int kl = 4 * s2 + j4;
                const u32x4 xr = *(const u32x4*)(xrow + 128 * ss + 8 * j4); const f32x4 xa = {bflo(xr.x), bfhi(xr.x), bflo(xr.y), bfhi(xr.y)}, xb = {bflo(xr.z), bfhi(xr.z), bflo(xr.w), bfhi(xr.w)};
                const f32x4 ga = *(const f32x4*)(F.g2 + 128 * ss + 32 * quad + 8 * j4), gb = *(const f32x4*)(F.g2 + 128 * ss + 32 * quad + 8 * j4 + 4);
                const f32x4 ya = xa * ga * rstd, yb = xb * gb * rstd;
                u32x4 h; h.x = cvt_pk_bf16(ya.x, ya.y); h.y = cvt_pk_bf16(ya.z, ya.w); h.z = cvt_pk_bf16(yb.x, yb.y); h.w = cvt_pk_bf16(yb.z, yb.w);
                u32x4 l; l.x = cvt_pk_bf16(ya.x - bflo(h.x), ya.y - bfhi(h.x)); l.y = cvt_pk_bf16(ya.z - bflo(h.y), ya.w - bfhi(h.y)); l.z = cvt_pk_bf16(yb.x - bflo(h.z), yb.y - bfhi(h.z)); l.w = cvt_pk_bf16(yb.z - bflo(h.w), yb.w - bfhi(h.w));
                if (j4 < 2) { va[8 * j4 + 0] = ya.x; va[8 * j4 + 1] = ya.y; va[8 * j4 + 2] = ya.z; va[8 * j4 + 3] = ya.w; va[8 * j4 + 4] = yb.x; va[8 * j4 + 5] = yb.y; va[8 * j4 + 6] = yb.z; va[8 * j4 + 7] = yb.w; }
                else { vb[8 * j4 - 16] = ya.x; vb[8 * j4 - 15] = ya.y; vb[8 * j4 - 14] = ya.z; vb[8 * j4 - 13] = ya.w; vb[8 * j4 - 12] = yb.x; vb[8 * j4 - 11] = yb.y; vb[8 * j4 - 10] = yb.z; vb[8 * j4 - 9] = yb.w; }
                const bf16x8 yh = __builtin_bit_cast(bf16x8, h), yl = __builtin_bit_cast(bf16x8, l);
#pragma unroll
                for (int et = 0; et < 2; ++et) {
                    const bf16x8 wh = *(const LAS bf16x8*)(wb + (16 * et) * WROW + kl * 64), wl = *(const LAS bf16x8*)(wb + (32 + 16 * et) * WROW + kl * 64);
                    acc[et] = __builtin_amdgcn_mfma_f32_16x16x32_bf16(wh, yh, acc[et], 0, 0, 0);
                    acc[et] = __builtin_amdgcn_mfma_f32_16x16x32_bf16(wh, yl, acc[et], 0, 0, 0);
                    acc[et] = __builtin_amdgcn_mfma_f32_16x16x32_bf16(wl, yh, acc[et], 0, 0, 0); } }
            u32x4 w0, w1; mx6_pack(va, vb, w0, w1);
            *(u32x4*)(trow + 128 * ss) = w0; *(u32x4*)(trow + 128 * ss + 64) = w1;
        }
        if (c < 7) RT_WSTORE((c + 1) & 1);
        __syncthreads();
    }
#undef RT_WLOAD
#undef RT_WSTORE
#pragma unroll
    for (int et = 0; et < 2; ++et)
#pragma unroll
        for (int i = 0; i < 4; ++i) { const int e = 16 * et + 4 * quad + i; lgL[(w * 16 + fr) * 33 + e] = acc[et][i] + F.b_r[e]; }
    __syncthreads();
    int ev[4]; float gv[4]; unsigned lp[4];
    const int mytok = unit * 128 + 16 * w + lane;
    if (lane < 16) {
        const LAS float* lg = lgL + (w * 16 + lane) * 33; unsigned mask = 0u; float vv[4];
#pragma unroll
        for (int k = 0; k < 4; ++k) { float best = -INFINITY; int bi = 0;
            for (int e = 0; e < 32; ++e) { const float v = lg[e]; if (!((mask >> e) & 1u) && v > best) { best = v; bi = e; } }
            mask |= 1u << bi; ev[k] = bi; vv[k] = best; }
        const float e1 = __expf(vv[1] - vv[0]), e2 = __expf(vv[2] - vv[0]), e3 = __expf(vv[3] - vv[0]); const float inv = 1.0f / (1.0f + e1 + e2 + e3);
        gv[0] = inv; gv[1] = e1 * inv; gv[2] = e2 * inv; gv[3] = e3 * inv;
#pragma unroll
        for (int k = 0; k < 4; ++k) lp[k] = __hip_atomic_fetch_add(histL + ev[k], 1u, __ATOMIC_RELAXED, __HIP_MEMORY_SCOPE_WORKGROUP);
    }
    __syncthreads();
    if (tid < 32) baseL[tid] = __hip_atomic_fetch_add((unsigned*)(F.ctl + CW_CNT + 64 * tid), histL[tid], RLX_AGENT);
    __syncthreads();
    if (lane < 16) {
#pragma unroll
        for (int k = 0; k < 4; ++k) { const unsigned pos = baseL[ev[k]] + lp[k];
            F.LIST[(size_t)ev[k] * CAP + pos] = mytok * 4 + k; F.GATE[(size_t)mytok * 4 + k] = gv[k]; }
    }
}

__device__ __forceinline__ int moe_tables(Frame& F) {
    LAS int* cntL = (LAS int*)(F.lds + XT_CNT); LAS int* tstartL = (LAS int*)(F.lds + XT_TSTART); LAS unsigned char* tileE = F.lds + XT_TILEE;
    __syncthreads();
    if (F.tid < 32) cntL[F.tid] = (int)__hip_atomic_load((unsigned*)(F.ctl + CW_CNT + 64 * F.tid), RLX_AGENT);
    __syncthreads();
    if (F.tid == 0) { int s = 0; for (int e = 0; e < 32; ++e) { tstartL[e] = s; s += (cntL[e] + 255) >> 8; } tstartL[32] = s; }
    __syncthreads();
    const int total = tstartL[32];
    for (int mt = F.tid; mt < total; mt += 512) { int e = 0; for (int k = 1; k < 32; ++k) e += (tstartL[k] <= mt) ? 1 : 0; tileE[mt] = (unsigned char)e; }
    __syncthreads();
    return __builtin_amdgcn_readfirstlane(total);
}

struct Args { const float* in[19]; float* out; unsigned char* ws; int ph_lo, ph_hi; };
__global__ void __launch_bounds__(NWAVES * 64, 2) mk_fwd(Args args) {
    extern __shared__ __attribute__((aligned(16))) unsigned char lds[];
    Frame F;
    F.lds = (LAS unsigned char*)lds;
    F.MISC = (volatile LAS unsigned*)(F.lds + MISC_OFF);
    F.tid = threadIdx.x; F.lane = F.tid & 63; F.wave = __builtin_amdgcn_readfirstlane(F.tid >> 6);
    F.G = gridDim.x; { const int bx = blockIdx.x; F.vcu = (F.G % 8 == 0) ? (bx % 8) * (F.G / 8) + bx / 8 : bx; }
    unsigned char* ws = args.ws;
    F.ctl = (gu32*)(ws + WS_CTL);
    F.x = args.in[0]; F.g1 = args.in[1]; F.w_in = args.in[2]; F.gq = args.in[3]; F.gk = args.in[4]; F.rpb = args.in[5]; F.gsg = args.in[6]; F.w_sp = args.in[7]; F.b_sp = args.in[8];
    F.ga = args.in[9]; F.gs = args.in[10]; F.w_out = args.in[11]; F.g2 = args.in[12]; F.w_r = args.in[13]; F.b_r = args.in[14]; F.w_gu = args.in[15]; F.b_gu = args.in[16]; F.w_dn = args.in[17]; F.b_dn = args.in[18];
    F.out = args.out;
    F.WIN = (bf16*)(ws + WS_WIN); F.WOUT = (bf16*)(ws + WS_WOUT); F.WSP = (bf16*)(ws + WS_WSP); F.WRH = (bf16*)(ws + WS_WRH); F.WRL = (bf16*)(ws + WS_WRL);
    F.WGU = ws + WS_WGU; F.WDN = ws + WS_WDN; F.H = (bf16*)(ws + WS_H); F.H8 = ws + WS_H; F.PROJ = (bf16*)(ws + WS_PROJ); F.X2B = (bf16*)(ws + WS_PROJ);     F.MIX = (bf16*)(ws + WS_MIX);
    F.ACT = ws + WS_ACT; F.Y = ws + WS_Y; F.RMS1 = (float*)(ws + WS_RMS1); F.IG1 = (float*)(ws + WS_IG1); F.SSX = (float*)(ws + WS_SSX); F.RA = (float*)(ws + WS_RA); F.RB = (float*)(ws + WS_RB); F.SSQA = (float*)(ws + WS_SSQA); F.SSG = (float*)(ws + WS_SSG); F.RSTD2 = (float*)(ws + WS_RSTD2); F.GATE = (float*)(ws + WS_GATE); F.SLOT = (unsigned*)(ws + WS_SLOT); F.LIST = (int*)(ws + WS_LIST);
    for (int u = F.tid; u < (LDS_BYTES - LDSCTL_OFF) / 4; u += NWAVES * 64) ((LAS unsigned*)(F.lds + LDSCTL_OFF))[u] = 0u;
    __syncthreads();
    XcdBarrier bar; bar.bar = (unsigned*)(F.ctl + CW_BAR); bar.x = 0; bar.st = nullptr;
    if (N_LAUNCHES == 1) bar = xcd_barrier_post((unsigned*)(F.ctl + CW_BAR), F.MISC + 8);
#define GRID_BAR() do { if (N_LAUNCHES == 1) xcd_barrier(bar); } while (0)
    const int lo = args.ph_lo, hi = args.ph_hi;
#define IN(k) (lo <= (k) && (k) < hi)
#define BOTH(k) (IN(k) && IN((k) + 1))

    if (IN(0)) { p0_prologue(F); if (BOTH(0)) GRID_BAR(); }

    if (IN(1)) {
        TileOrder S; S.init(NTOK / BM, NPROJ / BM, F.G, (int)blockIdx.x, nullptr);
        EpiProjX E{F.PROJ, F.gq, F.gk, F.SSG};
        const int grp = F.vcu & 1, nconv = (NE * (16 * 16 + 16 * 8) - F.vcu + F.G - 1) / F.G, hconv = nconv / 2;
        moe_convert(F, 0, grp == 0 ? hconv : 0);
        S.ib = 0; S.ie = 5;
        gemm_phase<EpiProjX, false, true, false>(F.lds, (const char*)F.H, (const char*)F.WIN, 0, DM * 2, S, E, nullptr);
        moe_convert(F, grp == 0 ? hconv : 0, grp == 0 ? nconv : hconv);
        S.ib = 5; S.ie = 0x7fffffff;
        gemm_phase<EpiProjX, false, true, false>(F.lds, (const char*)F.H, (const char*)F.WIN, 0, DM * 2, S, E, nullptr);
        moe_convert(F, grp == 0 ? nconv : hconv, nconv);
        if (BOTH(1)) GRID_BAR();
    }

    if (IN(2)) {
        for (int u = F.vcu; u < NBATCH * 16 * 8; u += F.G) attn_unit(F, u >> 7, (u >> 3) & 15, u & 7);
        if (BOTH(2)) GRID_BAR();
    }

    if (IN(3)) {
        for (int u = F.vcu; u < NTOK / 128; u += F.G) sgu_unit(F, u);
        if (BOTH(3)) GRID_BAR();
    }

    if (IN(4)) {
        TileOrder S; S.init(NTOK / BM, DM / BM, F.G, (int)blockIdx.x, nullptr);
        EpiResid E{F.H, F.RMS1, F.IG1, F.X2B, DM, F.RA, F.RB, F.SSX};
        gemm_phase<EpiResid, false, true, false>(F.lds, (const char*)F.MIX, (const char*)F.WOUT, 0, DM * 2, S, E, nullptr);
        if (BOTH(4)) GRID_BAR();
    }

    if (IN(5)) {
        for (int u = F.vcu; u < NTOK / 128; u += F.G) router_unit(F, u);
        if (BOTH(5)) GRID_BAR();
    }

    if (IN(6)) {
        const int total = moe_tables(F);
        LAS unsigned short* tokL = (LAS unsigned short*)(F.lds + XT_TOKL); const LAS int* cntL = (const LAS int*)(F.lds + XT_CNT); const LAS int* tstartL = (const LAS int*)(F.lds + XT_TSTART);
        TileOrder S; S.init(total, 16, F.G, (int)blockIdx.x, F.lds + XT_TILEE);
        { Unit u; for (int i = 0; i < 36 && S.next(i, u); ++i) { if (F.tid < 256) { const int lp = (u.pm - tstartL[u.e]) * 256 + F.tid; tokL[i * 256 + F.tid] = (unsigned short)(lp < cntL[u.e] ? (F.LIST[(size_t)u.e * CAP + lp] >> 2) : 0); } } }
        __syncthreads();
        EpiSwiglu E{F.ACT, F.b_gu, (const LAS float*)(F.lds + XT_BIAS), (unsigned)(size_t)(F.lds + XT_BIAS)};
        gemm_phase<EpiSwiglu, true, true, true>(F.lds, (const char*)F.H8, (const char*)F.WGU, (size_t)4096 * DM, DM, S, E, tokL);
        if (BOTH(6)) GRID_BAR();
    }

    if (IN(7)) {
        const int total = moe_tables(F);
        LAS unsigned* dstL = (LAS unsigned*)(F.lds + XT_TOKL); const LAS int* cntL = (const LAS int*)(F.lds + XT_CNT); const LAS int* tstartL = (const LAS int*)(F.lds + XT_TSTART);
        TileOrder S; S.init(total, 8, F.G, (int)blockIdx.x, F.lds + XT_TILEE);
        { Unit u; for (int i = 0; i < 18 && S.next(i, u); ++i) { if (F.tid < 256) { const int lp = (u.pm - tstartL[u.e]) * 256 + F.tid; dstL[i * 256 + F.tid] = lp < cntL[u.e] ? (unsigned)F.LIST[(size_t)u.e * CAP + lp] : (unsigned)(NTOK * TOPK); } } }
        __syncthreads();
        EpiDown E{F.Y, F.b_dn, dstL, (const LAS float*)(F.lds + XT_BIAS), (unsigned)(size_t)(F.lds + XT_BIAS)};
        gemm_phase<EpiDown, false, true, true>(F.lds, (const char*)F.ACT, (const char*)F.WDN, (size_t)DM * DM, DM, S, E, nullptr);
        if (BOTH(7)) GRID_BAR();
    }

    if (IN(8)) {
        const int gw = F.vcu * NWAVES + F.wave, NGW = F.G * NWAVES, lane = F.lane;
        for (int t = gw; t < NTOK; t += NGW) {
            const f32x4 gt = *(const f32x4*)(F.GATE + (size_t)t * 4);
            float* orow = F.out + (size_t)t * DM + 16 * lane; const unsigned char* yrow = F.Y + (size_t)t * 4 * DM + 16 * lane; const bf16* xrow = F.X2B + (size_t)t * DM + 16 * lane;
#pragma unroll
            for (int j = 0; j < 2; ++j) { f32x4 o[4];
                const u32x4 xlo = *(const u32x4*)(xrow + 1024 * j), xhi = *(const u32x4*)(xrow + 1024 * j + 8);
                o[0] = (f32x4){bflo(xlo.x), bfhi(xlo.x), bflo(xlo.y), bfhi(xlo.y)}; o[1] = (f32x4){bflo(xlo.z), bfhi(xlo.z), bflo(xlo.w), bfhi(xlo.w)};
                o[2] = (f32x4){bflo(xhi.x), bfhi(xhi.x), bflo(xhi.y), bfhi(xhi.y)}; o[3] = (f32x4){bflo(xhi.z), bfhi(xhi.z), bflo(xhi.w), bfhi(xhi.w)};
#pragma unroll
                for (int k = 0; k < 4; ++k) { const u32x4 y = *(const u32x4*)(yrow + (size_t)k * DM + 1024 * j); const float g = gt[k];
#pragma unroll
                    for (int q = 0; q < 4; ++q) { const f32x2 lo = __builtin_amdgcn_cvt_pk_f32_fp8((int)y[q], false), hi = __builtin_amdgcn_cvt_pk_f32_fp8((int)y[q], true);
                        o[q].x += g * lo.x; o[q].y += g * lo.y; o[q].z += g * hi.x; o[q].w += g * hi.y; } }
#pragma unroll
                for (int q = 0; q < 4; ++q) *(f32x4*)(orow + 1024 * j + 4 * q) = o[q]; }
        }
    }
#undef IN
#undef BOTH
}

extern "C" void kernel_launch(void* const* d_in, const int* in_sizes, int n_in, void* d_out, int out_size, void* d_ws, size_t ws_size, hipStream_t stream) {
    static int grid = 0;
    if (grid == 0) {
        if (n_in != 19 || out_size != NTOK * DM || ws_size < WS_END) { fprintf(stderr, "kernel_launch: unexpected problem (n_in %d, out %d, ws %zu)\n", n_in, out_size, ws_size); grid = -1; return; }
        int dev = 0, cus = 0, per_cu = 0;
        if (hipGetDevice(&dev) != hipSuccess || hipDeviceGetAttribute(&cus, hipDeviceAttributeMultiprocessorCount, dev) != hipSuccess) { grid = -1; return; }
        if (hipFuncSetAttribute((const void*)mk_fwd, hipFuncAttributeMaxDynamicSharedMemorySize, LDS_BYTES) != hipSuccess) { fprintf(stderr, "kernel_launch: hipFuncSetAttribute failed\n"); grid = -1; return; }
        if (hipOccupancyMaxActiveBlocksPerMultiprocessor(&per_cu, (const void*)mk_fwd, NWAVES * 64, LDS_BYTES) != hipSuccess || per_cu < 1) { fprintf(stderr, "kernel_launch: occupancy query says %d\n", per_cu); }
        (void)hipGetLastError();
        grid = cus;
    }
    if (grid < 0) return;
    if (hipMemsetAsync((char*)d_ws + WS_CTL, 0, CTL_ZERO_BYTES, stream) != hipSuccess) return;
    Args a{};
    for (int i = 0; i < 19; ++i) a.in[i] = (const float*)d_in[i];
    a.out = (float*)d_out; a.ws = (unsigned char*)d_ws;
    for (int li = 0; li < N_LAUNCHES; ++li) {
        a.ph_lo = (N_LAUNCHES == 1) ? 0 : li; a.ph_hi = (N_LAUNCHES == 1) ? N_PHASES : li + 1;
        hipLaunchKernelGGL(mk_fwd, dim3(grid), dim3(NWAVES * 64), LDS_BYTES, stream, a);
    }
}
```

```cpp
#include <hip/hip_runtime.h>
#include <cstdio>
#include <cstdint>

#ifndef MK_N_LAUNCHES
#define MK_N_LAUNCHES 1
#endif
constexpr int N_LAUNCHES = MK_N_LAUNCHES;
constexpr int N_PHASES = 9;

#define LAS __attribute__((address_space(3)))
#define GAS __attribute__((address_space(1)))
typedef unsigned short bf16;
typedef short bf16x8 __attribute__((ext_vector_type(8)));
typedef short s16x4 __attribute__((ext_vector_type(4)));
typedef float f32x4 __attribute__((ext_vector_type(4)));
typedef float f32x2 __attribute__((ext_vector_type(2)));
typedef unsigned u32x4 __attribute__((ext_vector_type(4)));
typedef unsigned u32x2 __attribute__((ext_vector_type(2)));
typedef GAS unsigned gu32;
typedef int v8i __attribute__((ext_vector_type(8)));
typedef int v4i __attribute__((ext_vector_type(4)));
typedef int v6i __attribute__((ext_vector_type(6)));
typedef float v16f __attribute__((ext_vector_type(16)));

constexpr int NTOK = 32768, DM = 2048, NPROJ = 5120, SEQ = 8192, NBATCH = 4;
constexpr int NE = 32, TOPK = 4, CAP = 32768;
constexpr int MAXROWS = NTOK * TOPK + NE * 256;
constexpr float EPS = 1e-6f;
constexpr float SWC = -1.702f * 1.4426950408889634f, SWIC = 1.0f / SWC;
constexpr int NWAVES = 8;

constexpr size_t MiB = 1u << 20;
constexpr size_t WS_CTL = 0, CTL_ZERO_BYTES = 64 * 1024;
constexpr size_t WS_WIN = 2 * MiB;
constexpr size_t WS_WOUT = 22 * MiB;
constexpr size_t WS_WSP = 30 * MiB;
constexpr size_t WS_WRH = 31 * MiB;
constexpr size_t WS_WRL = 31 * MiB + 128 * 1024;
constexpr size_t WS_RSTD2 = 31 * MiB + 512 * 1024;
constexpr size_t WS_SLOT = 32 * MiB;
constexpr size_t WS_GATE = 32 * MiB + 512 * 1024;
constexpr size_t WS_LIST = 33 * MiB;
constexpr size_t WS_WGU = 40 * MiB;
constexpr size_t WS_SSQA = 300 * MiB;
constexpr size_t WS_SSG = 304 * MiB;
constexpr size_t WS_RA = 308 * MiB;
constexpr size_t WS_RB = 309 * MiB;
constexpr size_t WS_SSX = 312 * MiB;
constexpr size_t WS_RMS1 = 310 * MiB;
constexpr size_t WS_IG1 = 311 * MiB;
constexpr size_t WS_WDN = 552 * MiB;
constexpr size_t WS_H = 808 * MiB;
constexpr size_t WS_PROJ = 936 * MiB;
constexpr size_t WS_MIX = 1256 * MiB;
constexpr size_t WS_ACT = 1384 * MiB;
constexpr size_t WS_Y = 1928 * MiB;
constexpr size_t WS_END = 2472 * MiB;

constexpr int CW_TMO = 0, CW_CODE = 1;
constexpr int CW_BAR = 4096;
constexpr int CW_CNT = 8192;

constexpr int RING_BYTES = 131072;
constexpr int XT_OFF = RING_BYTES;
constexpr int XT_TOKL = XT_OFF;
constexpr int XT_TILEE = XT_OFF + 18432;
constexpr int XT_TSTART = XT_TILEE + 576;
constexpr int XT_CNT = XT_TSTART + 160;
constexpr int XT_BIAS = XT_OFF + 19456;
constexpr int XT_GAINS = XT_BIAS + 2048;
constexpr int XT_MISC2 = XT_GAINS + 512;
constexpr int AT_RPB = 147456;
constexpr int AT_MRG = AT_RPB + 2048;
constexpr int LDSCTL_OFF = AT_MRG + 10240;
constexpr int MISC_OFF = LDSCTL_OFF + 320;
constexpr int LDS_BYTES = LDSCTL_OFF + 1024;
static_assert(XT_CNT + 128 <= XT_BIAS && XT_MISC2 <= LDSCTL_OFF && LDS_BYTES <= 160 * 1024, "LDS map");
constexpr int N_PH = 9;

#define RLX_AGENT __ATOMIC_RELAXED, __HIP_MEMORY_SCOPE_AGENT
#define LDS_WAIT() asm volatile("s_waitcnt lgkmcnt(0)" ::: "memory")
#define VM_WAIT() asm volatile("s_waitcnt vmcnt(0)" ::: "memory")

__device__ __forceinline__ unsigned cvt_pk_bf16(float lo, float hi) { unsigned r; asm volatile("v_cvt_pk_bf16_f32 %0, %1, %2" : "=v"(r) : "v"(lo), "v"(hi)); return r; }
__device__ __forceinline__ unsigned pk4_fp8(float a, float b, float c, float d) { int w = 0; w = __builtin_amdgcn_cvt_pk_fp8_f32(a, b, w, false); w = __builtin_amdgcn_cvt_pk_fp8_f32(c, d, w, true); return (unsigned)w; }
__device__ __forceinline__ v8i cat8(bf16x8 a, bf16x8 b) { const v4i x = __builtin_bit_cast(v4i, a), y = __builtin_bit_cast(v4i, b); return __builtin_shufflevector(x, y, 0, 1, 2, 3, 4, 5, 6, 7); }
__device__ __forceinline__ bf16x8 lo8(v8i a) { return __builtin_bit_cast(bf16x8, (v4i)__builtin_shufflevector(a, a, 0, 1, 2, 3)); }
__device__ __forceinline__ bf16x8 hi8(v8i a) { return __builtin_bit_cast(bf16x8, (v4i)__builtin_shufflevector(a, a, 4, 5, 6, 7)); }
__device__ __forceinline__ void glds16(const void* gsrc, unsigned lds_dst) { unsigned keep;
    asm volatile("s_mov_b32 %0, m0\n\ts_mov_b32 m0, %2\n\ts_nop 0\n\tglobal_load_lds_dwordx4 %1, off\n\ts_mov_b32 m0, %0" : "=&s"(keep) : "v"(gsrc), "s"(lds_dst) : "memory"); }
__device__ __forceinline__ u32x4 pair16(u32x2 a, u32x2 b) { const auto s0 = __builtin_amdgcn_permlane16_swap(a.x, b.x, false, false), s1 = __builtin_amdgcn_permlane16_swap(a.y, b.y, false, false);
    u32x4 w; w.x = s0[0]; w.y = s1[0]; w.z = s0[1]; w.w = s1[1]; return w; }
__device__ __forceinline__ void mx6_pack(v16f a, v16f b, u32x4& w0, u32x4& w1) {
    float m0 = 0.f, m1 = 0.f;
#pragma unroll
    for (int i = 0; i < 16; ++i) { m0 = fmaxf(m0, fabsf(a[i])); m1 = fmaxf(m1, fabsf(b[i])); }
    const float mx = fmaxf(m0, m1);
    int sb = (int)(((__float_as_uint(mx) + 0x00100000u) >> 23) & 0xffu) - 2;
    sb = sb < 2 ? 2 : (sb > 250 ? 250 : sb);
    const float scl = __uint_as_float((unsigned)sb << 23);
    v6i r; asm volatile("v_cvt_scalef32_2xpk16_fp6_f32 %0, %1, %2, %3" : "=&v"(r) : "v"(a), "v"(b), "v"(scl));
    w0.x = (unsigned)r[0]; w0.y = (unsigned)r[1]; w0.z = (unsigned)r[2]; w0.w = (unsigned)r[3];
    w1.x = (unsigned)r[4]; w1.y = (unsigned)r[5]; w1.z = (unsigned)sb; w1.w = 0u;
}
__device__ __forceinline__ float bflo(unsigned u) { return __uint_as_float(u << 16); }
__device__ __forceinline__ float bfhi(unsigned u) { return __uint_as_float(u & 0xffff0000u); }
__device__ __forceinline__ float quad_sum(float v) {
    const auto a = __builtin_amdgcn_permlane16_swap(__float_as_uint(v), __float_as_uint(v), false, false); v = __uint_as_float(a[0]) + __uint_as_float(a[1]);
    const auto b = __builtin_amdgcn_permlane32_swap(__float_as_uint(v), __float_as_uint(v), false, false); return __uint_as_float(b[0]) + __uint_as_float(b[1]); }
__device__ __forceinline__ float quad_max(float v) {
    const auto a = __builtin_amdgcn_permlane16_swap(__float_as_uint(v), __float_as_uint(v), false, false); v = fmaxf(__uint_as_float(a[0]), __uint_as_float(a[1]));
    const auto b = __builtin_amdgcn_permlane32_swap(__float_as_uint(v), __float_as_uint(v), false, false); return fmaxf(__uint_as_float(b[0]), __uint_as_float(b[1])); }
#define DPP_F(v_, ctrl_) __uint_as_float((unsigned)__builtin_amdgcn_update_dpp(0, (int)__float_as_uint(v_), ctrl_, 0xF, 0xF, true))
__device__ __forceinline__ float wave_sum(float v) {
    v += DPP_F(v, 0xB1); v += DPP_F(v, 0x4E); v += DPP_F(v, 0x124); v += DPP_F(v, 0x128);
    return quad_sum(v);
}
__device__ __forceinline__ f32x2 gelu_pk(f32x2 v) {
    const f32x2 av = __builtin_elementwise_abs(v), d = av * 0.2316418882f + 1.0f;
    f32x2 t; t.x = __builtin_amdgcn_rcpf(d.x); t.y = __builtin_amdgcn_rcpf(d.y);
    f32x2 q = t * 0.5307027145f + (-0.7265760135f); q = q * t + 0.7107068705f; q = q * t + (-0.142248368f); q = q * t + 0.127414796f; q = q * t;
    const f32x2 s = (v * v) * (-0.72134752044f);
    f32x2 e; e.x = __builtin_amdgcn_exp2f(s.x); e.y = __builtin_amdgcn_exp2f(s.y);
    const f32x2 m = v * (q * e), r = v - m;
    f32x2 o; o.x = v.x < 0.f ? m.x : r.x; o.y = v.y < 0.f ? m.y : r.y; return o;
}
__device__ __forceinline__ float gelu1(float x) { f32x2 r = gelu_pk((f32x2){x, x}); return r.x; }

#define XB_TMO      128
#define XB_XCNT(j)  (256  + 64 * (j))
#define XB_XSUB(j)  (1280 + 64 * (j))
#define XB_XGEN(j)  (2304 + 64 * (j))
#define XB_TOP      3328
#define XB_TOPGEN   3392
#define XCD_BAR_WORDS 3456
#define XB_SPIN_CAP (1u << 18)
__device__ __forceinline__ unsigned xb_ld(unsigned* p)              { return __hip_atomic_load(p, __ATOMIC_RELAXED, __HIP_MEMORY_SCOPE_AGENT); }
__device__ __forceinline__ unsigned xb_add(unsigned* p, unsigned v) { return __hip_atomic_fetch_add(p, v, __ATOMIC_RELAXED, __HIP_MEMORY_SCOPE_AGENT); }
__device__ __forceinline__ unsigned xb_xcc_id() { return (unsigned)__builtin_amdgcn_s_getreg((3 << 11) | 20) & 0xFu; }
#define XB_SPIN(cond, bar) do { unsigned _sp = 0; while (cond) { __builtin_amdgcn_s_sleep(1); \
    if ((++_sp & 255u) == 0u) { if (xb_ld(&(bar)[XB_TMO])) break; if (_sp > XB_SPIN_CAP) { atomicAdd(&(bar)[XB_TMO], 1u); break; } } } } while (0)
struct XcdBarrier { unsigned* bar; unsigned x; volatile LAS unsigned* st; };
__device__ __forceinline__ XcdBarrier xcd_barrier_post(unsigned* bar, volatile LAS unsigned* st) {
    XcdBarrier b; b.bar = bar; b.x = xb_xcc_id(); b.st = st;
    if (threadIdx.x == 0) (void)xb_add(&bar[XB_XCNT(b.x)], 1u);
    return b;
}
__device__ __forceinline__ void xcd_barrier_complete(unsigned* bar, unsigned x, unsigned& nloc, unsigned& nx) {
    const unsigned G = gridDim.x * gridDim.y * gridDim.z;
    unsigned sum, cnt, mine, sp = 0u;
    for (;;) {
        sum = 0u; cnt = 0u; mine = 0u;
#pragma unroll
        for (unsigned j = 0; j < 16; ++j) { const unsigned c = xb_ld(&bar[XB_XCNT(j)]); sum += c; cnt += (c > 0u) ? 1u : 0u; mine = (j == x) ? c : mine; }
        if (sum == G) break;
        __builtin_amdgcn_s_sleep(1);
        if ((++sp & 255u) == 0u) { if (xb_ld(&bar[XB_TMO])) break; if (sp > XB_SPIN_CAP) { atomicAdd(&bar[XB_TMO], 1u); break; } }
    }
    nloc = mine > 0u ? mine : 1u; nx = cnt > 0u ? cnt : 1u;
}
__device__ __forceinline__ void xcd_barrier(const XcdBarrier& b) {
    asm volatile("s_waitcnt vmcnt(0)" ::: "memory");
    __syncthreads();
    if (threadIdx.x == 0) {
        unsigned* bar = b.bar;
        __builtin_amdgcn_s_waitcnt(0);
        unsigned nloc = b.st[0], nx = b.st[1];
        if (nloc == 0u) { xcd_barrier_complete(bar, b.x, nloc, nx); b.st[0] = nloc; b.st[1] = nx; }
        const unsigned old = xb_add(&bar[XB_XSUB(b.x)], 1u);
        const unsigned gen = old / nloc;
        if (old + 1u == (gen + 1u) * nloc) {
            __builtin_amdgcn_fence(__ATOMIC_RELEASE, "agent");
            asm volatile("s_waitcnt vmcnt(0)" ::: "memory");
            const unsigned og = xb_add(&bar[XB_TOP], 1u);
            const unsigned tg = og / nx;
            if (og + 1u == (tg + 1u) * nx) xb_add(&bar[XB_TOPGEN], 1u);
            else XB_SPIN(xb_ld(&bar[XB_TOPGEN]) == tg, bar);
            __builtin_amdgcn_fence(__ATOMIC_ACQUIRE, "agent");
            xb_add(&bar[XB_XGEN(b.x)], 1u);
            asm volatile("s_waitcnt vmcnt(0)" ::: "memory");
        } else {
            XB_SPIN(xb_ld(&bar[XB_XGEN(b.x)]) == gen, bar);
            __builtin_amdgcn_fence(__ATOMIC_ACQUIRE, "agent");
            asm volatile("s_waitcnt vmcnt(0)" ::: "memory");
        }
    }
    __syncthreads();
}

constexpr int BM = 256, BK = 64, HALF = 128, HTB = HALF * BK * 2, NXCD = 8, WGM = 8;
__host__ __device__ __forceinline__ int lds_byte(int r, int c) { const int st = (r >> 4) * 2 + (c >> 5), rr = r & 15, cc = c & 31, ob = rr * 64 + cc * 2; return st * 1024 + (ob ^ (((ob >> 9) & 1) << 5)); }
__host__ __device__ __forceinline__ void stage_rc(int b, int& R, int& C) { const int st = b / 1024, sb = b % 1024, swz = sb ^ (((sb >> 9) & 1) << 5); R = (st >> 1) * 16 + swz / 64; C = (st & 1) * 32 + (swz % 64) / 2; }
__host__ __device__ __forceinline__ int perm32(int rho) { const int n = rho >> 4, i = rho & 15; return 8 * (i >> 2) + 4 * n + (i & 3); }

struct Unit { int pm, pn, e, ui; };
struct TileOrder {
    int nM, nN, nwg, G, c, ib, ie; const LAS unsigned char* tileE;
    __device__ __forceinline__ void init(int nM_, int nN_, int G_, int c_, const LAS unsigned char* te) { nM = nM_; nN = nN_; nwg = nM * nN; G = G_; c = c_; tileE = te; ib = 0; ie = 0x7fffffff; }
    __device__ __forceinline__ bool next(int i_, Unit& u) const {
        const int i = ib + i_; if (i >= ie) return false;
        const long L = (long)i * G + c; if (L >= nwg) return false;
        int wgid = (int)L; { const int q = nwg / NXCD, r = nwg % NXCD, xcd = wgid % NXCD, off = wgid / NXCD; wgid = (xcd < r ? xcd * (q + 1) : r * (q + 1) + (xcd - r) * q) + off; }
        const int nig = WGM * nN, gid = wgid / nig, fm = gid * WGM, gsz = (nM - fm) < WGM ? (nM - fm) : WGM;
        u.pm = fm + ((wgid % nig) % gsz); u.pn = (wgid % nig) / gsz; u.ui = i;
        u.e = tileE ? __builtin_amdgcn_readfirstlane((int)tileE[u.pm]) : 0;
        return true;
    }
    __device__ __forceinline__ bool at(int i_, Unit& u) const {
        const int i = ib + i_; const long L0 = (long)i * G + c; const bool ok = (i < ie) && (L0 < nwg); const long L = L0 < nwg ? L0 : nwg - 1;
        int wgid = (int)L; { const int q = nwg / NXCD, r = nwg % NXCD, xcd = wgid % NXCD, off = wgid / NXCD; wgid = (xcd < r ? xcd * (q + 1) : r * (q + 1) + (xcd - r) * q) + off; }
        const int nig = WGM * nN, gid = wgid / nig, fm = gid * WGM, gsz = (nM - fm) < WGM ? (nM - fm) : WGM;
        u.pm = fm + ((wgid % nig) % gsz); u.pn = (wgid % nig) / gsz; u.ui = i;
        u.e = tileE ? __builtin_amdgcn_readfirstlane((int)tileE[u.pm]) : 0;
        return ok;
    }
};

struct EpiProjX {
    static constexpr bool MIDK = false, BIASL = false, ACCINIT = false;
    static constexpr bool PERM = true;
    bf16* O; const float* gq; const float* gk; float* SSG; const LAS float* gL;
    __device__ __forceinline__ void operator()(const f32x4 (&acc)[2][2][4][2], const Unit& u, int wr, int wc, int fr, int fq) const {
        const int row0 = u.pm * BM + wr * 64 + fr, col0 = u.pn * BM + wc * 64 + 8 * fq, kind = u.pn >> 2;
        if (kind <= 1) {
            const LAS float* gp = gL + (kind == 0 ? 0 : 64) + 8 * fq; const float qs = kind == 0 ? 0.125f * 1.4426950408889634f : 1.0f;
            const f32x4 g00 = *(const LAS f32x4*)(gp), g01 = *(const LAS f32x4*)(gp + 4), g10 = *(const LAS f32x4*)(gp + 32), g11 = *(const LAS f32x4*)(gp + 36);
#pragma unroll
            for (int ai = 0; ai < 2; ++ai)
#pragma unroll
                for (int m = 0; m < 4; ++m) { const f32x4 a = acc[ai][0][m][0], b = acc[ai][0][m][1], c = acc[ai][1][m][0], d = acc[ai][1][m][1];
                    float ss = (a.x * a.x + a.y * a.y) + (a.z * a.z + a.w * a.w) + (b.x * b.x + b.y * b.y) + (b.z * b.z + b.w * b.w) + (c.x * c.x + c.y * c.y) + (c.z * c.z + c.w * c.w) + (d.x * d.x + d.y * d.y) + (d.z * d.z + d.w * d.w);
                    ss = quad_sum(ss);
                    const float r = qs / sqrtf(ss * (1.0f / 64.0f) + EPS);
                    const f32x4 oa = a * r * g00, ob = b * r * g01, oc = c * r * g10, od = d * r * g11;
                    bf16* rowp = O + (size_t)(row0 + ai * HALF + m * 16) * NPROJ + col0;
                    u32x4 w0, w1; w0.x = cvt_pk_bf16(oa.x, oa.y); w0.y = cvt_pk_bf16(oa.z, oa.w); w0.z = cvt_pk_bf16(ob.x, ob.y); w0.w = cvt_pk_bf16(ob.z, ob.w);
                    w1.x = cvt_pk_bf16(oc.x, oc.y); w1.y = cvt_pk_bf16(oc.z, oc.w); w1.z = cvt_pk_bf16(od.x, od.y); w1.w = cvt_pk_bf16(od.z, od.w);
                    *(u32x4*)(rowp) = w0; *(u32x4*)(rowp + 32) = w1; }
        } else if (kind == 2) {
#pragma unroll
            for (int ai = 0; ai < 2; ++ai)
#pragma unroll
                for (int m = 0; m < 4; ++m) { bf16* rowp = O + (size_t)(row0 + ai * HALF + m * 16) * NPROJ + col0;
#pragma unroll
                    for (int bj = 0; bj < 2; ++bj) { const f32x4 v0 = acc[ai][bj][m][0], v1 = acc[ai][bj][m][1];
                        u32x4 w; w.x = cvt_pk_bf16(v0[0], v0[1]); w.y = cvt_pk_bf16(v0[2], v0[3]); w.z = cvt_pk_bf16(v1[0], v1[1]); w.w = cvt_pk_bf16(v1[2], v1[3]);
                        *(u32x4*)(rowp + bj * 32) = w; } }
        } else {
#pragma unroll
            for (int ai = 0; ai < 2; ++ai)
#pragma unroll
                for (int m = 0; m < 4; ++m) { const int row = row0 + ai * HALF + m * 16; bf16* rowp = O + (size_t)row * NPROJ + col0; float ss = 0.f;
#pragma unroll
                    for (int bj = 0; bj < 2; ++bj) { const f32x4 v0 = acc[ai][bj][m][0], v1 = acc[ai][bj][m][1];
                        const f32x2 a = gelu_pk((f32x2){v0[0], v0[1]}), b = gelu_pk((f32x2){v0[2], v0[3]}), c = gelu_pk((f32x2){v1[0], v1[1]}), d = gelu_pk((f32x2){v1[2], v1[3]});
                        ss += (a.x * a.x + a.y * a.y) + (b.x * b.x + b.y * b.y) + (c.x * c.x + c.y * c.y) + (d.x * d.x + d.y * d.y);
                        u32x4 w; w.x = cvt_pk_bf16(a.x, a.y); w.y = cvt_pk_bf16(b.x, b.y); w.z = cvt_pk_bf16(c.x, c.y); w.w = cvt_pk_bf16(d.x, d.y);
                        *(u32x4*)(rowp + bj * 32) = w; }
                    if (kind == 4) { ss = quad_sum(ss); if (fq == 0) SSG[(size_t)row * 16 + (u.pn - 16) * 4 + wc] = ss; } }
        }
    }
};
struct EpiResid {
    static constexpr bool PERM = true, MIDK = true, BIASL = true, ACCINIT = false;
    const bf16* hb; const float* rms1; const float* ig1; bf16* x2b; int ldc; const float* RA; const float* RB; float* SSX; const LAS float* tabL; unsigned tabA;
    __device__ __forceinline__ void prefetch(const Unit& u, int wid, int lane) const {
        if (wid == 0) { glds16(RA + (size_t)u.pm * BM + lane * 4, tabA + (unsigned)(u.ui & 1) * 2048u); glds16(RB + (size_t)u.pm * BM + lane * 4, tabA + (unsigned)(u.ui & 1) * 2048u + 1024u); } }
    __device__ __forceinline__ void mid(f32x4 (&acc)[2][2][4][2], const Unit& u, int wr, int fr) const {
        const LAS float* tp = tabL + (u.ui & 1) * 512 + wr * 64 + fr;
#pragma unroll
        for (int ai = 0; ai < 2; ++ai)
#pragma unroll
            for (int m = 0; m < 4; ++m) { int ro = ai * HALF + m * 16; asm volatile("" : "+v"(ro));
                const float f = tp[ro] / tp[256 + ro];
#pragma unroll
                for (int bj = 0; bj < 2; ++bj)
#pragma unroll
                    for (int n = 0; n < 2; ++n) acc[ai][bj][m][n] = acc[ai][bj][m][n] * f; }
    }
    __device__ __forceinline__ void operator()(const f32x4 (&acc)[2][2][4][2], const Unit& u, int wr, int wc, int fr, int fq) const {
        const int row0 = u.pm * BM + wr * 64 + fr, col0 = u.pn * BM + wc * 32 + 8 * fq;
        f32x4 ig[2][2];
#pragma unroll
        for (int bj = 0; bj < 2; ++bj)
#pragma unroll
            for (int n = 0; n < 2; ++n) ig[bj][n] = *(const f32x4*)(ig1 + col0 + bj * HALF + 4 * n);
#pragma unroll
        for (int ai = 0; ai < 2; ++ai) {
            u32x4 hv[4][2]; float rb[4], rm[4];
#pragma unroll
            for (int m = 0; m < 4; ++m) { const int row = row0 + ai * HALF + m * 16; const size_t off = (size_t)row * ldc + col0; rb[m] = tabL[(u.ui & 1) * 512 + 256 + wr * 64 + ai * HALF + m * 16 + fr]; rm[m] = rms1[row];
#pragma unroll
                for (int bj = 0; bj < 2; ++bj) hv[m][bj] = *(const u32x4*)(hb + off + bj * HALF); }
#pragma unroll
            for (int m = 0; m < 4; ++m) { const int row = row0 + ai * HALF + m * 16; const size_t off = (size_t)row * ldc + col0;
                float ss = 0.f;
#pragma unroll
                for (int bj = 0; bj < 2; ++bj) { const u32x4 h = hv[m][bj];
                    const f32x4 x0 = (f32x4){bflo(h.x), bfhi(h.x), bflo(h.y), bfhi(h.y)} * ig[bj][0] * rm[m], x1 = (f32x4){bflo(h.z), bfhi(h.z), bflo(h.w), bfhi(h.w)} * ig[bj][1] * rm[m];
                    const f32x4 o0 = x0 + acc[ai][bj][m][0] * rb[m], o1 = x1 + acc[ai][bj][m][1] * rb[m];
                    ss += (o0.x * o0.x + o0.y * o0.y) + (o0.z * o0.z + o0.w * o0.w) + (o1.x * o1.x + o1.y * o1.y) + (o1.z * o1.z + o1.w * o1.w);
                    u32x4 w; w.x = cvt_pk_bf16(o0.x, o0.y); w.y = cvt_pk_bf16(o0.z, o0.w); w.z = cvt_pk_bf16(o1.x, o1.y); w.w = cvt_pk_bf16(o1.z, o1.w);
                    *(u32x4*)(x2b + off + bj * HALF) = w; }
                ss = quad_sum(ss);
                SSX[(size_t)row * 32 + u.pn * 4 + wc] = ss; }
        }
    }
};
struct EpiSwiglu {
    static constexpr bool MIDK = false, BIASL = true, ACCINIT = true;
    static constexpr bool PERM = true;
    unsigned char* act; const float* bgu; const LAS float* biasL; unsigned biasA;
    __device__ __forceinline__ void prefetch(const Unit& u, int wid, int lane) const {
        if (wid == 0) glds16(bgu + (size_t)u.e * 4096 + u.pn * 128 + (lane & 31) * 4 + (lane >> 5) * 2048, biasA + (unsigned)(u.ui & 1) * 1024u); }
    __device__ __forceinline__ void init(f32x4 (&acc)[2][2][4][2], const Unit& u, int wc, int fq) const {
        const int jl = wc * 32 + 8 * fq;
        const LAS float* bp = biasL + (u.ui & 1) * 256 + jl;
        const f32x4 bg0 = *(const LAS f32x4*)(bp), bg1 = *(const LAS f32x4*)(bp + 4), bl0 = (*(const LAS f32x4*)(bp + 128) + 1.0f) * SWIC, bl1 = (*(const LAS f32x4*)(bp + 132) + 1.0f) * SWIC;
#pragma unroll
        for (int ai = 0; ai < 2; ++ai)
#pragma unroll
            for (int m = 0; m < 4; ++m) { acc[ai][0][m][0] = bg0 * SWC; acc[ai][0][m][1] = bg1 * SWC; acc[ai][1][m][0] = bl0; acc[ai][1][m][1] = bl1; }
    }
    __device__ __forceinline__ void operator()(const f32x4 (&acc)[2][2][4][2], const Unit& u, int wr, int wc, int fr, int fq) const {
        unsigned char* obase = act + (size_t)(u.pm * BM + wr * 64 + 16 * (2 * (fq & 1) + (fq >> 1)) + fr) * 2048 + u.pn * 128 + wc * 16;
#pragma unroll
        for (int ai = 0; ai < 2; ++ai) {
            float o[4][8];
#pragma unroll
            for (int m = 0; m < 4; ++m)
#pragma unroll
                for (int n = 0; n < 2; ++n) { const f32x4 ag = acc[ai][0][m][n], al = acc[ai][1][m][n];
#pragma unroll
                    for (int hq = 0; hq < 2; ++hq) {
                        f32x2 g = (f32x2){ag[2 * hq], ag[2 * hq + 1]};
                        f32x2 l = (f32x2){al[2 * hq], al[2 * hq + 1]};
                        g.x = fmaxf(g.x, 7.0f * SWC); g.y = fmaxf(g.y, 7.0f * SWC);
                        l.x = __builtin_amdgcn_fmed3f(l.x, 8.0f * SWIC, -6.0f * SWIC); l.y = __builtin_amdgcn_fmed3f(l.y, 8.0f * SWIC, -6.0f * SWIC);
                        const f32x2 z = g;
                        f32x2 e; e.x = __builtin_amdgcn_exp2f(z.x); e.y = __builtin_amdgcn_exp2f(z.y);
                        const f32x2 d = e + 1.0f; f32x2 r; r.x = __builtin_amdgcn_rcpf(d.x); r.y = __builtin_amdgcn_rcpf(d.y);
                        const f32x2 oo = (g * r) * l; o[m][4 * n + 2 * hq] = oo.x; o[m][4 * n + 2 * hq + 1] = oo.y; } }
            v16f va, vb;
#pragma unroll
            for (int j = 0; j < 8; ++j) {
                const auto x0 = __builtin_amdgcn_permlane32_swap(__float_as_uint(o[0][j]), __float_as_uint(o[1][j]), false, false);
                const auto x1 = __builtin_amdgcn_permlane32_swap(__float_as_uint(o[2][j]), __float_as_uint(o[3][j]), false, false);
                const auto px = __builtin_amdgcn_permlane16_swap(x0[0], x1[0], false, false), py = __builtin_amdgcn_permlane16_swap(x0[1], x1[1], false, false);
                va[j] = __uint_as_float(px[0]); va[8 + j] = __uint_as_float(px[1]); vb[j] = __uint_as_float(py[0]); vb[8 + j] = __uint_as_float(py[1]); }
            u32x4 w0, w1; mx6_pack(va, vb, w0, w1);
            *(u32x4*)(obase + (size_t)(ai * HALF) * 2048) = w0; *(u32x4*)(obase + (size_t)(ai * HALF) * 2048 + 64) = w1; }
    }
};
struct EpiDown {
    static constexpr bool MIDK = false, BIASL = true, ACCINIT = true;
    static constexpr bool PERM = true;
    unsigned char* Y; const float* bdn; const LAS unsigned* dstL; const LAS float* biasL; unsigned biasA;
    __device__ __forceinline__ void prefetch(const Unit& u, int wid, int lane) const {
        if (wid == 0) glds16(bdn + (size_t)u.e * 2048 + u.pn * 256 + lane * 4, biasA + (unsigned)(u.ui & 1) * 1024u); }
    __device__ __forceinline__ void init(f32x4 (&acc)[2][2][4][2], const Unit& u, int wc, int fq) const {
        const LAS float* bp = biasL + (u.ui & 1) * 256 + wc * 64 + 16 * fq;
#pragma unroll
        for (int bj = 0; bj < 2; ++bj)
#pragma unroll
            for (int n = 0; n < 2; ++n) { const f32x4 bv = *(const LAS f32x4*)(bp + 8 * bj + 4 * n);
#pragma unroll
                for (int ai = 0; ai < 2; ++ai)
#pragma unroll
                    for (int m = 0; m < 4; ++m) acc[ai][bj][m][n] = bv; }
    }
    __device__ __forceinline__ void operator()(const f32x4 (&acc)[2][2][4][2], const Unit& u, int wr, int wc, int fr, int fq) const {
        const int col0 = u.pn * BM + wc * 64 + 16 * fq;
#pragma unroll
        for (int ai = 0; ai < 2; ++ai)
#pragma unroll
            for (int m = 0; m < 4; ++m) { const unsigned dst = dstL[u.ui * 256 + ai * HALF + wr * 64 + m * 16 + fr];
                const f32x4 v00 = acc[ai][0][m][0], v01 = acc[ai][0][m][1], v10 = acc[ai][1][m][0], v11 = acc[ai][1][m][1];
                u32x4 w; w.x = pk4_fp8(v00[0], v00[1], v00[2], v00[3]); w.y = pk4_fp8(v01[0], v01[1], v01[2], v01[3]); w.z = pk4_fp8(v10[0], v10[1], v10[2], v10[3]); w.w = pk4_fp8(v11[0], v11[1], v11[2], v11[3]);
                *(u32x4*)(Y + (size_t)dst * 2048 + col0) = w; }
    }
};

template <class Epi, bool GATHER, bool ALIGN_EPI, bool FP8>
__device__ __forceinline__ void gemm_phase(LAS unsigned char* lds, const char* Abase, const char* Bbase, size_t estrideB, int KB, const TileOrder& S, const Epi& E, const LAS unsigned short* tokL) {
    const int tid = threadIdx.x, wid = __builtin_amdgcn_readfirstlane(tid >> 6), lane = tid & 63, wr = wid >> 2, wc = wid & 3, fr = lane & 15, fq = lane >> 4;
    const int nt = KB / 128;
    int Rr[2], Cc[2]; unsigned voffB[2], vA[2][2];
#pragma unroll
    for (int i = 0; i < 2; ++i) { int R, C; stage_rc(tid * 16 + i * 8192, R, C); const int Rb = Epi::PERM ? ((R & ~31) + perm32(R & 31)) : R;
        Rr[i] = R; Cc[i] = C; voffB[i] = (unsigned)(Rb * KB + C * 2); }
    const size_t kstep = (size_t)128;
    const size_t hstep = (size_t)HALF * KB;
    const size_t tstep = 2 * hstep;
    const unsigned ldsw = (unsigned)wid * 1024u;
    const int aoff = lds_byte(wr * 64 + fr, fq * 8), boff = lds_byte(wc * 32 + fr, fq * 8);
#define PG8_SA(b, h) (((b) * 2 + (h)) * HTB)
#define PG8_SB(b, h) ((4 + (b) * 2 + (h)) * HTB)
#define PG8_STAGE(bufoff, gbase, voff) do { _Pragma("unroll") for (int _i = 0; _i < 2; ++_i) \
        __builtin_amdgcn_global_load_lds((const GAS unsigned*)((const char*)(gbase) + (voff)[_i]), (LAS unsigned*)(lds + (bufoff) + ldsw + _i * 8192), 16, 0, 0); } while (0)
#define PG8_LDA(dst, b, h) do { _Pragma("unroll") for (int m = 0; m < 4; ++m) dst[m] = __builtin_shufflevector(*(const LAS v4i*)(lds + PG8_SA(b, h) + aoff + m * 2048), *(const LAS v4i*)(lds + PG8_SA(b, h) + aoff + m * 2048 + 1024), 0, 1, 2, 3, 4, 5, 6, 7); } while (0)
#define PG8_LDB(dst, b, h) do { _Pragma("unroll") for (int n = 0; n < 2; ++n) dst[n] = __builtin_shufflevector(*(const LAS v4i*)(lds + PG8_SB(b, h) + boff + n * 2048), *(const LAS v4i*)(lds + PG8_SB(b, h) + boff + n * 2048 + 1024), 0, 1, 2, 3, 4, 5, 6, 7); } while (0)
#define PG8_MMA(ai, bj, At, Bt) do { __builtin_amdgcn_s_setprio(1); _Pragma("unroll") for (int m = 0; m < 4; ++m) _Pragma("unroll") for (int n = 0; n < 2; ++n) { \
        if constexpr (FP8) acc[ai][bj][m][n] = __builtin_amdgcn_mfma_scale_f32_16x16x128_f8f6f4(Bt[n], At[m], acc[ai][bj][m][n], 2, 2, 0, Bt[n][6], 0, At[m][6])    ; \
        else { acc[ai][bj][m][n] = __builtin_amdgcn_mfma_f32_16x16x32_bf16(lo8(Bt[n]), lo8(At[m]), acc[ai][bj][m][n], 0, 0, 0); acc[ai][bj][m][n] = __builtin_amdgcn_mfma_f32_16x16x32_bf16(hi8(Bt[n]), hi8(At[m]), acc[ai][bj][m][n], 0, 0, 0); } } __builtin_amdgcn_s_setprio(0); } while (0)
#define PG8_WAIT_V(n) asm volatile("s_waitcnt vmcnt(" #n ")" ::: "memory")
#define PG8_WAIT_L(n) asm volatile("s_waitcnt lgkmcnt(" #n ")" ::: "memory")
#define PG8_BAR __builtin_amdgcn_s_barrier()
#define PG8_SCHED __builtin_amdgcn_sched_barrier(0)
#define PG8_SETVA(u) do { _Pragma("unroll") for (int _h = 0; _h < 2; ++_h) _Pragma("unroll") for (int _i = 0; _i < 2; ++_i) { \
        const int _row = GATHER ? (int)tokL[(u).ui * 256 + _h * HALF + Rr[_i]] : (_h * HALF + Rr[_i]); vA[_h][_i] = (unsigned)(_row * KB + Cc[_i] * 2); asm volatile("" : "+v"(vA[_h][_i])); } } while (0)
    Unit cur, nxt; int ui = 0;
    if (!S.next(0, cur)) return;
    f32x4 acc[2][2][4][2];
#pragma unroll
    for (int a = 0; a < 2; ++a)
#pragma unroll
        for (int b = 0; b < 2; ++b)
#pragma unroll
            for (int m = 0; m < 4; ++m)
#pragma unroll
                for (int n = 0; n < 2; ++n) acc[a][b][m][n] = (f32x4){0.f, 0.f, 0.f, 0.f};
    v8i At[4], B0[2], B1[2];
    const char* cA = GATHER ? Abase : Abase + (size_t)cur.pm * tstep;
    const char* cB = Bbase + (size_t)cur.e * estrideB + (size_t)cur.pn * tstep;
    PG8_SETVA(cur);
    if constexpr (Epi::BIASL) E.prefetch(cur, wid, lane);
    PG8_STAGE(PG8_SB(0, 0), cB, voffB); PG8_STAGE(PG8_SB(0, 1), cB + hstep, voffB); PG8_STAGE(PG8_SA(0, 0), cA, vA[0]); PG8_STAGE(PG8_SA(0, 1), cA, vA[1]);
    if (wr == 1) PG8_BAR;
    PG8_WAIT_V(2); PG8_BAR;
    PG8_STAGE(PG8_SB(1, 0), cB + kstep, voffB); PG8_STAGE(PG8_SA(1, 0), cA + kstep, vA[0]); PG8_STAGE(PG8_SB(1, 1), cB + hstep + kstep, voffB);
    PG8_WAIT_V(6); PG8_BAR;
    if constexpr (Epi::ACCINIT) E.init(acc, cur, wc, fq);
    for (;;) {
        const bool has_next = S.next(ui + 1, nxt);
        if constexpr (Epi::ACCINIT) { if (has_next) E.prefetch(nxt, wid, lane); }
        const char* nA = has_next ? (GATHER ? Abase : Abase + (size_t)nxt.pm * tstep) : cA;
        const char* nB = has_next ? Bbase + (size_t)nxt.e * estrideB + (size_t)nxt.pn * tstep : cB;
        for (int t = 0; t < nt; t += 2) {
            if constexpr (Epi::MIDK) { if (t == nt / 2) E.mid(acc, cur, wr, fr); }
            const bool last = (t == nt - 2);
            const char* a1 = cA + (size_t)(t + 1) * kstep;
            const char* a2 = last ? nA : cA + (size_t)(t + 2) * kstep; const char* b2 = last ? nB : cB + (size_t)(t + 2) * kstep;
            const char* a3 = a2 + kstep; const char* b3 = b2 + kstep;
            PG8_LDB(B0, 0, 0); PG8_LDB(B1, 0, 1); PG8_SCHED; PG8_LDA(At, 0, 0); PG8_STAGE(PG8_SA(1, 1), a1, vA[1]);
            if (last && has_next) PG8_SETVA(nxt);
            PG8_WAIT_V(8); PG8_WAIT_L(0); PG8_BAR; PG8_MMA(0, 0, At, B0); PG8_MMA(0, 1, At, B1); PG8_BAR; PG8_SCHED;
            PG8_LDA(At, 0, 1); PG8_STAGE(PG8_SB(0, 0), b2, voffB); PG8_STAGE(PG8_SB(0, 1), b2 + hstep, voffB); PG8_STAGE(PG8_SA(0, 0), a2, vA[0]);
            PG8_WAIT_V(8); PG8_WAIT_L(0); PG8_BAR; PG8_MMA(1, 0, At, B0); PG8_MMA(1, 1, At, B1); PG8_BAR; PG8_SCHED;
            PG8_LDB(B0, 1, 0); PG8_LDB(B1, 1, 1); PG8_SCHED; PG8_LDA(At, 1, 0); PG8_STAGE(PG8_SA(0, 1), a2, vA[1]);
            PG8_WAIT_V(8); PG8_WAIT_L(0); PG8_BAR; PG8_MMA(0, 0, At, B0); PG8_MMA(0, 1, At, B1); PG8_BAR; PG8_SCHED;
            PG8_LDA(At, 1, 1); PG8_STAGE(PG8_SB(1, 0), b3, voffB); PG8_STAGE(PG8_SB(1, 1), b3 + hstep, voffB); PG8_STAGE(PG8_SA(1, 0), a3, vA[0]);
            PG8_WAIT_V(8); PG8_WAIT_L(0); PG8_BAR; PG8_MMA(1, 0, At, B0); PG8_MMA(1, 1, At, B1); PG8_BAR; PG8_SCHED;
        }
        if constexpr (ALIGN_EPI) { if (wr == 0) PG8_BAR; }
        E(acc, cur, wr, wc, fr, fq);
        if (!has_next) break;
#pragma unroll
        for (int a = 0; a < 2; ++a)
#pragma unroll
            for (int b = 0; b < 2; ++b)
#pragma unroll
                for (int m = 0; m < 4; ++m)
#pragma unroll
                    for (int n = 0; n < 2; ++n) acc[a][b][m][n] = (f32x4){0.f, 0.f, 0.f, 0.f};
        cur = nxt; cA = nA; cB = nB; ++ui;
        if constexpr (Epi::ACCINIT) E.init(acc, cur, wc, fq);
        else if constexpr (Epi::BIASL) E.prefetch(cur, wid, lane);
        if constexpr (ALIGN_EPI) { if (wr == 1) PG8_BAR; }
    }
    PG8_WAIT_V(0);
    if constexpr (!ALIGN_EPI) { if (wr == 0) PG8_BAR; }
    PG8_BAR;
#undef PG8_SA
#undef PG8_SB
#undef PG8_STAGE
#undef PG8_LDA
#undef PG8_LDB
#undef PG8_MMA
#undef PG8_WAIT_V
#undef PG8_WAIT_L
#undef PG8_BAR
#undef PG8_SCHED
#undef PG8_SETVA
}

struct Frame {
    LAS unsigned char* lds;
    volatile LAS unsigned* MISC;
    gu32* ctl;
    int tid, lane, wave, vcu, G;
    const float *x, *g1, *w_in, *gq, *gk, *rpb, *gsg, *w_sp, *b_sp, *ga, *gs, *w_out, *g2, *w_r, *b_r, *w_gu, *b_gu, *w_dn, *b_dn;
    float* out;
    bf16 *WIN, *WOUT, *WSP, *WRH, *WRL, *H, *PROJ, *MIX, *X2B; unsigned char *WGU, *WDN, *ACT, *H8, *Y;
    float *RSTD2, *GATE, *SSQA, *SSG, *RA, *RB, *SSX, *RMS1, *IG1; unsigned* SLOT; int* LIST;
};

__device__ __forceinline__ void p0_transpose_item(const float* W, int N, int K, bf16* WT, int k0, int n0, int out_row0, int hi_off, const float* kgain, LAS float* scr, int lane) {
    const int l16 = lane & 15, lq = lane >> 4;
#pragma unroll 4
    for (int i = 0; i < 16; ++i) { const int kk = 4 * i + lq; f32x4 v = *(const f32x4*)(W + (size_t)(k0 + kk) * N + n0 + 4 * l16); if (kgain) v = v * kgain[k0 + kk];
        LAS float* d = scr + kk * 65 + 4 * l16; d[0] = v.x; d[1] = v.y; d[2] = v.z; d[3] = v.w; }
    LDS_WAIT(); asm volatile("" ::: "memory");
    const int c = lane >> 3, nn = lane & 7;
#pragma unroll
    for (int j = 0; j < 8; ++j) { const int n = nn + 8 * j; const LAS float* s = scr + (8 * c) * 65 + n;
        u32x4 o; o.x = cvt_pk_bf16(s[0], s[65]); o.y = cvt_pk_bf16(s[2 * 65], s[3 * 65]); o.z = cvt_pk_bf16(s[4 * 65], s[5 * 65]); o.w = cvt_pk_bf16(s[6 * 65], s[7 * 65]);
        *(u32x4*)(WT + (size_t)(out_row0 + n + (n >= 32 ? hi_off : 0)) * K + k0 + 8 * c) = o; }
    LDS_WAIT(); asm volatile("" ::: "memory");
}
__device__ __forceinline__ void p0_transpose_item_fp8(const float* W, int N, int K, unsigned char* WT, int k0, int n0, int out_row0, LAS float* scr, int lane) {
    const int l8 = lane & 7, lr = lane >> 3;
#pragma unroll 4
    for (int i = 0; i < 16; ++i) { const int kk = 8 * i + lr; const f32x4 v = *(const f32x4*)(W + (size_t)(k0 + kk) * N + n0 + 4 * l8);
        LAS float* d = scr + kk * 33 + 4 * l8; d[0] = v.x; d[1] = v.y; d[2] = v.z; d[3] = v.w; }
    LDS_WAIT(); asm volatile("" ::: "memory");
    const int n = lane & 31, kh = lane >> 5; const LAS float* s = scr + (64 * kh) * 33 + n;
#pragma unroll
    for (int c4 = 0; c4 < 4; ++c4) { u32x4 o;
        o.x = pk4_fp8(s[(16 * c4 + 0) * 33] * 64.f, s[(16 * c4 + 1) * 33] * 64.f, s[(16 * c4 + 2) * 33] * 64.f, s[(16 * c4 + 3) * 33] * 64.f);
        o.y = pk4_fp8(s[(16 * c4 + 4) * 33] * 64.f, s[(16 * c4 + 5) * 33] * 64.f, s[(16 * c4 + 6) * 33] * 64.f, s[(16 * c4 + 7) * 33] * 64.f);
        o.z = pk4_fp8(s[(16 * c4 + 8) * 33] * 64.f, s[(16 * c4 + 9) * 33] * 64.f, s[(16 * c4 + 10) * 33] * 64.f, s[(16 * c4 + 11) * 33] * 64.f);
        o.w = pk4_fp8(s[(16 * c4 + 12) * 33] * 64.f, s[(16 * c4 + 13) * 33] * 64.f, s[(16 * c4 + 14) * 33] * 64.f, s[(16 * c4 + 15) * 33] * 64.f);
        *(u32x4*)(WT + (size_t)(out_row0 + n) * K + k0 + 64 * kh + 16 * c4) = o; }
    LDS_WAIT(); asm volatile("" ::: "memory");
}
__device__ __forceinline__ void moe_convert(Frame& F, int j0, int j1) {
    LAS float* img = (LAS float*)F.lds;
    constexpr int T_GU = 16 * 16, T_DN = 16 * 8, NT = NE * (T_GU + T_DN);
    const int w = F.wave, lane = F.lane;
    f32x4 v0[16], v1[16];
#define P0_DECODE(t, W_, N_, WT_, k0_, n0_, isgu_) do { int r_ = (t); if (r_ < NE * T_GU) { const int e_ = r_ / T_GU, q_ = r_ % T_GU; W_ = F.w_gu + (size_t)e_ * DM * 4096; N_ = 4096; WT_ = F.WGU + (size_t)e_ * 4096 * DM; k0_ = 128 * (q_ / 16); n0_ = 256 * (q_ % 16); isgu_ = 1; } \
        else { r_ -= NE * T_GU; const int e_ = r_ / T_DN, q_ = r_ % T_DN; W_ = F.w_dn + (size_t)e_ * DM * DM; N_ = DM; WT_ = F.WDN + (size_t)e_ * DM * DM; k0_ = 128 * (q_ / 8); n0_ = 256 * (q_ % 8); isgu_ = 0; } } while (0)
#define P0_VALID(jj) ((jj) < j1 && F.vcu + (jj) * F.G < NT)
#define P0_LOAD(v_, jj) do { const float* W_ = nullptr; unsigned char* WT_ = nullptr; int N_ = 0, k0_ = 0, n0_ = 0, ig_ = 0; P0_DECODE(F.vcu + (jj) * F.G, W_, N_, WT_, k0_, n0_, ig_); (void)WT_; (void)ig_; \
        _Pragma("unroll") for (int i = 0; i < 16; ++i) v_[i] = __builtin_nontemporal_load((const f32x4*)(W_ + (size_t)(k0_ + 16 * w + i) * N_ + n0_ + 4 * lane)); } while (0)
#define P0_IMG(v_) do { _Pragma("unroll") for (int i = 0; i < 16; ++i) *(LAS f32x4*)(img + (16 * w + i) * 256 + ((4 * lane + 8 * (w >> 1)) & 255)) = v_[i]; } while (0)
#define P0_CONVERT(jj) do { const float* W_ = nullptr; unsigned char* WT = nullptr; int N_ = 0, k0 = 0, n0 = 0, isgu = 0; P0_DECODE(F.vcu + (jj) * F.G, W_, N_, WT, k0, n0, isgu); (void)W_; (void)N_; \
          const int q = lane & 3; \
          _Pragma("unroll") for (int h = 0; h < 2; ++h) { const int n = 32 * w + (lane >> 2) + 16 * h;     \
              const int nn = n0 + n; const int ll = nn & 255;            \
              const int jl = nn & 127;                                   \
              const int orow = isgu ? (((nn & 2047) >> 7) * 256 + (nn >> 11) * 128 + jl) : ((nn & ~255) + 128 * ((ll >> 3) & 1) + 32 * (ll >> 6) + 8 * ((ll >> 4) & 3) + (ll & 7)); \
              unsigned char* dst = WT + (size_t)orow * DM + k0 + 16 * q;     \
              const LAS float* sp = img + (32 * q) * 256 + ((n + 8 * q) & 255); v16f va, vb; \
              _Pragma("unroll") for (int p = 0; p < 16; ++p) { va[p] = sp[p * 256]; vb[p] = sp[(16 + p) * 256]; } \
              if (isgu) { const float f_ = (nn >> 11) ? SWIC : SWC; va = va * f_; vb = vb * f_; }     \
              u32x4 w0, w1; mx6_pack(va, vb, w0, w1); \
              __builtin_nontemporal_store(w0, (u32x4*)(dst)); __builtin_nontemporal_store(w1, (u32x4*)(dst + 64)); } } while (0)
    if (P0_VALID(j0)) P0_LOAD(v0, j0);
    if (P0_VALID(j0 + 1)) P0_LOAD(v1, j0 + 1);
    for (int j = j0; P0_VALID(j); j += 2) {
        P0_IMG(v0); __syncthreads();
        if (P0_VALID(j + 2)) P0_LOAD(v0, j + 2);
        P0_CONVERT(j); __syncthreads();
        if (!P0_VALID(j + 1)) break;
        P0_IMG(v1); __syncthreads();
        if (P0_VALID(j + 3)) P0_LOAD(v1, j + 3);
        P0_CONVERT(j + 1); __syncthreads();
    }
#undef P0_DECODE
#undef P0_VALID
#undef P0_LOAD
#undef P0_IMG
#undef P0_CONVERT
}
__device__ __forceinline__ void p0_prologue(Frame& F) {
    LAS float* scr = (LAS float*)(F.lds + F.wave * 16896);
    const int gw = F.vcu * NWAVES + F.wave, NGW = F.G * NWAVES, lane = F.lane;
    constexpr int I_IN = 32 * 80, I_OUT = 32 * 32;
    constexpr int NITEMS = I_IN + I_OUT;
    for (int it = gw; it < NITEMS; it += NGW) {
        int r = it;
        if (r < I_IN) { const int kb = r / 80, nb = r % 80; p0_transpose_item(F.w_in, NPROJ, DM, F.WIN, 64 * kb, 64 * nb, (nb >> 2) * 256 + (nb & 3) * 32, 96, nullptr, scr, lane); continue; } r -= I_IN;
        { const int kb = r / 32, nb = r % 32; p0_transpose_item(F.w_out, DM, DM, F.WOUT, 64 * kb, 64 * nb, 64 * nb, 0, kb < 16 ? F.ga : F.gs - 1024, scr, lane); }
    }
    {
        f32x4 g1v[8];
#pragma unroll
        for (int j = 0; j < 4; ++j) { g1v[2 * j] = *(const f32x4*)(F.g1 + 8 * lane + 512 * j); g1v[2 * j + 1] = *(const f32x4*)(F.g1 + 8 * lane + 512 * j + 4); }
        for (int m = gw; m < NTOK; m += 2 * NGW) {
            const int m2 = m + NGW; const bool has2 = m2 < NTOK;
            const float* xr = F.x + (size_t)m * DM + 8 * lane; const float* xr2 = F.x + (size_t)(has2 ? m2 : m) * DM + 8 * lane;
            f32x4 v[8], u[8]; float s = 0.f, s2 = 0.f;
#pragma unroll
            for (int j = 0; j < 4; ++j) { v[2 * j] = __builtin_nontemporal_load((const f32x4*)(xr + 512 * j)); v[2 * j + 1] = __builtin_nontemporal_load((const f32x4*)(xr + 512 * j + 4)); u[2 * j] = __builtin_nontemporal_load((const f32x4*)(xr2 + 512 * j)); u[2 * j + 1] = __builtin_nontemporal_load((const f32x4*)(xr2 + 512 * j + 4)); }
#pragma unroll
            for (int j = 0; j < 8; ++j) { s += (v[j].x * v[j].x + v[j].y * v[j].y) + (v[j].z * v[j].z + v[j].w * v[j].w); s2 += (u[j].x * u[j].x + u[j].y * u[j].y) + (u[j].z * u[j].z + u[j].w * u[j].w); }
            const float rm = sqrtf(wave_sum(s) * (1.0f / DM) + EPS), rm2 = sqrtf(wave_sum(s2) * (1.0f / DM) + EPS); const float rs = 1.0f / rm, rs2 = 1.0f / rm2;
            if (lane == 0) { F.RMS1[m] = rm; if (has2) F.RMS1[m2] = rm2; }
#pragma unroll
            for (int j = 0; j < 4; ++j) { const f32x4 a = v[2 * j] * rs * g1v[2 * j], b = v[2 * j + 1] * rs * g1v[2 * j + 1]; u32x4 o; o.x = cvt_pk_bf16(a.x, a.y); o.y = cvt_pk_bf16(a.z, a.w); o.z = cvt_pk_bf16(b.x, b.y); o.w = cvt_pk_bf16(b.z, b.w);
                *(u32x4*)(F.H + (size_t)m * DM + 8 * lane + 512 * j) = o; }
            if (has2) {
#pragma unroll
                for (int j = 0; j < 4; ++j) { const f32x4 a = u[2 * j] * rs2 * g1v[2 * j], b = u[2 * j + 1] * rs2 * g1v[2 * j + 1]; u32x4 o; o.x = cvt_pk_bf16(a.x, a.y); o.y = cvt_pk_bf16(a.z, a.w); o.z = cvt_pk_bf16(b.x, b.y); o.w = cvt_pk_bf16(b.z, b.w);
                    *(u32x4*)(F.H + (size_t)m2 * DM + 8 * lane + 512 * j) = o; } }
        }
    }
    const int gt = F.vcu * 512 + F.tid, NGT = F.G * 512;
    for (int i = gt; i < DM; i += NGT) F.IG1[i] = 1.0f / F.g1[i];
    for (int i = gt; i < 16 * 128 * 128; i += NGT) { const float v = F.w_sp[i]; F.WSP[i] = (bf16)(cvt_pk_bf16(v, 0.f) & 0xffffu); }
    for (int i = gt; i < NE * DM; i += NGT) { const int e = i / DM, d = i % DM; const float v = F.w_r[(size_t)d * NE + e]; const unsigned hi = cvt_pk_bf16(v, 0.f) & 0xffffu; const float lo = v - __uint_as_float(hi << 16);
        F.WRH[i] = (bf16)hi; F.WRL[i] = (bf16)(cvt_pk_bf16(lo, 0.f) & 0xffffu); }
    if (F.vcu < 16 && F.wave == 7) {
        const int hh = F.vcu;
        float gqm = fabsf(F.gq[F.lane]), gkm = fabsf(F.gk[F.lane]), bm = 0.f;
#pragma unroll
        for (int i = 0; i < 8; ++i) { const int idx = F.lane + 64 * i; bm = fmaxf(bm, idx < 465 ? fabsf(F.rpb[hh * 465 + idx]) : 0.f); }
        for (int o = 1; o < 64; o <<= 1) { gqm = fmaxf(gqm, __shfl_xor(gqm, o)); gkm = fmaxf(gkm, __shfl_xor(gkm, o)); bm = fmaxf(bm, __shfl_xor(bm, o)); }
        if (F.lane == 0) F.RSTD2[hh] = 11.6f * gqm * gkm + 1.4427f * bm;
    }
}

typedef short v4i16_t __attribute__((ext_vector_type(4)));
__device__ __forceinline__ s16x4 tr_read(const LAS unsigned char* p) { return __builtin_bit_cast(s16x4, __builtin_amdgcn_ds_read_tr16_b64_v4i16((LAS v4i16_t*)p)); }
__device__ __forceinline__ void attn_unit(Frame& F, int b, int h, int band) {
    constexpr int SLOT = 16384;
    LAS unsigned char* ring = F.lds;
    LAS float* rpbL = (LAS float*)(F.lds + AT_RPB);
    LAS unsigned* mrg = (LAS unsigned*)(F.lds + AT_MRG);
    const int tid = F.tid, lane = F.lane, w = F.wave, fr = lane & 15, quad = lane >> 4;
    const int cg = w & 3, hf8 = w >> 2;
    const int c0 = 16 * cg, w0 = (cg == 0) ? 0 : (cg == 1) ? 8 : (cg == 2) ? 24 : 32;
    const int qc = c0 + fr; const int cs = min(max(qc - 8, 0), 48);
    const int R0 = band * 16;
    __syncthreads();
    for (int i = tid; i < 480; i += 512) { const int ro = i >> 5, co = i & 31; rpbL[i] = co < 31 ? F.rpb[h * 465 + ro * 31 + co] * 1.4426950408889634f : -INFINITY; }
    int cooff[2][4];
#pragma unroll
    for (int hf = 0; hf < 2; ++hf)
#pragma unroll
        for (int i = 0; i < 4; ++i) { const int kc = w0 + 16 * hf + 4 * quad + i; const bool valid = (kc >= cs) && (kc < cs + 16); cooff[hf][i] = 4 * (valid ? kc - qc + 15 : 31); }
    const char* projb = (const char*)F.PROJ + (size_t)b * SEQ * NPROJ * 2; const unsigned ringb = (unsigned)(size_t)ring;
    const unsigned lane_src = (unsigned)((8 * w + (lane >> 3)) * NPROJ + 1024 + h * 64) * 2u + (unsigned)(((lane & 7) ^ (lane >> 3)) * 16);
#define ROW_DMA(rowabs) do { const char* src_ = projb + (size_t)(rowabs) * 64 * NPROJ * 2 + lane_src; const unsigned sb_ = ringb + (unsigned)(((rowabs) % 9) * SLOT + w * 1024); \
        glds16(src_, sb_); glds16(src_ + 2048, sb_ + 8192u); } while (0)
    const int rs0 = min(max(R0 - 4, 0), 120);
    for (int j = 0; j < 8; ++j) ROW_DMA(rs0 + j);
    int loaded_hi = rs0 + 7;
    const bf16* qbase = F.PROJ + ((size_t)b * SEQ + qc) * NPROJ + h * 64 + 8 * quad;
    bf16x8 qa = *(const bf16x8*)(qbase + (size_t)R0 * 64 * NPROJ), qb = *(const bf16x8*)(qbase + (size_t)R0 * 64 * NPROJ + 32);
    VM_WAIT(); __syncthreads();
    const bool nomax = __builtin_amdgcn_readfirstlane(__float_as_uint(F.RSTD2[h])) < __float_as_uint(60.0f);
    float bias[4][2][4]; int bias_row = -1000;
    for (int step = 0; step < 16; ++step) {
        const int r = R0 + step, rs = min(max(r - 4, 0), 120);
        bf16x8 qf0 = qa, qf1 = qb;
        if (step < 15) { const int nh = min(max(r - 3, 0), 120) + 7; if (nh > loaded_hi) { ROW_DMA(nh); loaded_hi = nh; }
            qa = *(const bf16x8*)(qbase + (size_t)(r + 1) * 64 * NPROJ); qb = *(const bf16x8*)(qbase + (size_t)(r + 1) * 64 * NPROJ + 32); }
        f32x4 s[4][2];
#pragma unroll
        for (int kr = 0; kr < 4; ++kr) { const int sb = ((rs + 4 * hf8 + kr) % 9) * SLOT;
#pragma unroll
            for (int hf = 0; hf < 2; ++hf) { const int key = w0 + 16 * hf + fr;
                const bf16x8 a0 = *(const LAS bf16x8*)(ring + sb + key * 128 + ((quad ^ (key & 7)) << 4));
                const bf16x8 a1 = *(const LAS bf16x8*)(ring + sb + key * 128 + (((quad + 4) ^ (key & 7)) << 4));
                f32x4 z = {0.f, 0.f, 0.f, 0.f};
                z = __builtin_amdgcn_mfma_f32_16x16x32_bf16(a0, qf0, z, 0, 0, 0);
                z = __builtin_amdgcn_mfma_f32_16x16x32_bf16(a1, qf1, z, 0, 0, 0);
                s[kr][hf] = z; } }
        { const int brow = rs + 4 * hf8 - r + 7;
            if (brow != bias_row) { bias_row = brow; const LAS unsigned char* bb = (const LAS unsigned char*)rpbL + brow * 128;
#pragma unroll
                for (int kr = 0; kr < 4; ++kr)
#pragma unroll
                    for (int hf = 0; hf < 2; ++hf)
#pragma unroll
                        for (int i = 0; i < 4; ++i) bias[kr][hf][i] = *(const LAS float*)(bb + kr * 128 + cooff[hf][i]); } }
        float mx = 0.f; bf16x8 pf[4];
        if (nomax) {
#pragma unroll
            for (int kr = 0; kr < 4; ++kr) { float p[8];
#pragma unroll
                for (int i = 0; i < 8; ++i) p[i] = __builtin_amdgcn_exp2f(s[kr][i >> 2][i & 3] + bias[kr][i >> 2][i & 3]);
                u32x4 pk; pk.x = cvt_pk_bf16(p[0], p[1]); pk.y = cvt_pk_bf16(p[2], p[3]); pk.z = cvt_pk_bf16(p[4], p[5]); pk.w = cvt_pk_bf16(p[6], p[7]); pf[kr] = __builtin_bit_cast(bf16x8, pk); }
        } else {
            mx = -INFINITY;
#pragma unroll
            for (int kr = 0; kr < 4; ++kr)
#pragma unroll
                for (int hf = 0; hf < 2; ++hf)
#pragma unroll
                    for (int i = 0; i < 4; ++i) { const float v = s[kr][hf][i] + bias[kr][hf][i]; s[kr][hf][i] = v; mx = fmaxf(mx, v); }
            mx = quad_max(mx);
#pragma unroll
            for (int kr = 0; kr < 4; ++kr) { float p[8];
#pragma unroll
                for (int i = 0; i < 8; ++i) p[i] = __builtin_amdgcn_exp2f(s[kr][i >> 2][i & 3] - mx);
                u32x4 pk; pk.x = cvt_pk_bf16(p[0], p[1]); pk.y = cvt_pk_bf16(p[2], p[3]); pk.z = cvt_pk_bf16(p[4], p[5]); pk.w = cvt_pk_bf16(p[6], p[7]); pf[kr] = __builtin_bit_cast(bf16x8, pk); }
        }
        f32x4 o[4];
#pragma unroll
        for (int dt = 0; dt < 4; ++dt) o[dt] = (f32x4){0.f, 0.f, 0.f, 0.f};
        f32x4 osum = {0.f, 0.f, 0.f, 0.f};
        const bf16x8 ones = {(short)0x3F80, (short)0x3F80, (short)0x3F80, (short)0x3F80, (short)0x3F80, (short)0x3F80, (short)0x3F80, (short)0x3F80};
#pragma unroll
        for (int kr = 0; kr < 4; ++kr) osum = __builtin_amdgcn_mfma_f32_16x16x32_bf16(ones, pf[kr], osum, 0, 0, 0);
        const float lsum = osum[0];
#pragma unroll
        for (int kr = 0; kr < 4; ++kr) { const int sb = ((rs + 4 * hf8 + kr) % 9) * SLOT + 8192; const int key = w0 + 4 * quad + (fr >> 2), pp = fr & 3;
#pragma unroll
            for (int dt = 0; dt < 4; ++dt) { const int c = 2 * dt + (pp >> 1); const int ad = sb + key * 128 + ((c ^ (key & 7)) << 4) + 8 * (pp & 1);
                const s16x4 lo = tr_read(ring + ad), hi = tr_read(ring + ad + 16 * 128);
                const bf16x8 vf = __builtin_shufflevector(lo, hi, 0, 1, 2, 3, 4, 5, 6, 7);
                o[dt] = __builtin_amdgcn_mfma_f32_16x16x32_bf16(vf, pf[kr], o[dt], 0, 0, 0); } }
        if (w >= 4) { LAS unsigned* m = mrg + (w - 4) * 640 + lane; m[0] = __float_as_uint(mx); m[64] = __float_as_uint(lsum);
#pragma unroll
            for (int dt = 0; dt < 4; ++dt) { m[(2 + 2 * dt) * 64] = cvt_pk_bf16(o[dt][0], o[dt][1]); m[(3 + 2 * dt) * 64] = cvt_pk_bf16(o[dt][2], o[dt][3]); } }
        __syncthreads();
        if (w < 4) { const LAS unsigned* m = mrg + w * 640 + lane; const float mx2 = __uint_as_float(m[0]), l2 = __uint_as_float(m[64]);
            const float mm = fmaxf(mx, mx2), a1 = __builtin_amdgcn_exp2f(mx - mm), a2 = __builtin_amdgcn_exp2f(mx2 - mm); const float inv = 1.0f / (lsum * a1 + l2 * a2);
            const float f1 = a1 * inv, f2 = a2 * inv; float ssq = 0.f;
            bf16* op = F.MIX + ((size_t)b * SEQ + (size_t)r * 64 + qc) * DM + h * 64 + 4 * quad;
            u32x2 pk[4];
#pragma unroll
            for (int dt = 0; dt < 4; ++dt) { const unsigned u0 = m[(2 + 2 * dt) * 64], u1 = m[(3 + 2 * dt) * 64];
                const float v0 = o[dt][0] * f1 + bflo(u0) * f2, v1 = o[dt][1] * f1 + bfhi(u0) * f2, v2 = o[dt][2] * f1 + bflo(u1) * f2, v3 = o[dt][3] * f1 + bfhi(u1) * f2;
                ssq += (v0 * v0 + v1 * v1) + (v2 * v2 + v3 * v3);
                pk[dt].x = cvt_pk_bf16(v0, v1); pk[dt].y = cvt_pk_bf16(v2, v3); }
            ssq = quad_sum(ssq);
            VM_WAIT();
#pragma unroll
            for (int dp = 0; dp < 2; ++dp) *(u32x4*)(op + 32 * dp + ((quad & 1) ? 12 : 0)) = pair16(pk[2 * dp], pk[2 * dp + 1]);
            if (quad == 0) F.SSQA[((size_t)b * SEQ + (size_t)r * 64 + qc) * 16 + h] = ssq; }
        else VM_WAIT();
        __syncthreads();
    }
#undef ROW_DMA
}

__device__ __forceinline__ void sgu_unit(Frame& F, int unit) {
    LAS unsigned char* Gn = F.lds;
    LAS float* rsG = (LAS float*)(F.lds + 16384);
    const int tid = F.tid, lane = F.lane, w = F.wave, fr = lane & 15, quad = lane >> 4;
    const size_t tk0 = (size_t)unit * 128;
    __syncthreads();
    if (tid < 128) { const f32x4* sp = (const f32x4*)(F.SSG + (tk0 + tid) * 16); const f32x4 a = sp[0], b2 = sp[1], c = sp[2], d = sp[3];
        const float ss = ((a.x + a.y) + (a.z + a.w)) + ((b2.x + b2.y) + (b2.z + b2.w)) + ((c.x + c.y) + (c.z + c.w)) + ((d.x + d.y) + (d.z + d.w)); rsG[tid] = 1.0f / sqrtf(ss * (1.0f / 1024.0f) + EPS); }
    else if (tid < 256) { const int q = tid - 128; const f32x4* sp = (const f32x4*)(F.SSQA + (tk0 + q) * 16); const f32x4 a = sp[0], b2 = sp[1], c = sp[2], d = sp[3];
        const float ss = ((a.x + a.y) + (a.z + a.w)) + ((b2.x + b2.y) + (b2.z + b2.w)) + ((c.x + c.y) + (c.z + c.w)) + ((d.x + d.y) + (d.z + d.w)); F.RA[tk0 + q] = 1.0f / sqrtf(ss * (1.0f / 1024.0f) + EPS); }
    LAS float* gsgL = (LAS float*)(F.lds + 16896); LAS float* bspL = (LAS float*)(F.lds + 20992);
    if (tid < 256) *(LAS f32x4*)(gsgL + 4 * tid) = *(const f32x4*)(F.gsg + 4 * tid);
    *(LAS f32x4*)(bspL + 4 * tid) = *(const f32x4*)(F.b_sp + 4 * tid);
    float ssq = 0.f; const int p = 16 * w + fr;
    const bf16* gsrc0 = F.PROJ + (tk0 + (tid >> 3)) * NPROJ + 4096 + (tid & 7) * 8;
    const bf16* usrc = F.PROJ + (tk0 + p) * NPROJ + 3072 + 4 * quad;
    const bf16* wsrc = F.WSP + (size_t)p * 128 + 8 * quad;
    u32x4 gv0 = *(const u32x4*)(gsrc0), gv1 = *(const u32x4*)(gsrc0 + (size_t)64 * NPROJ);
    u32x2 uv[4]; bf16x8 wv[4];
#pragma unroll
    for (int dt = 0; dt < 4; ++dt) { uv[dt] = *(const u32x2*)(usrc + 16 * dt); wv[dt] = *(const bf16x8*)(wsrc + 32 * dt); }
    for (int gi = 0; gi < 16; ++gi) {
        __syncthreads();
#pragma unroll
        for (int j = 0; j < 2; ++j) { const int q = (tid >> 3) + 64 * j, c = tid & 7; const u32x4 v = j ? gv1 : gv0; const float rr = rsG[q];
            const f32x4 ga = *(const LAS f32x4*)(gsgL + gi * 64 + c * 8), gb = *(const LAS f32x4*)(gsgL + gi * 64 + c * 8 + 4);
            u32x4 o; o.x = cvt_pk_bf16(bflo(v.x) * rr * ga.x, bfhi(v.x) * rr * ga.y); o.y = cvt_pk_bf16(bflo(v.y) * rr * ga.z, bfhi(v.y) * rr * ga.w);
            o.z = cvt_pk_bf16(bflo(v.z) * rr * gb.x, bfhi(v.z) * rr * gb.y); o.w = cvt_pk_bf16(bflo(v.w) * rr * gb.z, bfhi(v.w) * rr * gb.w);
            *(LAS u32x4*)(Gn + q * 128 + ((c ^ (q & 7)) << 4)) = o; }
        u32x2 uc[4]; bf16x8 wf[4];
#pragma unroll
        for (int dt = 0; dt < 4; ++dt) { uc[dt] = uv[dt]; wf[dt] = wv[dt]; }
        if (gi < 15) { gv0 = *(const u32x4*)(gsrc0 + (gi + 1) * 64); gv1 = *(const u32x4*)(gsrc0 + (size_t)64 * NPROJ + (gi + 1) * 64);
#pragma unroll
            for (int dt = 0; dt < 4; ++dt) { uv[dt] = *(const u32x2*)(usrc + (gi + 1) * 64 + 16 * dt); wv[dt] = *(const bf16x8*)(wsrc + (size_t)(gi + 1) * 16384 + 32 * dt); } }
        __syncthreads();
        f32x4 acc[4];
#pragma unroll
        for (int dt = 0; dt < 4; ++dt) acc[dt] = (f32x4){0.f, 0.f, 0.f, 0.f};
#pragma unroll
        for (int ks = 0; ks < 4; ++ks) { const int rowA = 32 * ks + 8 * quad + (fr >> 2), rowB = rowA + 4; const int pp = fr & 3;
#pragma unroll
            for (int dt = 0; dt < 4; ++dt) { const int c = 2 * dt + (pp >> 1);
                const s16x4 lo = tr_read(Gn + rowA * 128 + ((c ^ (rowA & 7)) << 4) + 8 * (pp & 1)), hi = tr_read(Gn + rowB * 128 + ((c ^ (rowB & 7)) << 4) + 8 * (pp & 1));
                const bf16x8 af = __builtin_shufflevector(lo, hi, 0, 1, 2, 3, 4, 5, 6, 7);
                acc[dt] = __builtin_amdgcn_mfma_f32_16x16x32_bf16(af, wf[ks], acc[dt], 0, 0, 0); } }
        const float bs = bspL[gi * 128 + p];
        u32x2 pk[4];
#pragma unroll
        for (int dt = 0; dt < 4; ++dt) { const u32x2 uu = uc[dt];
            const float s0 = bflo(uu.x) * (acc[dt][0] + bs), s1 = bfhi(uu.x) * (acc[dt][1] + bs), s2 = bflo(uu.y) * (acc[dt][2] + bs), s3 = bfhi(uu.y) * (acc[dt][3] + bs);
            ssq += (s0 * s0 + s1 * s1) + (s2 * s2 + s3 * s3);
            pk[dt].x = cvt_pk_bf16(s0, s1); pk[dt].y = cvt_pk_bf16(s2, s3); }
#pragma unroll
        for (int dp = 0; dp < 2; ++dp) *(u32x4*)(F.MIX + (tk0 + p) * DM + 1024 + gi * 64 + 32 * dp + 4 * quad + ((quad & 1) ? 12 : 0)) = pair16(pk[2 * dp], pk[2 * dp + 1]);
    }
    ssq = quad_sum(ssq);
    if (quad == 0) F.RB[tk0 + p] = 1.0f / sqrtf(ssq * (1.0f / 1024.0f) + EPS);
}

__device__ __forceinline__ void router_unit(Frame& F, int unit) {
    constexpr int WROW = 544, WBUF = 64 * WROW;
    LAS unsigned char* wimg = F.lds;
    LAS float* lgL = (LAS float*)(F.lds + 2 * WBUF);
    LAS unsigned* histL = (LAS unsigned*)(F.lds + 2 * WBUF + 16896); LAS unsigned* baseL = histL + 32;
    const int tid = F.tid, lane = F.lane, w = F.wave, fr = lane & 15, quad = lane >> 4;
    const int token = unit * 128 + 16 * w + fr;
    __syncthreads();
    if (tid < 32) histL[tid] = 0u;
    const bf16* xrow = F.X2B + (size_t)token * DM + 32 * quad;
    unsigned char* trow = F.H8 + (size_t)token * DM + 16 * quad;
    f32x4 acc[2]; acc[0] = (f32x4){0.f, 0.f, 0.f, 0.f}; acc[1] = acc[0];
    float rstd;
    { const f32x4 p0 = *(const f32x4*)(F.SSX + (size_t)token * 32 + 8 * quad), p1 = *(const f32x4*)(F.SSX + (size_t)token * 32 + 8 * quad + 4);
      float ss = ((p0.x + p0.y) + (p0.z + p0.w)) + ((p1.x + p1.y) + (p1.z + p1.w)); ss = quad_sum(ss); rstd = 1.0f / sqrtf(ss * (1.0f / DM) + EPS); }
    u32x4 wst[4];
#define RT_WLOAD(c) do { _Pragma("unroll") for (int j = 0; j < 4; ++j) { const int id = j * 512 + tid, row = id >> 5, cc = id & 31; \
        wst[j] = *(const u32x4*)((row < 32 ? F.WRH + (size_t)row * DM : F.WRL + (size_t)(row - 32) * DM) + 256 * (c) + 8 * cc); } } while (0)
#define RT_WSTORE(b) do { _Pragma("unroll") for (int j = 0; j < 4; ++j) { const int id = j * 512 + tid, row = id >> 5, cc = id & 31; *(LAS u32x4*)(wimg + (b) * WBUF + row * WROW + (((cc >> 2) & 3) + 4 * (cc & 3) + 16 * (cc >> 4)) * 16) = wst[j]; } } while (0)
    RT_WLOAD(0); RT_WSTORE(0);
    LAS float* g2L = (LAS float*)(F.lds + 2 * WBUF + 16896 + 1024);
    *(LAS f32x4*)(g2L + 4 * tid) = *(const f32x4*)(F.g2 + 4 * tid);
    u32x4 xq[4];
#pragma unroll
    for (int j4 = 0; j4 < 4; ++j4) xq[j4] = *(const u32x4*)(xrow + 8 * j4);
    __syncthreads();
    for (int c = 0; c < 8; ++c) {
        if (c < 7) RT_WLOAD(c + 1);
        const LAS unsigned char* wb = wimg + (c & 1) * WBUF + fr * WROW + quad * 16;
        for (int s2 = 0; s2 < 2; ++s2) { const int ss = 2 * c + s2;
            v16f va, vb;
            u32x4 xc[4];
#pragma unroll
            for (int j4 = 0; j4 < 4; ++j4) xc[j4] = xq[j4];
            if (ss < 15) {
#pragma unroll
                for (int j4 = 0; j4 < 4; ++j4) xq[j4] = *(const u32x4*)(xrow + 128 * (ss + 1) + 8 * j4); }
#pragma unroll
            for (int j4 = 0; j4 < 4; ++j4) { const int kl = 4 * s2 + j4;
                const u32x4 xr = xc[j4]; const f32x4 xa = {bflo(xr.x), bfhi(xr.x), bflo(xr.y), bfhi(xr.y)}, xb = {bflo(xr.z), bfhi(xr.z), bflo(xr.w), bfhi(xr.w)};
                const f32x4 ga = *(const LAS f32x4*)(g2L + 128 * ss + 32 * quad + 8 * j4), gb = *(const LAS f32x4*)(g2L + 128 * ss + 32 * quad + 8 * j4 + 4);
                const f32x4 ya = xa * ga * rstd, yb = xb * gb * rstd;
                u32x4 h; h.x = cvt_pk_bf16(ya.x, ya.y); h.y = cvt_pk_bf16(ya.z, ya.w); h.z = cvt_pk_bf16(yb.x, yb.y); h.w = cvt_pk_bf16(yb.z, yb.w);
                u32x4 l; l.x = cvt_pk_bf16(ya.x - bflo(h.x), ya.y - bfhi(h.x)); l.y = cvt_pk_bf16(ya.z - bflo(h.y), ya.w - bfhi(h.y)); l.z = cvt_pk_bf16(yb.x - bflo(h.z), yb.y - bfhi(h.z)); l.w = cvt_pk_bf16(yb.z - bflo(h.w), yb.w - bfhi(h.w));
                if (j4 < 2) { va[8 * j4 + 0] = ya.x; va[8 * j4 + 1] = ya.y; va[8 * j4 + 2] = ya.z; va[8 * j4 + 3] = ya.w; va[8 * j4 + 4] = yb.x; va[8 * j4 + 5] = yb.y; va[8 * j4 + 6] = yb.z; va[8 * j4 + 7] = yb.w; }
                else { vb[8 * j4 - 16] = ya.x; vb[8 * j4 - 15] = ya.y; vb[8 * j4 - 14] = ya.z; vb[8 * j4 - 13] = ya.w; vb[8 * j4 - 12] = yb.x; vb[8 * j4 - 11] = yb.y; vb[8 * j4 - 10] = yb.z; vb[8 * j4 - 9] = yb.w; }
                const bf16x8 yh = __builtin_bit_cast(bf16x8, h), yl = __builtin_bit_cast(bf16x8, l);
#pragma unroll
                for (int et = 0; et < 2; ++et) {
                    const bf16x8 wh = *(const LAS bf16x8*)(wb + (16 * et) * WROW + kl * 64), wl = *(const LAS bf16x8*)(wb + (32 + 16 * et) * WROW + kl * 64);
                    acc[et] = __builtin_amdgcn_mfma_f32_16x16x32_bf16(wh, yh, acc[et], 0, 0, 0);
                    acc[et] = __builtin_amdgcn_mfma_f32_16x16x32_bf16(wh, yl, acc[et], 0, 0, 0);
                    acc[et] = __builtin_amdgcn_mfma_f32_16x16x32_bf16(wl, yh, acc[et], 0, 0, 0); } }
            u32x4 w0, w1; mx6_pack(va, vb, w0, w1);
            *(u32x4*)(trow + 128 * ss) = w0; *(u32x4*)(trow + 128 * ss + 64) = w1;
        }
        if (c < 7) RT_WSTORE((c + 1) & 1);
        __syncthreads();
    }
#undef RT_WLOAD
#undef RT_WSTORE
#pragma unroll
    for (int et = 0; et < 2; ++et)
#pragma unroll
        for (int i = 0; i < 4; ++i) { const int e = 16 * et + 4 * quad + i; lgL[(w * 16 + fr) * 33 + e] = acc[et][i] + F.b_r[e]; }
    __syncthreads();
    int ev[4]; float gv[4]; unsigned lp[4];
    const int mytok = unit * 128 + 16 * w + lane;
    if (lane < 16) {
        const LAS float* lg = lgL + (w * 16 + lane) * 33; unsigned mask = 0u; float vv[4];
#pragma unroll
        for (int k = 0; k < 4; ++k) { float best = -INFINITY; int bi = 0;
            for (int e = 0; e < 32; ++e) { const float v = lg[e]; if (!((mask >> e) & 1u) && v > best) { best = v; bi = e; } }
            mask |= 1u << bi; ev[k] = bi; vv[k] = best; }
        const float e1 = __expf(vv[1] - vv[0]), e2 = __expf(vv[2] - vv[0]), e3 = __expf(vv[3] - vv[0]); const float inv = 1.0f / (1.0f + e1 + e2 + e3);
        gv[0] = inv; gv[1] = e1 * inv; gv[2] = e2 * inv; gv[3] = e3 * inv;
#pragma unroll
        for (int k = 0; k < 4; ++k) lp[k] = __hip_atomic_fetch_add(histL + ev[k], 1u, __ATOMIC_RELAXED, __HIP_MEMORY_SCOPE_WORKGROUP);
    }
    __syncthreads();
    if (tid < 32) baseL[tid] = __hip_atomic_fetch_add((unsigned*)(F.ctl + CW_CNT + 64 * tid), histL[tid], RLX_AGENT);
    __syncthreads();
    if (lane < 16) {
#pragma unroll
        for (int k = 0; k < 4; ++k) { const unsigned pos = baseL[ev[k]] + lp[k];
            F.LIST[(size_t)ev[k] * CAP + pos] = mytok * 4 + k; F.GATE[(size_t)mytok * 4 + k] = gv[k]; }
    }
}

__device__ __forceinline__ int moe_tables(Frame& F) {
    LAS int* cntL = (LAS int*)(F.lds + XT_CNT); LAS int* tstartL = (LAS int*)(F.lds + XT_TSTART); LAS unsigned char* tileE = F.lds + XT_TILEE;
    __syncthreads();
    if (F.wave == 0) {
        const int lane = F.lane; const int c = lane < 32 ? (int)__hip_atomic_load((unsigned*)(F.ctl + CW_CNT + 64 * lane), RLX_AGENT) : 0; const int t = (c + 255) >> 8; int incl = t;
#pragma unroll
        for (int o = 1; o < 32; o <<= 1) { const int v = __shfl_up(incl, o); if (lane >= o) incl += v; }
        if (lane < 32) { cntL[lane] = c; tstartL[lane] = incl - t; }
        if (lane == 31) tstartL[32] = incl; }
    __syncthreads();
    const int total = tstartL[32];
    for (int mt = F.tid; mt < total; mt += 512) { int e = 0; for (int k = 1; k < 32; ++k) e += (tstartL[k] <= mt) ? 1 : 0; tileE[mt] = (unsigned char)e; }
    __syncthreads();
    return __builtin_amdgcn_readfirstlane(total);
}

struct Args { const float* in[19]; float* out; unsigned char* ws; int ph_lo, ph_hi; };
__global__ void __launch_bounds__(NWAVES * 64, 2) mk_fwd(Args args) {
    extern __shared__ __attribute__((aligned(16))) unsigned char lds[];
    Frame F;
    F.lds = (LAS unsigned char*)lds;
    F.MISC = (volatile LAS unsigned*)(F.lds + MISC_OFF);
    F.tid = threadIdx.x; F.lane = F.tid & 63; F.wave = __builtin_amdgcn_readfirstlane(F.tid >> 6);
    F.G = gridDim.x; { const int bx = blockIdx.x; F.vcu = (F.G % 8 == 0) ? (bx % 8) * (F.G / 8) + bx / 8 : bx; }
    unsigned char* ws = args.ws;
    F.ctl = (gu32*)(ws + WS_CTL);
    F.x = args.in[0]; F.g1 = args.in[1]; F.w_in = args.in[2]; F.gq = args.in[3]; F.gk = args.in[4]; F.rpb = args.in[5]; F.gsg = args.in[6]; F.w_sp = args.in[7]; F.b_sp = args.in[8];
    F.ga = args.in[9]; F.gs = args.in[10]; F.w_out = args.in[11]; F.g2 = args.in[12]; F.w_r = args.in[13]; F.b_r = args.in[14]; F.w_gu = args.in[15]; F.b_gu = args.in[16]; F.w_dn = args.in[17]; F.b_dn = args.in[18];
    F.out = args.out;
    F.WIN = (bf16*)(ws + WS_WIN); F.WOUT = (bf16*)(ws + WS_WOUT); F.WSP = (bf16*)(ws + WS_WSP); F.WRH = (bf16*)(ws + WS_WRH); F.WRL = (bf16*)(ws + WS_WRL);
    F.WGU = ws + WS_WGU; F.WDN = ws + WS_WDN; F.H = (bf16*)(ws + WS_H); F.H8 = ws + WS_H; F.PROJ = (bf16*)(ws + WS_PROJ); F.X2B = (bf16*)(ws + WS_PROJ);     F.MIX = (bf16*)(ws + WS_MIX);
    F.ACT = ws + WS_ACT; F.Y = ws + WS_Y; F.RMS1 = (float*)(ws + WS_RMS1); F.IG1 = (float*)(ws + WS_IG1); F.SSX = (float*)(ws + WS_SSX); F.RA = (float*)(ws + WS_RA); F.RB = (float*)(ws + WS_RB); F.SSQA = (float*)(ws + WS_SSQA); F.SSG = (float*)(ws + WS_SSG); F.RSTD2 = (float*)(ws + WS_RSTD2); F.GATE = (float*)(ws + WS_GATE); F.SLOT = (unsigned*)(ws + WS_SLOT); F.LIST = (int*)(ws + WS_LIST);
    for (int u = F.tid; u < (LDS_BYTES - LDSCTL_OFF) / 4; u += NWAVES * 64) ((LAS unsigned*)(F.lds + LDSCTL_OFF))[u] = 0u;
    __syncthreads();
    XcdBarrier bar; bar.bar = (unsigned*)(F.ctl + CW_BAR); bar.x = 0; bar.st = nullptr;
    if (N_LAUNCHES == 1) bar = xcd_barrier_post((unsigned*)(F.ctl + CW_BAR), F.MISC + 8);
#define GRID_BAR() do { if (N_LAUNCHES == 1) xcd_barrier(bar); } while (0)
    const int lo = args.ph_lo, hi = args.ph_hi;
#define IN(k) (lo <= (k) && (k) < hi)
#define BOTH(k) (IN(k) && IN((k) + 1))

    if (IN(0)) { p0_prologue(F); if (BOTH(0)) GRID_BAR(); }

    if (IN(1)) {
        TileOrder S; S.init(NTOK / BM, NPROJ / BM, F.G, (int)blockIdx.x, nullptr);
        if (F.tid < 128) ((LAS float*)(F.lds + XT_GAINS))[F.tid] = F.tid < 64 ? F.gq[F.tid] : F.gk[F.tid - 64];
        __syncthreads();
        EpiProjX E{F.PROJ, F.gq, F.gk, F.SSG, (const LAS float*)(F.lds + XT_GAINS)};
        const int grp = F.vcu & 1, nconv = (NE * (16 * 16 + 16 * 8) - F.vcu + F.G - 1) / F.G, hconv = nconv / 2;
        moe_convert(F, 0, grp == 0 ? hconv : 0);
        S.ib = 0; S.ie = 6;
        gemm_phase<EpiProjX, false, true, false>(F.lds, (const char*)F.H, (const char*)F.WIN, 0, DM * 2, S, E, nullptr);
        moe_convert(F, grp == 0 ? hconv : 0, grp == 0 ? nconv : hconv);
        S.ib = 6; S.ie = 0x7fffffff;
        gemm_phase<EpiProjX, false, true, false>(F.lds, (const char*)F.H, (const char*)F.WIN, 0, DM * 2, S, E, nullptr);
        moe_convert(F, grp == 0 ? nconv : hconv, nconv);
        if (BOTH(1)) GRID_BAR();
    }

    if (IN(2)) {
        for (int u = F.vcu; u < NBATCH * 16 * 8; u += F.G) attn_unit(F, u >> 7, (u >> 3) & 15, u & 7);
        if (BOTH(2)) GRID_BAR();
    }

    if (IN(3)) {
        for (int u = F.vcu; u < NTOK / 128; u += F.G) sgu_unit(F, u);
        if (BOTH(3)) GRID_BAR();
    }

    if (IN(4)) {
        TileOrder S; S.init(NTOK / BM, DM / BM, F.G, (int)blockIdx.x, nullptr);
        EpiResid E{F.H, F.RMS1, F.IG1, F.X2B, DM, F.RA, F.RB, F.SSX, (const LAS float*)(F.lds + XT_TOKL), (unsigned)(size_t)(F.lds + XT_TOKL)};
        gemm_phase<EpiResid, false, true, false>(F.lds, (const char*)F.MIX, (const char*)F.WOUT, 0, DM * 2, S, E, nullptr);
        if (BOTH(4)) GRID_BAR();
    }

    if (IN(5)) {
        for (int u = F.vcu; u < NTOK / 128; u += F.G) router_unit(F, u);
        if (BOTH(5)) GRID_BAR();
    }

    if (IN(6)) {
        const int total = moe_tables(F);
        LAS unsigned short* tokL = (LAS unsigned short*)(F.lds + XT_TOKL); const LAS int* cntL = (const LAS int*)(F.lds + XT_CNT); const LAS int* tstartL = (const LAS int*)(F.lds + XT_TSTART);
        TileOrder S; S.init(total, 16, F.G, (int)blockIdx.x, F.lds + XT_TILEE);
        { const int ih = F.tid >> 8, rowi = F.tid & 255; int vals[18];
#pragma unroll
          for (int k = 0; k < 18; ++k) { Unit u; const bool ok = S.at(ih + 2 * k, u); const int lp = (u.pm - tstartL[u.e]) * 256 + rowi; const bool in = lp < cntL[u.e];
              const int v = F.LIST[(size_t)u.e * CAP + (in ? lp : 0)]; vals[k] = ok ? (in ? (v >> 2) : 0) : -1; }
#pragma unroll
          for (int k = 0; k < 18; ++k) if (vals[k] >= 0) tokL[(ih + 2 * k) * 256 + rowi] = (unsigned short)vals[k]; }
        __syncthreads();
        EpiSwiglu E{F.ACT, F.b_gu, (const LAS float*)(F.lds + XT_BIAS), (unsigned)(size_t)(F.lds + XT_BIAS)};
        gemm_phase<EpiSwiglu, true, true, true>(F.lds, (const char*)F.H8, (const char*)F.WGU, (size_t)4096 * DM, DM, S, E, tokL);
        if (BOTH(6)) GRID_BAR();
    }

    if (IN(7)) {
        int total;
        if (IN(6)) { __syncthreads(); total = __builtin_amdgcn_readfirstlane(((const LAS int*)(F.lds + XT_TSTART))[32]); } else total = moe_tables(F);
        LAS unsigned* dstL = (LAS unsigned*)(F.lds + XT_TOKL); const LAS int* cntL = (const LAS int*)(F.lds + XT_CNT); const LAS int* tstartL = (const LAS int*)(F.lds + XT_TSTART);
        TileOrder S; S.init(total, 8, F.G, (int)blockIdx.x, F.lds + XT_TILEE);
        { const int ih = F.tid >> 8, rowi = F.tid & 255; int vals[9];
#pragma unroll
          for (int k = 0; k < 9; ++k) { Unit u; const bool ok = S.at(ih + 2 * k, u); const int lp = (u.pm - tstartL[u.e]) * 256 + rowi; const bool in = lp < cntL[u.e];
              const int v = F.LIST[(size_t)u.e * CAP + (in ? lp : 0)]; vals[k] = ok ? (in ? v : NTOK * TOPK) : -1; }
#pragma unroll
          for (int k = 0; k < 9; ++k) if (vals[k] >= 0) dstL[(ih + 2 * k) * 256 + rowi] = (unsigned)vals[k]; }
        __syncthreads();
        EpiDown E{F.Y, F.b_dn, dstL, (const LAS float*)(F.lds + XT_BIAS), (unsigned)(size_t)(F.lds + XT_BIAS)};
        gemm_phase<EpiDown, false, true, true>(F.lds, (const char*)F.ACT, (const char*)F.WDN, (size_t)DM * DM, DM, S, E, nullptr);
        if (BOTH(7)) GRID_BAR();
    }

    if (IN(8)) {
        const int gw = F.vcu * NWAVES + F.wave, NGW = F.G * NWAVES, lane = F.lane;
        f32x4 gA, gB; u32x4 xA[4], xB[4], yA[8], yB[8];
#define P8_LOAD(g_, x_, y_, t_) do { const size_t tt_ = (size_t)(t_); g_ = *(const f32x4*)(F.GATE + tt_ * 4); const unsigned char* yr_ = F.Y + tt_ * 4 * DM + 16 * lane; const bf16* xr_ = F.X2B + tt_ * DM + 16 * lane; \
        _Pragma("unroll") for (int j = 0; j < 2; ++j) { x_[2 * j] = *(const u32x4*)(xr_ + 1024 * j); x_[2 * j + 1] = *(const u32x4*)(xr_ + 1024 * j + 8); \
            _Pragma("unroll") for (int k = 0; k < 4; ++k) y_[4 * j + k] = *(const u32x4*)(yr_ + (size_t)k * DM + 1024 * j); } } while (0)
#define P8_DO(g_, x_, y_, t_) do { float* orow = F.out + (size_t)(t_) * DM + 16 * lane; \
        _Pragma("unroll") for (int j = 0; j < 2; ++j) { f32x4 o[4]; const u32x4 xlo = x_[2 * j], xhi = x_[2 * j + 1]; \
            o[0] = (f32x4){bflo(xlo.x), bfhi(xlo.x), bflo(xlo.y), bfhi(xlo.y)}; o[1] = (f32x4){bflo(xlo.z), bfhi(xlo.z), bflo(xlo.w), bfhi(xlo.w)}; \
            o[2] = (f32x4){bflo(xhi.x), bfhi(xhi.x), bflo(xhi.y), bfhi(xhi.y)}; o[3] = (f32x4){bflo(xhi.z), bfhi(xhi.z), bflo(xhi.w), bfhi(xhi.w)}; \
            _Pragma("unroll") for (int k = 0; k < 4; ++k) { const u32x4 y = y_[4 * j + k]; const float g = g_[k]; \
                _Pragma("unroll") for (int q = 0; q < 4; ++q) { const f32x2 lo = __builtin_amdgcn_cvt_pk_f32_fp8((int)y[q], false), hi = __builtin_amdgcn_cvt_pk_f32_fp8((int)y[q], true); \
                    o[q].x += g * lo.x; o[q].y += g * lo.y; o[q].z += g * hi.x; o[q].w += g * hi.y; } } \
            _Pragma("unroll") for (int q = 0; q < 4; ++q) *(f32x4*)(orow + 1024 * j + 4 * q) = o[q]; } } while (0)
        if (gw < NTOK) {
            P8_LOAD(gA, xA, yA, gw);
            for (int t = gw; t < NTOK; t += 2 * NGW) {
                const int t1 = t + NGW, t2 = t + 2 * NGW;
                P8_LOAD(gB, xB, yB, t1 < NTOK ? t1 : t);
                P8_DO(gA, xA, yA, t);
                if (t1 >= NTOK) break;
                P8_LOAD(gA, xA, yA, t2 < NTOK ? t2 : t1);
                P8_DO(gB, xB, yB, t1);
            }
        }
#undef P8_LOAD
#undef P8_DO
    }
#undef IN
#undef BOTH
}

extern "C" void kernel_launch(void* const* d_in, const int* in_sizes, int n_in, void* d_out, int out_size, void* d_ws, size_t ws_size, hipStream_t stream) {
    static int grid = 0;
    if (grid == 0) {
        if (n_in != 19 || out_size != NTOK * DM || ws_size < WS_END) { fprintf(stderr, "kernel_launch: unexpected problem (n_in %d, out %d, ws %zu)\n", n_in, out_size, ws_size); grid = -1; return; }
        int dev = 0, cus = 0, per_cu = 0;
        if (hipGetDevice(&dev) != hipSuccess || hipDeviceGetAttribute(&cus, hipDeviceAttributeMultiprocessorCount, dev) != hipSuccess) { grid = -1; return; }
        if (hipFuncSetAttribute((const void*)mk_fwd, hipFuncAttributeMaxDynamicSharedMemorySize, LDS_BYTES) != hipSuccess) { fprintf(stderr, "kernel_launch: hipFuncSetAttribute failed\n"); grid = -1; return; }
        if (hipOccupancyMaxActiveBlocksPerMultiprocessor(&per_cu, (const void*)mk_fwd, NWAVES * 64, LDS_BYTES) != hipSuccess || per_cu < 1) { fprintf(stderr, "kernel_launch: occupancy query says %d\n", per_cu); }
        (void)hipGetLastError();
        grid = cus;
    }
    if (grid < 0) return;
    if (hipMemsetAsync((char*)d_ws + WS_CTL, 0, CTL_ZERO_BYTES, stream) != hipSuccess) return;
    Args a{};
    for (int i = 0; i < 19; ++i) a.in[i] = (const float*)d_in[i];
    a.out = (float*)d_out; a.ws = (unsigned char*)d_ws;
    for (int li = 0; li < N_LAUNCHES; ++li) {
        a.ph_lo = (N_LAUNCHES == 1) ? 0 : li; a.ph_hi = (N_LAUNCHES == 1) ? N_PHASES : li + 1;
        hipLaunchKernelGGL(mk_fwd, dim3(grid), dim3(NWAVES * 64), LDS_BYTES, stream, a);
    }
}
```
